# Optimizing an MI355X kernel written in HIP

```python
import jax, jax.numpy as jnp
from jax import lax
import numpy as np

D_MODEL = 1024
BATCH = 8
SEQ = 2048
DEPTH = 1

PLE_DIM = 256
LRU_WIDTH = D_MODEL
LRU_BLOCKS = 8
LRU_BLOCK = LRU_WIDTH // LRU_BLOCKS
CONV_WIDTH = 4
LRU_C = 8.0
GLA_HEADS = 4
GLA_DK = D_MODEL // 2 // GLA_HEADS
GLA_DV = D_MODEL // GLA_HEADS
GLA_GATE_RANK = 16
GLA_TAU = 16.0
GLA_CHUNK = 64
PEER_HEADS = 8
PEER_KEYS = 128
PEER_EXPERTS = PEER_KEYS * PEER_KEYS
PEER_TOPK = 16
PEER_QDIM = 128
PEER_HALF = PEER_QDIM // 2
PEER_TOKEN_BLOCK = 128
DN_ALPHA = (2.0 * DEPTH) ** 0.25
DN_BETA = (8.0 * DEPTH) ** -0.25
LN_EPS = 1e-5
RMS_EPS = 1e-6
IN_SPLITS = (LRU_WIDTH, LRU_WIDTH, GLA_HEADS * GLA_DK, GLA_HEADS * GLA_DK,
             GLA_HEADS * GLA_DV, GLA_HEADS * GLA_DV, GLA_GATE_RANK, D_MODEL, D_MODEL)
IN_WIDTH = sum(IN_SPLITS)

kernel_name = "hawk_gla_peer_deepnorm_hybrid"


def layer_norm(x, g, b):
    xf = x.astype(jnp.float32)
    mu = jnp.mean(xf, axis=-1, keepdims=True)
    var = jnp.mean(jnp.square(xf - mu), axis=-1, keepdims=True)
    return ((xf - mu) * lax.rsqrt(var + LN_EPS) * g.astype(jnp.float32) + b.astype(jnp.float32)).astype(x.dtype)


def causal_depthwise_conv(x, w, b):
    y = lax.conv_general_dilated(
        x, w[:, None, :].astype(x.dtype), window_strides=(1,), padding=[(CONV_WIDTH - 1, 0)],
        dimension_numbers=("NWC", "WIO", "NWC"), feature_group_count=x.shape[-1])
    return y + b.astype(x.dtype)


def rg_lru(u, w_r, b_r, w_i, b_i, lam):
    B, S, W = u.shape
    uf = u.astype(jnp.float32)
    ub = uf.reshape(B, S, LRU_BLOCKS, LRU_BLOCK)
    r = jax.nn.sigmoid(jnp.einsum("bsnc,ncd->bsnd", ub, w_r.astype(jnp.float32)) + b_r.astype(jnp.float32)).reshape(B, S, W)
    i = jax.nn.sigmoid(jnp.einsum("bsnc,ncd->bsnd", ub, w_i.astype(jnp.float32)) + b_i.astype(jnp.float32)).reshape(B, S, W)
    log_a = -LRU_C * r * jax.nn.softplus(-lam.astype(jnp.float32))
    a = jnp.exp(log_a)
    mult = jnp.sqrt(-jnp.expm1(2.0 * log_a))
    inp = mult * (i * uf)

    def combine(c1, c2):
        a1, b1 = c1
        a2, b2 = c2
        return a1 * a2, a2 * b1 + b2

    _, h = lax.associative_scan(combine, (a, inp), axis=1)
    return h


def gla_chunked(q, k, v, log_f):
    B, S, H, _ = q.shape
    n = S // GLA_CHUNK

    def to_chunks(t):
        return t.reshape(B, n, GLA_CHUNK, H, t.shape[-1]).transpose(1, 0, 3, 2, 4)

    qc, kc, vc, gc = to_chunks(q), to_chunks(k), to_chunks(v), to_chunks(log_f)
    causal = jnp.tril(jnp.ones((GLA_CHUNK, GLA_CHUNK), dtype=bool))[:, :, None]

    def step(state, inp):
        q_, k_, v_, g_ = inp
        b = jnp.cumsum(g_, axis=2)
        b_last = b[:, :, -1:, :]
        o_inter = jnp.einsum("bhcd,bhde->bhce", q_ * jnp.exp(b), state)
        diff = b[:, :, :, None, :] - b[:, :, None, :, :]
        decay = jnp.exp(jnp.where(causal, diff, -jnp.inf))
        attn = jnp.einsum("bhid,bhjd,bhijd->bhij", q_, k_, decay)
        o = o_inter + jnp.einsum("bhij,bhje->bhie", attn, v_)
        new_state = (jnp.exp(b_last[:, :, 0, :, None]) * state
                     + jnp.einsum("bhcd,bhce->bhde", k_ * jnp.exp(b_last - b), v_))
        return new_state, o

    state0 = jnp.zeros((B, H, q.shape[-1], v.shape[-1]), jnp.float32)
    _, o = lax.scan(step, state0, (qc, kc, vc, gc))
    return o.transpose(1, 0, 3, 2, 4).reshape(B, S, H, v.shape[-1])


def hybrid_mixer(x, w_in, conv_w, conv_b, lru_wr, lru_br, lru_wi, lru_bi, lru_lambda,
                 gla_wf2, gla_bf, gla_norm_g, w_out):
    B, S, _ = x.shape
    z = x @ w_in
    offs = [int(o) for o in np.cumsum(IN_SPLITS)[:-1]]
    lru_x, lru_y, q, k, v, gla_r, f_low, gate_a, gate_b = jnp.split(z, offs, axis=-1)

    ua = causal_depthwise_conv(lru_x, conv_w, conv_b)
    ha = rg_lru(ua, lru_wr, lru_br, lru_wi, lru_bi, lru_lambda)
    ya = ha.astype(x.dtype) * jax.nn.gelu(lru_y, approximate=False)

    qf = q.astype(jnp.float32).reshape(B, S, GLA_HEADS, GLA_DK) * (GLA_DK ** -0.5)
    kf = k.astype(jnp.float32).reshape(B, S, GLA_HEADS, GLA_DK)
    vf = v.astype(jnp.float32).reshape(B, S, GLA_HEADS, GLA_DV)
    f_logit = f_low.astype(jnp.float32) @ gla_wf2.astype(jnp.float32) + gla_bf.astype(jnp.float32)
    log_f = (jax.nn.log_sigmoid(f_logit) / GLA_TAU).reshape(B, S, GLA_HEADS, GLA_DK)
    o = gla_chunked(qf, kf, vf, log_f)
    o = o * lax.rsqrt(jnp.mean(jnp.square(o), axis=-1, keepdims=True) + RMS_EPS)
    o = o.reshape(B, S, GLA_HEADS * GLA_DV) * gla_norm_g.astype(jnp.float32)
    yb = o.astype(x.dtype) * jax.nn.silu(gla_r)

    m = jax.nn.sigmoid(gate_a) * ya + jax.nn.sigmoid(gate_b) * yb
    return m @ w_out


def peer(x, w_q, sub_keys, u_tab, v_tab):
    B, S, D = x.shape
    T = B * S
    xt = x.reshape(T, D)
    q = (xt @ w_q).astype(jnp.float32).reshape(T, PEER_HEADS, 2, PEER_HALF)
    s = jnp.einsum("thpc,hpkc->thpk", q, sub_keys.astype(jnp.float32))
    top_s, top_i = lax.top_k(s, PEER_TOPK)
    cand_s = (top_s[:, :, 0, :, None] + top_s[:, :, 1, None, :]).reshape(T, PEER_HEADS, PEER_TOPK * PEER_TOPK)
    cand_i = (top_i[:, :, 0, :, None] * PEER_KEYS + top_i[:, :, 1, None, :]).reshape(T, PEER_HEADS, PEER_TOPK * PEER_TOPK)
    best_s, best_pos = lax.top_k(cand_s, PEER_TOPK)
    expert_idx = jnp.take_along_axis(cand_i, best_pos, axis=-1)
    gate = jax.nn.softmax(best_s, axis=-1)

    n_blk = T // PEER_TOKEN_BLOCK
    n_sel = PEER_HEADS * PEER_TOPK
    x_b = xt.reshape(n_blk, PEER_TOKEN_BLOCK, D)
    idx_b = expert_idx.reshape(n_blk, PEER_TOKEN_BLOCK, n_sel)
    gate_b = gate.reshape(n_blk, PEER_TOKEN_BLOCK, n_sel).astype(x.dtype)

    def block(args):
        xb, ib, gb = args
        u = jnp.take(u_tab, ib, axis=0)
        hid = jax.nn.gelu(jnp.einsum("td,ted->te", xb, u), approximate=False)
        vv = jnp.take(v_tab, ib, axis=0)
        return jnp.einsum("te,ted->td", gb * hid, vv)

    out = lax.map(block, (x_b, idx_b, gate_b))
    return out.reshape(B, S, D)


def setup_inputs(seed: int = 0) -> dict:
    key = jax.random.key(seed)
    ks = jax.random.split(key, 24)
    f32 = jnp.float32
    L = DEPTH

    def nrm(k, shape, scale):
        return jax.random.normal(k, shape, f32) * scale

    a_pow = jax.random.uniform(ks[10], (L, LRU_WIDTH), f32, 0.9, 0.999)
    sig = a_pow ** (1.0 / LRU_C)
    lru_lambda = jnp.log(sig) - jnp.log1p(-sig)
    return {
        "x": nrm(ks[0], (BATCH, SEQ, D_MODEL), 1.0),
        "p": nrm(ks[1], (DEPTH, BATCH, SEQ, PLE_DIM), 1.0),
        "w_in": nrm(ks[2], (L, D_MODEL, IN_WIDTH), D_MODEL ** -0.5),
        "conv_w": nrm(ks[3], (L, CONV_WIDTH, LRU_WIDTH), CONV_WIDTH ** -0.5),
        "conv_b": nrm(ks[4], (L, LRU_WIDTH), 0.01),
        "lru_wr": nrm(ks[5], (L, LRU_BLOCKS, LRU_BLOCK, LRU_BLOCK), LRU_BLOCK ** -0.5),
        "lru_br": nrm(ks[6], (L, LRU_BLOCKS, LRU_BLOCK), 0.01),
        "lru_wi": nrm(ks[7], (L, LRU_BLOCKS, LRU_BLOCK, LRU_BLOCK), LRU_BLOCK ** -0.5),
        "lru_bi": nrm(ks[8], (L, LRU_BLOCKS, LRU_BLOCK), 0.01),
        "lru_lambda": lru_lambda,
        "gla_wf2": nrm(ks[9], (L, GLA_GATE_RANK, GLA_HEADS * GLA_DK), GLA_GATE_RANK ** -0.5),
        "gla_bf": nrm(ks[11], (L, GLA_HEADS * GLA_DK), 0.01),
        "gla_norm_g": 1.0 + nrm(ks[12], (L, GLA_HEADS * GLA_DV), 0.02),
        "w_out": nrm(ks[13], (L, D_MODEL, D_MODEL), DN_BETA * D_MODEL ** -0.5),
        "ln1_g": 1.0 + nrm(ks[14], (L, D_MODEL), 0.02),
        "ln1_b": nrm(ks[15], (L, D_MODEL), 0.01),
        "peer_wq": nrm(ks[16], (L, D_MODEL, PEER_HEADS * PEER_QDIM), D_MODEL ** -0.5),
        "peer_subkeys": nrm(ks[17], (L, PEER_HEADS, 2, PEER_KEYS, PEER_HALF), PEER_HALF ** -0.5),
        "peer_u": nrm(ks[18], (L, PEER_EXPERTS, D_MODEL), D_MODEL ** -0.5),
        "peer_v": nrm(ks[19], (L, PEER_EXPERTS, D_MODEL), DN_BETA * PEER_HEADS ** -0.5),
        "ple_gate_w": nrm(ks[20], (L, D_MODEL, D_MODEL), D_MODEL ** -0.5),
        "ple_proj_w": nrm(ks[21], (L, PLE_DIM, D_MODEL), PLE_DIM ** -0.5),
        "ln2_g": 1.0 + nrm(ks[22], (L, D_MODEL), 0.02),
        "ln2_b": nrm(ks[23], (L, D_MODEL), 0.01),
    }


def reference(x, p, w_in, conv_w, conv_b, lru_wr, lru_br, lru_wi, lru_bi, lru_lambda,
              gla_wf2, gla_bf, gla_norm_g, w_out, ln1_g, ln1_b, peer_wq, peer_subkeys,
              peer_u, peer_v, ple_gate_w, ple_proj_w, ln2_g, ln2_b):
    for i in range(DEPTH):
        mix = hybrid_mixer(x, w_in[i], conv_w[i], conv_b[i], lru_wr[i], lru_br[i], lru_wi[i],
                           lru_bi[i], lru_lambda[i], gla_wf2[i], gla_bf[i], gla_norm_g[i], w_out[i])
        x = layer_norm(DN_ALPHA * x + mix, ln1_g[i], ln1_b[i])
        ple = jax.nn.sigmoid(x @ ple_gate_w[i]) * (p[i] @ ple_proj_w[i])
        ffn = peer(x, peer_wq[i], peer_subkeys[i], peer_u[i], peer_v[i])
        x = layer_norm(DN_ALPHA * x + ffn + ple, ln2_g[i], ln2_b[i])
    return x
```

```cpp
#include <hip/hip_runtime.h>
#include <hip/hip_cooperative_groups.h>
#include <cstdio>
namespace cg = cooperative_groups;
namespace pg8 {
#define PG8_LAS __attribute__((address_space(3)))
typedef unsigned short bf16_t;
typedef short bf16x8 __attribute__((ext_vector_type(8)));
typedef float f32x4 __attribute__((ext_vector_type(4)));
typedef unsigned u32x4 __attribute__((ext_vector_type(4)));
constexpr int BM = 256, BK = 64, HALF = 128, HTB = HALF * BK * 2  , STAGE_BYTES = 8 * HTB, NXCD = 8, WGM = 8;

__host__ __device__ __forceinline__ int lds_byte(int r, int c) { const int st = (r >> 4) * 2 + (c >> 5), rr = r & 15, cc = c & 31, ob = rr * 64 + cc * 2; return st * 1024 + (ob ^ (((ob >> 9) & 1) << 5)); }
__host__ __device__ __forceinline__ void stage_rc(int b, int& R, int& C) { const int st = b / 1024, sb = b % 1024, swz = sb ^ (((sb >> 9) & 1) << 5); R = (st >> 1) * 16 + swz / 64; C = (st & 1) * 32 + (swz % 64) / 2; }
__host__ __device__ __forceinline__ int perm32(int rho) { const int n = rho >> 4, i = rho & 15; return 8 * (i >> 2) + 4 * n + (i & 3); }

struct Unit { int pm, pn; };
struct Gemm { const bf16_t* A; const bf16_t* Bt; int M, N, K; };

struct StaticOrder {
    int nM, nN, nwg, G, c;
    __host__ __device__ void init(int M, int N, int G_, int c_) { nM = M / BM; nN = N / BM; nwg = nM * nN; G = G_; c = c_; }
    __host__ __device__ bool next(int i, Unit& u) const {
        const long L = (long)i * G + c; if (L >= nwg) return false;
        int wgid = (int)L; { const int q = nwg / NXCD, r = nwg % NXCD, xcd = wgid % NXCD, off = wgid / NXCD; wgid = (xcd < r ? xcd * (q + 1) : r * (q + 1) + (xcd - r) * q) + off; }
        const int nig = WGM * nN, gid = wgid / nig, fm = gid * WGM, gsz = (nM - fm) < WGM ? (nM - fm) : WGM;
        u.pm = fm + ((wgid % nig) % gsz); u.pn = (wgid % nig) / gsz; return true;
    }
    __device__ __forceinline__ void a_ready(const Unit&) const {}
    __device__ __forceinline__ void done(const Unit&) const {}
};
struct CountedOrder : StaticOrder {
    const unsigned* ready; unsigned need; unsigned* tmo;
    __device__ __forceinline__ void a_ready(const Unit& u) const {
        if (threadIdx.x < 64) {
            const unsigned long long t0 = __builtin_amdgcn_s_memrealtime(); unsigned polls = 0;
            while ((unsigned)__builtin_amdgcn_readfirstlane(__hip_atomic_load(ready + 64 * u.pm, __ATOMIC_RELAXED, __HIP_MEMORY_SCOPE_AGENT)) < need) {
                if ((++polls & 255u) == 0u && __builtin_amdgcn_readfirstlane(__hip_atomic_load(tmo, __ATOMIC_RELAXED, __HIP_MEMORY_SCOPE_AGENT)) != 0u) break;
                if (__builtin_amdgcn_s_memrealtime() - t0 > 2000000ull) {
                    if (threadIdx.x == 0) { unsigned expect = 0u; __hip_atomic_compare_exchange_strong(tmo + 1, &expect, 0x600u | (unsigned)(u.pm & 0xff), __ATOMIC_RELAXED, __ATOMIC_RELAXED, __HIP_MEMORY_SCOPE_AGENT); __hip_atomic_store(tmo, 1u, __ATOMIC_RELAXED, __HIP_MEMORY_SCOPE_AGENT); }
                    break; }
                __builtin_amdgcn_s_sleep(2); }
            __builtin_amdgcn_fence(__ATOMIC_ACQUIRE, "agent");
            asm volatile("s_waitcnt vmcnt(0)" ::: "memory");
        }
#if !defined(BROKEN_HOOK_NO_BARRIER)
        asm volatile("" ::: "memory"); __builtin_amdgcn_s_barrier(); asm volatile("" ::: "memory");
#endif
    }
};

__device__ __forceinline__ unsigned cvt_pk_bf16(float lo, float hi) { unsigned r; asm volatile("v_cvt_pk_bf16_f32 %0, %1, %2" : "=v"(r) : "v"(lo), "v"(hi)); return r; }
typedef float f32x2 __attribute__((ext_vector_type(2)));
__device__ __forceinline__ f32x2 gelu_pk(f32x2 v) {
    const f32x2 av = __builtin_elementwise_abs(v), d = av * 0.2316418882f + 1.0f;
    f32x2 t; t.x = __builtin_amdgcn_rcpf(d.x); t.y = __builtin_amdgcn_rcpf(d.y);
    f32x2 q = t * 0.5307027145f + (-0.7265760135f); q = q * t + 0.7107068705f; q = q * t + (-0.142248368f); q = q * t + 0.127414796f; q = q * t;
    const f32x2 s = (v * v) * (-0.72134752044f);
    f32x2 e; e.x = __builtin_amdgcn_exp2f(s.x); e.y = __builtin_amdgcn_exp2f(s.y);
    const f32x2 m = v * (q * e), r = v - m;
    f32x2 o; o.x = v.x < 0.f ? m.x : r.x; o.y = v.y < 0.f ? m.y : r.y; return o;
}
template <class Epi, class Sched, bool STAMP = false>
__device__ __forceinline__ void gemm_phase(PG8_LAS unsigned char* lds, const Gemm g, const Sched& S, const Epi& E, unsigned long long* stamps) {
    const int tid = threadIdx.x, wid = __builtin_amdgcn_readfirstlane(tid >> 6), lane = tid & 63, wr = wid >> 2, wc = wid & 3, fr = lane & 15, fq = lane >> 4;
    const int K = g.K, nt = K / BK;
    int ts_lo = 0, ts_hi = 0, nts = 0; const unsigned long long rt_entry = STAMP ? (unsigned long long)wall_clock64() : 0ull;
#define PG8_STAMP() do { if (STAMP && wid == 0 && nts < 64) { const unsigned long long _c = (unsigned long long)clock64(); \
        ts_lo = (lane == nts) ? (int)(unsigned)_c : ts_lo; ts_hi = (lane == nts) ? (int)(unsigned)(_c >> 32) : ts_hi; ++nts; } } while (0)
    PG8_STAMP();
    unsigned voffA[2], voffB[2];
#pragma unroll
    for (int i = 0; i < 2; ++i) { int R, C; stage_rc(tid * 16 + i * 8192, R, C); const int Rb = Epi::PERM ? ((R & ~31) + perm32(R & 31)) : R;
        voffA[i] = (unsigned)(R * K + C) * 2u; voffB[i] = (unsigned)(Rb * K + C) * 2u; }
    const size_t kstep = (size_t)(BK * 2);
    const size_t hstep = (size_t)HALF * K * 2;
    const size_t tstep = 2 * hstep;
    const unsigned ldsw = (unsigned)wid * 1024u;
    const int aoff = lds_byte(wr * 64 + fr, fq * 8), boff = lds_byte(wc * 32 + fr, fq * 8);
#define PG8_SA(b, h) (((b) * 2 + (h)) * HTB)
#define PG8_SB(b, h) ((4 + (b) * 2 + (h)) * HTB)
#define PG8_STAGE(bufoff, gbase, voff) do { _Pragma("unroll") for (int _i = 0; _i < 2; ++_i) \
        __builtin_amdgcn_global_load_lds((const unsigned*)((const char*)(gbase) + (voff)[_i]), (PG8_LAS unsigned*)(lds + (bufoff) + ldsw + _i * 8192), 16, 0, 0); } while (0)
#define PG8_LDA(dst, b, h) do { _Pragma("unroll") for (int m = 0; m < 4; ++m) _Pragma("unroll") for (int k = 0; k < 2; ++k) dst[m][k] = *(const PG8_LAS bf16x8*)(lds + PG8_SA(b, h) + aoff + m * 2048 + k * 1024); } while (0)
#define PG8_LDB(dst, b, h) do { _Pragma("unroll") for (int n = 0; n < 2; ++n) _Pragma("unroll") for (int k = 0; k < 2; ++k) dst[n][k] = *(const PG8_LAS bf16x8*)(lds + PG8_SB(b, h) + boff + n * 2048 + k * 1024); } while (0)
#define PG8_MMA(ai, bj, At, Bt) do { __builtin_amdgcn_s_setprio(1); _Pragma("unroll") for (int m = 0; m < 4; ++m) _Pragma("unroll") for (int n = 0; n < 2; ++n) _Pragma("unroll") for (int k = 0; k < 2; ++k) \
        acc[ai][bj][m][n] = __builtin_amdgcn_mfma_f32_16x16x32_bf16(Bt[n][k], At[m][k], acc[ai][bj][m][n], 0, 0, 0); __builtin_amdgcn_s_setprio(0); } while (0)
#define PG8_WAIT_V(n) asm volatile("s_waitcnt vmcnt(" #n ")" ::: "memory")
#define PG8_WAIT_L(n) asm volatile("s_waitcnt lgkmcnt(" #n ")" ::: "memory")
#define PG8_BAR __builtin_amdgcn_s_barrier()
#define PG8_SCHED __builtin_amdgcn_sched_barrier(0)
    Unit cur, nxt; int ui = 0;
    if (!S.next(0, cur)) return;
    f32x4 acc[2][2][4][2];
#pragma unroll
    for (int a = 0; a < 2; ++a)
#pragma unroll
        for (int b = 0; b < 2; ++b)
#pragma unroll
            for (int m = 0; m < 4; ++m)
#pragma unroll
                for (int n = 0; n < 2; ++n) acc[a][b][m][n] = (f32x4){0.f, 0.f, 0.f, 0.f};
    bf16x8 At[4][2], B0[2][2], B1[2][2];
    const char* cA = (const char*)g.A + (size_t)cur.pm * tstep; const char* cB = (const char*)g.Bt + (size_t)cur.pn * tstep;
    S.a_ready(cur);
    PG8_STAGE(PG8_SB(0, 0), cB, voffB); PG8_STAGE(PG8_SA(0, 0), cA, voffA); PG8_STAGE(PG8_SB(0, 1), cB + hstep, voffB); PG8_STAGE(PG8_SA(0, 1), cA + hstep, voffA);
    if (wr == 1) PG8_BAR;
    PG8_WAIT_V(4); PG8_BAR;
    PG8_STAGE(PG8_SB(1, 0), cB + kstep, voffB); PG8_STAGE(PG8_SA(1, 0), cA + kstep, voffA); PG8_STAGE(PG8_SB(1, 1), cB + hstep + kstep, voffB);
    PG8_WAIT_V(6); PG8_BAR;
    PG8_STAMP();
    for (;;) {
        const bool has_next = S.next(ui + 1, nxt);
        const char* nA = has_next ? (const char*)g.A + (size_t)nxt.pm * tstep : cA; const char* nB = has_next ? (const char*)g.Bt + (size_t)nxt.pn * tstep : cB;
        for (int t = 0; t < nt; t += 2) {
            const bool last = (t == nt - 2);
            const char* a1 = cA + (size_t)(t + 1) * kstep;
            const char* a2 = last ? nA : cA + (size_t)(t + 2) * kstep; const char* b2 = last ? nB : cB + (size_t)(t + 2) * kstep;
            const char* a3 = a2 + kstep; const char* b3 = b2 + kstep;
            if (last && has_next) S.a_ready(nxt);
            PG8_LDB(B0, 0, 0); PG8_SCHED; PG8_LDA(At, 0, 0); PG8_STAGE(PG8_SA(1, 1), a1 + hstep, voffA);
            PG8_WAIT_L(8); PG8_BAR; PG8_WAIT_L(0); PG8_MMA(0, 0, At, B0); PG8_BAR; PG8_SCHED;
            PG8_LDB(B1, 0, 1); PG8_STAGE(PG8_SB(0, 0), b2, voffB);
            PG8_BAR; PG8_WAIT_L(0); PG8_MMA(0, 1, At, B1); PG8_BAR;
            PG8_LDA(At, 0, 1); PG8_STAGE(PG8_SA(0, 0), a2, voffA);
            PG8_BAR; PG8_WAIT_L(0); PG8_MMA(1, 0, At, B0); PG8_BAR; PG8_SCHED;
            PG8_STAGE(PG8_SB(0, 1), b2 + hstep, voffB);
            PG8_WAIT_V(6); PG8_BAR; PG8_MMA(1, 1, At, B1); PG8_BAR;
            PG8_LDB(B0, 1, 0); PG8_SCHED; PG8_LDA(At, 1, 0); PG8_STAGE(PG8_SA(0, 1), a2 + hstep, voffA);
            PG8_WAIT_L(8); PG8_BAR; PG8_WAIT_L(0); PG8_MMA(0, 0, At, B0); PG8_BAR; PG8_SCHED;
            PG8_LDB(B1, 1, 1); PG8_STAGE(PG8_SB(1, 0), b3, voffB);
            PG8_BAR; PG8_WAIT_L(0); PG8_MMA(0, 1, At, B1); PG8_BAR;
            PG8_LDA(At, 1, 1); PG8_STAGE(PG8_SA(1, 0), a3, voffA);
            PG8_BAR; PG8_WAIT_L(0); PG8_MMA(1, 0, At, B0); PG8_BAR; PG8_SCHED;
            PG8_STAGE(PG8_SB(1, 1), b3 + hstep, voffB);
            PG8_WAIT_V(6); PG8_BAR; PG8_MMA(1, 1, At, B1); PG8_BAR;
        }
        PG8_STAMP();
        if constexpr (!Epi::AFTER_DRAIN) { E(acc, cur, wr, wc, fr, fq); S.done(cur); }
        PG8_STAMP();
        if (!has_next) break;
#pragma unroll
        for (int a = 0; a < 2; ++a)
#pragma unroll
            for (int b = 0; b < 2; ++b)
#pragma unroll
                for (int m = 0; m < 4; ++m)
#pragma unroll
                    for (int n = 0; n < 2; ++n) acc[a][b][m][n] = (f32x4){0.f, 0.f, 0.f, 0.f};
        cur = nxt; cA = nA; cB = nB; ++ui;
    }
    PG8_WAIT_V(0);
    if (wr == 0) PG8_BAR;
    PG8_BAR;
    if constexpr (Epi::AFTER_DRAIN) { E.fused(acc, cur, wr, wc, fr, fq, lds, wid, lane); S.done(cur); }
    PG8_STAMP();
    if (STAMP && wid == 0) { stamps[lane] = lane < nts ? (((unsigned long long)(unsigned)ts_hi << 32) | (unsigned)ts_lo) : 0ull;
        if (lane == 62) stamps[62] = rt_entry; if (lane == 63) stamps[63] = (unsigned long long)wall_clock64(); }
#undef PG8_STAMP
#undef PG8_SA
#undef PG8_SB
#undef PG8_STAGE
#undef PG8_LDA
#undef PG8_LDB
#undef PG8_MMA
#undef PG8_WAIT_V
#undef PG8_WAIT_L
#undef PG8_BAR
#undef PG8_SCHED
}
}

using pg8::bf16_t; using pg8::bf16x8; using pg8::f32x4; using pg8::u32x4; using pg8::f32x2; using pg8::Unit;
typedef __bf16 bf16x2_t __attribute__((ext_vector_type(2)));
typedef unsigned u32x2 __attribute__((ext_vector_type(2)));

constexpr int NTOK = 16384, DM = 1024, SEQL = 2048;
constexpr int INW = 7184;
constexpr size_t MBY = (size_t)1 << 20;
constexpr size_t O_ZX = 0, O_GY = 32 * MBY, O_ZQ = 64 * MBY, O_ZK = 80 * MBY, O_ZV = 96 * MBY, O_GR = 128 * MBY, O_XB = 160 * MBY,
                 O_WINT = 192 * MBY, O_WOUTT = 207 * MBY, O_WQGT = 209 * MBY, O_WPPT = 213 * MBY, O_PB = 214 * MBY, O_FLOW = 222 * MBY,
                 O_DLAST = 223 * MBY, O_SSQ = 224 * MBY;
constexpr size_t O_UT = 0, O_UB = 0, O_VB = 32 * MBY, O_X1B = 64 * MBY, O_PP = 96 * MBY, O_QP = 128 * MBY;
constexpr int LDS_BYTES = 144 * 1024;
constexpr float DN_ALPHA = 1.189207115002721f;

struct Params {
    const float* x; const float* p; const float* w_in; const float* conv_w; const float* conv_b; const float* lru_wr; const float* lru_br;
    const float* lru_wi; const float* lru_bi; const float* lru_lambda; const float* gla_wf2; const float* gla_bf; const float* gla_norm_g;
    const float* w_out; const float* ln1_g; const float* ln1_b; const float* peer_wq; const float* peer_subkeys; const float* peer_u;
    const float* peer_v; const float* ple_gate_w; const float* ple_proj_w; const float* ln2_g; const float* ln2_b;
    float* out; unsigned char* ws; int ph_lo, ph_hi, coop, pad_;
};

__device__ __forceinline__ bf16_t f2bf(float f) { unsigned u = __float_as_uint(f); u += 0x7FFFu + ((u >> 16) & 1u); return (bf16_t)(u >> 16); }
__device__ __forceinline__ float bf2f(bf16_t b) { return __uint_as_float(((unsigned)b) << 16); }
__device__ __forceinline__ float bflo(unsigned w) { return __uint_as_float(w << 16); }
__device__ __forceinline__ float bfhi(unsigned w) { return __uint_as_float(w & 0xffff0000u); }
__device__ __forceinline__ unsigned pk2(float lo, float hi) { typedef float f2_t __attribute__((ext_vector_type(2))); f2_t v = {lo, hi}; return __builtin_bit_cast(unsigned, __builtin_convertvector(v, bf16x2_t)); }
__device__ __forceinline__ float sigmoidf_(float x) { return 1.0f / (1.0f + __expf(-x)); }
__device__ __forceinline__ f32x4 mfma16(bf16x8 a, bf16x8 b, f32x4 c) { return __builtin_amdgcn_mfma_f32_16x16x32_bf16(a, b, c, 0, 0, 0); }
__device__ __forceinline__ float dot2bf(unsigned a, unsigned b, float c) { return __builtin_amdgcn_fdot2_f32_bf16(__builtin_bit_cast(bf16x2_t, a), __builtin_bit_cast(bf16x2_t, b), c, false); }
__device__ __forceinline__ float wave_sum(float v) {
#pragma unroll
    for (int o = 32; o >= 1; o >>= 1) v += __shfl_xor(v, o);
    return v;
}

struct EpiZ {
    static constexpr bool PERM = true, AFTER_DRAIN = false;
    unsigned char* ws;
    __device__ __forceinline__ void operator()(const f32x4 (&acc)[2][2][4][2], const Unit& u, int wr, int wc, int fr, int fq) const {
        const int pn = u.pn; const int row0 = u.pm * 256 + wr * 64 + fr;
        const bool pairA = (pn >= 4 && pn < 12), pairB = (pn >= 20);
        if (pairA || pairB) {
            const int j = pairA ? pn - 4 : pn - 20;
            bf16_t* base = (bf16_t*)(ws + (pairA ? O_GY : O_GR));
            const int col = j * 128 + wc * 32 + 8 * fq;
#pragma unroll
            for (int ai = 0; ai < 2; ++ai)
#pragma unroll
                for (int m = 0; m < 4; ++m) {
                    const f32x4 a0 = acc[ai][0][m][0], a1 = acc[ai][0][m][1], g0 = acc[ai][1][m][0], g1 = acc[ai][1][m][1];
                    float o[8];
                    if (pairA) {
                        f32x2 e0 = pg8::gelu_pk((f32x2){a0[0], a0[1]}), e1 = pg8::gelu_pk((f32x2){a0[2], a0[3]}), e2 = pg8::gelu_pk((f32x2){a1[0], a1[1]}), e3 = pg8::gelu_pk((f32x2){a1[2], a1[3]});
                        o[0] = e0.x; o[1] = e0.y; o[2] = e1.x; o[3] = e1.y; o[4] = e2.x; o[5] = e2.y; o[6] = e3.x; o[7] = e3.y;
                    } else {
#pragma unroll
                        for (int q = 0; q < 4; ++q) { o[q] = a0[q] * sigmoidf_(a0[q]); o[4 + q] = a1[q] * sigmoidf_(a1[q]); }
                    }
#pragma unroll
                    for (int q = 0; q < 4; ++q) { o[q] *= sigmoidf_(g0[q]); o[4 + q] *= sigmoidf_(g1[q]); }
                    u32x4 w; w.x = pk2(o[0], o[1]); w.y = pk2(o[2], o[3]); w.z = pk2(o[4], o[5]); w.w = pk2(o[6], o[7]);
                    *(u32x4*)(base + (size_t)(row0 + ai * 128 + m * 16) * 1024 + col) = w;
                }
        } else {
            bf16_t* base; int ldc, colt;
            if (pn < 4) { base = (bf16_t*)(ws + O_ZX); ldc = 1024; colt = pn * 256; }
            else if (pn < 14) { base = (bf16_t*)(ws + O_ZQ); ldc = 512; colt = (pn - 12) * 256; }
            else if (pn < 16) { base = (bf16_t*)(ws + O_ZK); ldc = 512; colt = (pn - 14) * 256; }
            else { base = (bf16_t*)(ws + O_ZV); ldc = 1024; colt = (pn - 16) * 256; }
            const int col0 = colt + wc * 32 + 8 * fq;
#pragma unroll
            for (int ai = 0; ai < 2; ++ai)
#pragma unroll
                for (int m = 0; m < 4; ++m) {
                    bf16_t* rowp = base + (size_t)(row0 + ai * 128 + m * 16) * ldc + col0;
#pragma unroll
                    for (int bj = 0; bj < 2; ++bj) {
                        const f32x4 v0 = acc[ai][bj][m][0], v1 = acc[ai][bj][m][1];
                        u32x4 w; w.x = pk2(v0[0], v0[1]); w.y = pk2(v0[2], v0[3]); w.z = pk2(v1[0], v1[1]); w.w = pk2(v1[2], v1[3]);
                        *(u32x4*)(rowp + bj * 128) = w;
                    }
                }
        }
    }
};
struct EpiPP {
    static constexpr bool PERM = true, AFTER_DRAIN = false;
    bf16_t* O;
    __device__ __forceinline__ void operator()(const f32x4 (&acc)[2][2][4][2], const Unit& u, int wr, int wc, int fr, int fq) const {
        const int row0 = u.pm * 256 + wr * 64 + fr, col0 = u.pn * 256 + wc * 32 + 8 * fq;
#pragma unroll
        for (int ai = 0; ai < 2; ++ai)
#pragma unroll
            for (int m = 0; m < 4; ++m) {
                bf16_t* rowp = O + (size_t)(row0 + ai * 128 + m * 16) * 1024 + col0;
#pragma unroll
                for (int bj = 0; bj < 2; ++bj) {
                    const f32x4 v0 = acc[ai][bj][m][0], v1 = acc[ai][bj][m][1];
                    u32x4 w; w.x = pk2(v0[0], v0[1]); w.y = pk2(v0[2], v0[3]); w.z = pk2(v1[0], v1[1]); w.w = pk2(v1[2], v1[3]);
                    *(u32x4*)(rowp + bj * 128) = w;
                }
            }
    }
};
struct EpiY1 {
    static constexpr bool PERM = false, AFTER_DRAIN = false;
    const float* X; float* Y;
    __device__ __forceinline__ void operator()(const f32x4 (&acc)[2][2][4][2], const Unit& u, int wr, int wc, int fr, int fq) const {
        const int row0 = u.pm * 256 + wr * 64 + fr, col0 = u.pn * 256 + wc * 32 + 4 * fq;
#pragma unroll
        for (int ai = 0; ai < 2; ++ai)
#pragma unroll
            for (int m = 0; m < 4; ++m) {
                const size_t ro = (size_t)(row0 + ai * 128 + m * 16) * 1024 + col0;
#pragma unroll
                for (int bj = 0; bj < 2; ++bj)
#pragma unroll
                    for (int n = 0; n < 2; ++n) {
                        const f32x4 xv = *(const f32x4*)(X + ro + bj * 128 + n * 16);
                        *(f32x4*)(Y + ro + bj * 128 + n * 16) = xv * DN_ALPHA + acc[ai][bj][m][n];
                    }
            }
    }
};
struct EpiQG {
    static constexpr bool PERM = false, AFTER_DRAIN = false;
    float* QP; bf16_t* PP;
    __device__ __forceinline__ void operator()(const f32x4 (&acc)[2][2][4][2], const Unit& u, int wr, int wc, int fr, int fq) const {
        const int row0 = u.pm * 256 + wr * 64 + fr; const int pn = u.pn;
        const int col0 = (pn & 3) * 256 + wc * 32 + 4 * fq;
#pragma unroll
        for (int ai = 0; ai < 2; ++ai)
#pragma unroll
            for (int m = 0; m < 4; ++m) {
                const size_t ro = (size_t)(row0 + ai * 128 + m * 16) * 1024 + col0;
#pragma unroll
                for (int bj = 0; bj < 2; ++bj)
#pragma unroll
                    for (int n = 0; n < 2; ++n) {
                        const f32x4 a = acc[ai][bj][m][n];
                        if (pn < 4) { *(f32x4*)(QP + ro + bj * 128 + n * 16) = a; }
                        else {
                            u32x2* pp = (u32x2*)(PP + ro + bj * 128 + n * 16);
                            const u32x2 w = *pp;
                            u32x2 o; o.x = pk2(sigmoidf_(a[0]) * bflo(w.x), sigmoidf_(a[1]) * bfhi(w.x)); o.y = pk2(sigmoidf_(a[2]) * bflo(w.y), sigmoidf_(a[3]) * bfhi(w.y));
                            *pp = o;
                        }
                    }
            }
    }
};

__device__ __forceinline__ int win_src_col(int n) {
    if (n < 1024) return n;
    if (n < 3072) { const int j = (n - 1024) >> 8, r = (n - 1024) & 255; return r < 128 ? 1024 + j * 128 + r : 5136 + j * 128 + (r - 128); }
    if (n < 3584) return 2048 + (n - 3072);
    if (n < 4096) return 2560 + (n - 3584);
    if (n < 5120) return 3072 + (n - 4096);
    { const int j = (n - 5120) >> 8, r = (n - 5120) & 255; return r < 128 ? 4096 + j * 128 + r : 6160 + j * 128 + (r - 128); }
}
__device__ void phase_prep(const Params& P, unsigned char* lds) {
    const int tid = threadIdx.x, wid = tid >> 6, lane = tid & 63;
    bf16_t* wf = (bf16_t*)lds;
    float* ts = (float*)(lds + 34816);
    for (int i = tid; i < 16 * 1024; i += 512) { const int r = i & 15, k = i >> 4; wf[r * 1032 + k] = f2bf(P.w_in[(size_t)k * INW + 5120 + r]); }
    __syncthreads();
    bf16_t* xb = (bf16_t*)(P.ws + O_XB); float* flow = (float*)(P.ws + O_FLOW);
    if (wid < 4) {
        for (int tile = wid * gridDim.x + blockIdx.x; tile < 1024; tile += 4 * gridDim.x) {
            const int c = lane & 15, kq = lane >> 4; const int row = tile * 16 + c;
            f32x4 acc = {0.f, 0.f, 0.f, 0.f};
            const float* xr = P.x + (size_t)row * 1024 + kq * 8;
#pragma unroll 4
            for (int ks = 0; ks < 32; ++ks) {
                const f32x4 a0 = *(const f32x4*)(xr + ks * 32), a1 = *(const f32x4*)(xr + ks * 32 + 4);
                u32x4 w; w.x = pk2(a0[0], a0[1]); w.y = pk2(a0[2], a0[3]); w.z = pk2(a1[0], a1[1]); w.w = pk2(a1[2], a1[3]);
                *(u32x4*)(xb + (size_t)row * 1024 + ks * 32 + kq * 8) = w;
                const bf16x8 bfr = *(const bf16x8*)(wf + c * 1032 + ks * 32 + kq * 8);
                acc = mfma16(__builtin_bit_cast(bf16x8, w), bfr, acc);
            }
#pragma unroll
            for (int i = 0; i < 4; ++i) flow[(size_t)(tile * 16 + kq * 4 + i) * 16 + c] = acc[i];
        }
    } else {
        bf16_t* pb = (bf16_t*)(P.ws + O_PB);
        const int nthr = 4 * 64 * gridDim.x;
        for (int i = ((wid - 4) * gridDim.x + blockIdx.x) * 64 + lane; i < NTOK * 256 / 4; i += nthr) {
            const f32x4 a = *(const f32x4*)(P.p + (size_t)i * 4);
            u32x2 w; w.x = pk2(a[0], a[1]); w.y = pk2(a[2], a[3]);
            *(u32x2*)(pb + (size_t)i * 4) = w;
        }
    }
    for (int job = blockIdx.x; job < 2624; job += gridDim.x) {
        const float* W; bf16_t* O; int ldw, Kd, tn, tk, mode;
        if (job < 1792) { W = P.w_in; O = (bf16_t*)(P.ws + O_WINT); ldw = INW; Kd = 1024; tn = job >> 4; tk = job & 15; mode = 0; }
        else if (job < 2048) { const int j = job - 1792; W = P.w_out; O = (bf16_t*)(P.ws + O_WOUTT); ldw = 1024; Kd = 1024; tn = j >> 4; tk = j & 15; mode = 1; }
        else if (job < 2560) { const int j = job - 2048; tn = j >> 4; tk = j & 15; mode = 2; ldw = 1024; Kd = 1024; O = (bf16_t*)(P.ws + O_WQGT); W = tn < 16 ? P.peer_wq : P.ple_gate_w; }
        else { const int j = job - 2560; W = P.ple_proj_w; O = (bf16_t*)(P.ws + O_WPPT); ldw = 1024; Kd = 256; tn = j >> 2; tk = j & 3; mode = 1; }
        const int n0 = tn * 64, k0 = tk * 64;
        int sc0 = n0; if (mode == 0) sc0 = win_src_col(n0); if (mode == 2) sc0 = n0 & 1023;
        {
            const int kk = tid >> 4, c4 = (tid & 15) * 4;
#pragma unroll
            for (int i = 0; i < 2; ++i) {
                const f32x4 v = *(const f32x4*)(W + (size_t)(k0 + kk + 32 * i) * ldw + sc0 + c4);
                float* d = ts + (kk + 32 * i) * 65 + c4; d[0] = v[0]; d[1] = v[1]; d[2] = v[2]; d[3] = v[3];
            }
        }
        __syncthreads();
        {
            const int n = tid >> 3, kc = (tid & 7) * 8;
            float v[8];
#pragma unroll
            for (int j = 0; j < 8; ++j) v[j] = ts[(kc + j) * 65 + n];
            u32x4 w; w.x = pk2(v[0], v[1]); w.y = pk2(v[2], v[3]); w.z = pk2(v[4], v[5]); w.w = pk2(v[6], v[7]);
            *(u32x4*)(O + (size_t)(n0 + n) * Kd + k0 + kc) = w;
        }
        __syncthreads();
    }
}

__device__ void phase_lru(const Params& P, unsigned char* lds) {
    const int tid = threadIdx.x, wid = __builtin_amdgcn_readfirstlane(tid >> 6), lane = tid & 63, c = lane & 15, kq = lane >> 4;
    bf16_t* u_s = (bf16_t*)lds;
    float* u32_s = (float*)(lds + 34816);
    float* a_s = (float*)(lds + 51712);
    float* i_s = (float*)(lds + 68608);
    float* segA = (float*)(lds + 85504);
    float* segH = (float*)(lds + 87552);
    float* carry = (float*)(lds + 89600);
    const bf16_t* zx = (const bf16_t*)(P.ws + O_ZX); const bf16_t* gy = (const bf16_t*)(P.ws + O_GY); bf16_t* yag = (bf16_t*)(P.ws + O_XB);
    for (int item = blockIdx.x; item < 256; item += gridDim.x) {
        const int b = item >> 5, blk = (item >> 2) & 7, qd = item & 3;
        const int ch0 = blk * 128, d0 = ch0 + qd * 32;
        bf16x8 Bf[2][2][4];
#pragma unroll
        for (int mat = 0; mat < 2; ++mat) {
            const float* W = (mat ? P.lru_wi : P.lru_wr) + (size_t)blk * 128 * 128;
#pragma unroll
            for (int nt = 0; nt < 2; ++nt)
#pragma unroll
                for (int ks = 0; ks < 4; ++ks) {
                    float v[8];
#pragma unroll
                    for (int j = 0; j < 8; ++j) v[j] = W[(size_t)(ks * 32 + kq * 8 + j) * 128 + qd * 32 + nt * 16 + c];
                    u32x4 w; w.x = pk2(v[0], v[1]); w.y = pk2(v[2], v[3]); w.z = pk2(v[4], v[5]); w.w = pk2(v[6], v[7]);
                    Bf[mat][nt][ks] = __builtin_bit_cast(bf16x8, w);
                }
        }
        float br[2], bi[2], sp[2];
#pragma unroll
        for (int nt = 0; nt < 2; ++nt) {
            const int dch = d0 + nt * 16 + c;
            br[nt] = P.lru_br[dch]; bi[nt] = P.lru_bi[dch];
            const float lam = P.lru_lambda[dch];
            const float spl = (lam > 0.f ? 0.f : -lam) + log1pf(__expf(-fabsf(lam)));
            sp[nt] = -8.0f * spl;
        }
        const int cg8 = tid & 15, tgrp = tid >> 4;
        float cw[4][8], cb[8];
#pragma unroll
        for (int j = 0; j < 4; ++j)
#pragma unroll
            for (int q = 0; q < 8; ++q) cw[j][q] = P.conv_w[j * 1024 + ch0 + cg8 * 8 + q];
#pragma unroll
        for (int q = 0; q < 8; ++q) cb[q] = P.conv_b[ch0 + cg8 * 8 + q];
        if (tid < 32) carry[tid] = 0.f;
        for (int tile = 0; tile < 16; ++tile) {
            const int t0 = tile * 128;
            {
                u32x4 rows[7];
#pragma unroll
                for (int r = 0; r < 7; ++r) {
                    const int tt = t0 + tgrp * 4 - 3 + r;
                    if (tt >= 0) rows[r] = *(const u32x4*)(zx + ((size_t)b * SEQL + tt) * 1024 + ch0 + cg8 * 8);
                    else rows[r] = (u32x4){0u, 0u, 0u, 0u};
                }
#pragma unroll
                for (int i = 0; i < 4; ++i) {
                    float o[8];
#pragma unroll
                    for (int q = 0; q < 8; ++q) o[q] = cb[q];
#pragma unroll
                    for (int j = 0; j < 4; ++j) {
                        const u32x4 rw = rows[i + j];
                        o[0] += cw[j][0] * bflo(rw.x); o[1] += cw[j][1] * bfhi(rw.x); o[2] += cw[j][2] * bflo(rw.y); o[3] += cw[j][3] * bfhi(rw.y);
                        o[4] += cw[j][4] * bflo(rw.z); o[5] += cw[j][5] * bfhi(rw.z); o[6] += cw[j][6] * bflo(rw.w); o[7] += cw[j][7] * bfhi(rw.w);
                    }
                    const int t = tgrp * 4 + i;
                    u32x4 w; w.x = pk2(o[0], o[1]); w.y = pk2(o[2], o[3]); w.z = pk2(o[4], o[5]); w.w = pk2(o[6], o[7]);
                    *(u32x4*)(u_s + t * 136 + cg8 * 8) = w;
                    if ((cg8 >> 2) == qd) {
#pragma unroll
                        for (int q = 0; q < 8; ++q) u32_s[t * 33 + (cg8 & 3) * 8 + q] = o[q];
                    }
                }
            }
            __syncthreads();
            {
                f32x4 accR[2], accI[2];
#pragma unroll
                for (int nt = 0; nt < 2; ++nt) { accR[nt] = (f32x4){0.f, 0.f, 0.f, 0.f}; accI[nt] = (f32x4){0.f, 0.f, 0.f, 0.f}; }
#pragma unroll
                for (int ks = 0; ks < 4; ++ks) {
                    const bf16x8 af = *(const bf16x8*)(u_s + (wid * 16 + c) * 136 + ks * 32 + kq * 8);
#pragma unroll
                    for (int nt = 0; nt < 2; ++nt) { accR[nt] = mfma16(af, Bf[0][nt][ks], accR[nt]); accI[nt] = mfma16(af, Bf[1][nt][ks], accI[nt]); }
                }
#pragma unroll
                for (int nt = 0; nt < 2; ++nt)
#pragma unroll
                    for (int i = 0; i < 4; ++i) {
                        const int t = wid * 16 + kq * 4 + i, dl = nt * 16 + c;
                        const float r = sigmoidf_(accR[nt][i] + br[nt]), ig = sigmoidf_(accI[nt][i] + bi[nt]);
                        const float log_a = sp[nt] * r;
                        const float a = __expf(log_a);
                        const float mult = sqrtf(-expm1f(2.0f * log_a));
                        a_s[t * 33 + dl] = a; i_s[t * 33 + dl] = mult * ig * u32_s[t * 33 + dl];
                    }
            }
            __syncthreads();
            {
                const int cs = tid & 31, seg = tid >> 5;
                float av[8], iv[8];
#pragma unroll
                for (int j = 0; j < 8; ++j) { av[j] = a_s[(seg * 8 + j) * 33 + cs]; iv[j] = i_s[(seg * 8 + j) * 33 + cs]; }
                float A = 1.f, H = 0.f;
#pragma unroll
                for (int j = 0; j < 8; ++j) { H = av[j] * H + iv[j]; A *= av[j]; }
                segA[seg * 32 + cs] = A; segH[seg * 32 + cs] = H;
                __syncthreads();
                float h = carry[cs];
                for (int s = 0; s < seg; ++s) h = segA[s * 32 + cs] * h + segH[s * 32 + cs];
#pragma unroll
                for (int j = 0; j < 8; ++j) {
                    h = av[j] * h + iv[j];
                    const size_t gi = ((size_t)b * SEQL + t0 + seg * 8 + j) * 1024 + d0 + cs;
                    yag[gi] = f2bf(h * bf2f(gy[gi]));
                }
                __syncthreads();
                if (seg == 15) carry[cs] = h;
            }
        }
        __syncthreads();
    }
}

__device__ void phase_gla1(const Params& P, unsigned char* lds) {
    const int tid = threadIdx.x, wid = __builtin_amdgcn_readfirstlane(tid >> 6), lane = tid & 63, c = lane & 15, kq = lane >> 4;
    bf16_t* Qb_s = (bf16_t*)(lds + 33024);
    bf16_t* Kb_s = (bf16_t*)(lds + 50432);
    bf16_t* Klt_s = (bf16_t*)(lds + 67840);
    bf16_t* Vt_s = (bf16_t*)(lds + 86272);
    bf16_t* A_s = (bf16_t*)(lds + 123136);
    float* fl_s = (float*)(lds + 132352);
    float* segs = (float*)(lds + 136448);
    bf16_t* zq = (bf16_t*)(P.ws + O_ZQ); const bf16_t* zk = (const bf16_t*)(P.ws + O_ZK); const bf16_t* zv = (const bf16_t*)(P.ws + O_ZV);
    const float* flow = (const float*)(P.ws + O_FLOW); float* dlast = (float*)(P.ws + O_DLAST); bf16_t* UT = (bf16_t*)(P.ws + O_UT); float* oin = P.out;
    for (int item = blockIdx.x; item < 1024; item += gridDim.x) {
        const int h = item & 3, bn = item >> 2, tok0 = bn * 64;
        const int d = tid & 127, tg = tid >> 7;
        for (int i = tid; i < 1024; i += 512) fl_s[i] = flow[(size_t)tok0 * 16 + i];
        float w2[16];
#pragma unroll
        for (int r = 0; r < 16; ++r) w2[r] = P.gla_wf2[r * 512 + h * 128 + d];
        const float bfd = P.gla_bf[h * 128 + d];
        __syncthreads();
        float g[16]; float run = 0.f;
#pragma unroll
        for (int j = 0; j < 16; ++j) {
            const int t = tg * 16 + j; float xv = bfd;
#pragma unroll
            for (int r = 0; r < 16; ++r) xv += fl_s[t * 16 + r] * w2[r];
            const float ls = fminf(xv, 0.f) - log1pf(__expf(-fabsf(xv)));
            run += ls * 0.0625f; g[j] = run;
#ifdef DBG_SCAN
            { int* fl = (int*)(P.ws + 240 * MBY); if (!(fabsf(fl_s[t * 16 + (j & 15)]) < 1e3f)) fl[40] = 1; if (!(fabsf(xv) < 1e30f)) fl[41] = 1; if (!(fabsf(ls) < 1e30f)) fl[42] = 1; }
#endif
        }
        segs[tg * 128 + d] = run;
        __syncthreads();
        float pre = 0.f, blast = 0.f;
#pragma unroll
        for (int s = 0; s < 4; ++s) { const float v = segs[s * 128 + d]; if (s < tg) pre += v; blast += v; }
#pragma unroll
        for (int j = 0; j < 16; ++j) {
            const int t = tg * 16 + j; const float bv = pre + g[j];
            const size_t gi = (size_t)(tok0 + t) * 512 + h * 128 + d;
            const float qv = bf2f(zq[gi]), kv = bf2f(zk[gi]);
            const float qb = qv * __expf(bv) * 0.08838834764831845f, kb = kv * __expf(-bv), kl = kv * __expf(blast - bv);
            const bf16_t qbb = f2bf(qb);
#ifdef DBG_SCAN
            { int* fl = (int*)(P.ws + 240 * MBY); if (!(fabsf(bv) < 1e30f)) fl[43] = 1; if (!(fabsf(kl) < 1e30f)) fl[44] = 1; if (!(fabsf(kb) < 1e30f)) fl[46] = 1; }
#endif
            Qb_s[t * 136 + d] = qbb; zq[gi] = qbb; Kb_s[t * 136 + d] = f2bf(kb); Klt_s[d * 72 + t] = f2bf(kl);
        }
        if (tg == 0) dlast[(size_t)item * 128 + d] = __expf(blast);
        {
            const int n = tid & 255, tg2 = tid >> 8;
#pragma unroll 8
            for (int j = 0; j < 32; ++j) { const int t = tg2 * 32 + j; Vt_s[n * 72 + t] = zv[(size_t)(tok0 + t) * 1024 + h * 256 + n]; }
        }
        __syncthreads();
        {
            const int mi = wid >> 1;
#pragma unroll
            for (int jj = 0; jj < 2; ++jj) {
                const int nj = (wid & 1) * 2 + jj;
                f32x4 acc = {0.f, 0.f, 0.f, 0.f};
                if (nj <= mi) {
#pragma unroll
                    for (int ks = 0; ks < 4; ++ks) {
                        const bf16x8 a = *(const bf16x8*)(Qb_s + (mi * 16 + c) * 136 + ks * 32 + kq * 8);
                        const bf16x8 bb = *(const bf16x8*)(Kb_s + (nj * 16 + c) * 136 + ks * 32 + kq * 8);
                        acc = mfma16(a, bb, acc);
                    }
                }
#pragma unroll
                for (int r = 0; r < 4; ++r) { const int i = mi * 16 + kq * 4 + r, jx = nj * 16 + c; A_s[i * 72 + jx] = f2bf(jx <= i ? acc[r] : 0.f); }
            }
        }
        __syncthreads();
        {
#pragma unroll
            for (int mt = 0; mt < 2; ++mt) {
                const int nt_ = wid * 2 + mt;
                bf16x8 afr[2];
#pragma unroll
                for (int ks = 0; ks < 2; ++ks) afr[ks] = *(const bf16x8*)(Vt_s + (nt_ * 16 + c) * 72 + ks * 32 + kq * 8);
#pragma unroll
                for (int it = 0; it < 4; ++it) {
                    f32x4 acc = {0.f, 0.f, 0.f, 0.f};
#pragma unroll
                    for (int ks = 0; ks < 2; ++ks) acc = mfma16(afr[ks], *(const bf16x8*)(A_s + (it * 16 + c) * 72 + ks * 32 + kq * 8), acc);
                    *(f32x4*)(oin + (size_t)(tok0 + it * 16 + c) * 1024 + h * 256 + nt_ * 16 + kq * 4) = acc;
                }
            }
            bf16x8 kfr[2];
#pragma unroll
            for (int ks = 0; ks < 2; ++ks) kfr[ks] = *(const bf16x8*)(Klt_s + (wid * 16 + c) * 72 + ks * 32 + kq * 8);
#pragma unroll 4
            for (int nt = 0; nt < 16; ++nt) {
                f32x4 acc = {0.f, 0.f, 0.f, 0.f};
#pragma unroll
                for (int ks = 0; ks < 2; ++ks) acc = mfma16(kfr[ks], *(const bf16x8*)(Vt_s + (nt * 16 + c) * 72 + ks * 32 + kq * 8), acc);
#ifdef DBG_SCAN
                { int* fl = (int*)(P.ws + 240 * MBY); if (!(fabsf(acc[0]) < 1e30f) || !(fabsf(acc[1]) < 1e30f) || !(fabsf(acc[2]) < 1e30f) || !(fabsf(acc[3]) < 1e30f)) fl[45] = 1; }
#endif
                u32x2 w; w.x = pk2(acc[0], acc[1]); w.y = pk2(acc[2], acc[3]);
                *(u32x2*)(UT + ((size_t)item * 256 + nt * 16 + c) * 128 + wid * 16 + kq * 4) = w;
            }
        }
        __syncthreads();
    }
}

__device__ void phase_gla2(const Params& P) {
    const int tid = threadIdx.x, wid = __builtin_amdgcn_readfirstlane(tid >> 6), lane = tid & 63, c = lane & 15, kq = lane >> 4;
    const bf16_t* zq = (const bf16_t*)(P.ws + O_ZQ); const float* dlast = (const float*)(P.ws + O_DLAST); const bf16_t* UT = (const bf16_t*)(P.ws + O_UT);
    float* oin = P.out; float* ssq = (float*)(P.ws + O_SSQ);
    for (int item = blockIdx.x; item < 256; item += gridDim.x) {
        const int b = item >> 5, h = (item >> 3) & 3, s = item & 7;
        const int mi = wid & 3, ni = wid >> 2, ncol = s * 32 + ni * 16;
        float S[4][8];
#pragma unroll
        for (int ks = 0; ks < 4; ++ks)
#pragma unroll
            for (int j = 0; j < 8; ++j) S[ks][j] = 0.f;
        for (int nc = 0; nc < 32; ++nc) {
            const int bn = b * 32 + nc, it = bn * 4 + h, tok = bn * 64 + mi * 16 + c;
            bf16x8 Qf[4]; u32x4 Uf[4]; f32x4 D0[4], D1[4];
            float* op = oin + (size_t)tok * 1024 + h * 256 + ncol + kq * 4;
            const f32x4 oi = *(const f32x4*)op;
#pragma unroll
            for (int ks = 0; ks < 4; ++ks) {
                Qf[ks] = *(const bf16x8*)(zq + (size_t)tok * 512 + h * 128 + ks * 32 + kq * 8);
                Uf[ks] = *(const u32x4*)(UT + ((size_t)it * 256 + ncol + c) * 128 + ks * 32 + kq * 8);
                D0[ks] = *(const f32x4*)(dlast + (size_t)it * 128 + ks * 32 + kq * 8);
                D1[ks] = *(const f32x4*)(dlast + (size_t)it * 128 + ks * 32 + kq * 8 + 4);
            }
            f32x4 acc = oi;
#pragma unroll
            for (int ks = 0; ks < 4; ++ks) {
                u32x4 w; w.x = pk2(S[ks][0], S[ks][1]); w.y = pk2(S[ks][2], S[ks][3]); w.z = pk2(S[ks][4], S[ks][5]); w.w = pk2(S[ks][6], S[ks][7]);
                acc = mfma16(__builtin_bit_cast(bf16x8, w), Qf[ks], acc);
            }
            *(f32x4*)op = acc;
            float ss = acc[0] * acc[0] + acc[1] * acc[1] + acc[2] * acc[2] + acc[3] * acc[3];
            ss += __shfl_xor(ss, 16); ss += __shfl_xor(ss, 32);
            if (kq == 0) ssq[((size_t)tok * 4 + h) * 16 + s * 2 + ni] = ss;
#pragma unroll
            for (int ks = 0; ks < 4; ++ks) {
                const u32x4 uu = Uf[ks];
                S[ks][0] = D0[ks][0] * S[ks][0] + bflo(uu.x); S[ks][1] = D0[ks][1] * S[ks][1] + bfhi(uu.x);
                S[ks][2] = D0[ks][2] * S[ks][2] + bflo(uu.y); S[ks][3] = D0[ks][3] * S[ks][3] + bfhi(uu.y);
                S[ks][4] = D1[ks][0] * S[ks][4] + bflo(uu.z); S[ks][5] = D1[ks][1] * S[ks][5] + bfhi(uu.z);
                S[ks][6] = D1[ks][2] * S[ks][6] + bflo(uu.w); S[ks][7] = D1[ks][3] * S[ks][7] + bfhi(uu.w);
            }
        }
    }
}

__device__ void phase_combine(const Params& P) {
    const float* oin = P.out; const float* ssq = (const float*)(P.ws + O_SSQ); const bf16_t* gr = (const bf16_t*)(P.ws + O_GR); bf16_t* ym = (bf16_t*)(P.ws + O_XB);
    for (int idx = blockIdx.x * 512 + threadIdx.x; idx < NTOK * 128; idx += gridDim.x * 512) {
        const int row = idx >> 7, col = (idx & 127) * 8, h = col >> 8;
        const f32x4* sp = (const f32x4*)(ssq + ((size_t)row * 4 + h) * 16);
        const f32x4 s0 = sp[0], s1 = sp[1], s2 = sp[2], s3 = sp[3];
        const float tot = (s0[0] + s0[1] + s0[2] + s0[3]) + (s1[0] + s1[1] + s1[2] + s1[3]) + (s2[0] + s2[1] + s2[2] + s2[3]) + (s3[0] + s3[1] + s3[2] + s3[3]);
        const float rs = rsqrtf(tot * (1.0f / 256.0f) + 1e-6f);
        const size_t gi = (size_t)row * 1024 + col;
        const f32x4 o0 = *(const f32x4*)(oin + gi), o1 = *(const f32x4*)(oin + gi + 4);
        const f32x4 n0 = *(const f32x4*)(P.gla_norm_g + col), n1 = *(const f32x4*)(P.gla_norm_g + col + 4);
        const u32x4 g = *(const u32x4*)(gr + gi), y = *(const u32x4*)(ym + gi);
        u32x4 w;
        w.x = pk2(bflo(y.x) + bflo(g.x) * (o0[0] * rs * n0[0]), bfhi(y.x) + bfhi(g.x) * (o0[1] * rs * n0[1]));
        w.y = pk2(bflo(y.y) + bflo(g.y) * (o0[2] * rs * n0[2]), bfhi(y.y) + bfhi(g.y) * (o0[3] * rs * n0[3]));
        w.z = pk2(bflo(y.z) + bflo(g.z) * (o1[0] * rs * n1[0]), bfhi(y.z) + bfhi(g.z) * (o1[1] * rs * n1[1]));
        w.w = pk2(bflo(y.w) + bflo(g.w) * (o1[2] * rs * n1[2]), bfhi(y.w) + bfhi(g.w) * (o1[3] * rs * n1[3]));
        *(u32x4*)(ym + gi) = w;
    }
}

__device__ void phase_ln1(const Params& P) {
    const int tid = threadIdx.x, wid = tid >> 6, lane = tid & 63;
    float* y = P.out; bf16_t* x1b = (bf16_t*)(P.ws + O_X1B);
    for (int row = blockIdx.x * 8 + wid; row < NTOK; row += gridDim.x * 8) {
        f32x4 v[4]; float s = 0.f;
#pragma unroll
        for (int i = 0; i < 4; ++i) { v[i] = *(const f32x4*)(y + (size_t)row * 1024 + i * 256 + lane * 4); s += (v[i][0] + v[i][1]) + (v[i][2] + v[i][3]); }
        const float mu = wave_sum(s) * (1.0f / 1024.0f);
        float q = 0.f;
#pragma unroll
        for (int i = 0; i < 4; ++i) { v[i] = v[i] - mu; q += (v[i][0] * v[i][0] + v[i][1] * v[i][1]) + (v[i][2] * v[i][2] + v[i][3] * v[i][3]); }
        const float rstd = rsqrtf(wave_sum(q) * (1.0f / 1024.0f) + 1e-5f);
#pragma unroll
        for (int i = 0; i < 4; ++i) {
            const int col = i * 256 + lane * 4;
            const f32x4 gg = *(const f32x4*)(P.ln1_g + col), bb = *(const f32x4*)(P.ln1_b + col);
            const f32x4 o = v[i] * rstd * gg + bb;
            *(f32x4*)(y + (size_t)row * 1024 + col) = o;
            u32x2 w; w.x = pk2(o[0], o[1]); w.y = pk2(o[2], o[3]);
            *(u32x2*)(x1b + (size_t)row * 1024 + col) = w;
        }
    }
    bf16_t* ub = (bf16_t*)(P.ws + O_UB);
    const int n4 = NTOK * 1024 / 4;
    for (int i = blockIdx.x * 512 + tid; i < 2 * n4; i += gridDim.x * 512) {
        const float* src = i < n4 ? P.peer_u + (size_t)i * 4 : P.peer_v + (size_t)(i - n4) * 4;
        const f32x4 a = *(const f32x4*)src;
        u32x2 w; w.x = pk2(a[0], a[1]); w.y = pk2(a[2], a[3]);
        *(u32x2*)(ub + (size_t)i * 4) = w;
    }
}

__device__ __forceinline__ int sortable(int bits) { return bits ^ ((bits >> 31) & 0x7fffffff); }
__device__ void phase_peer(const Params& P, unsigned char* lds) {
    const int tid = threadIdx.x, wid = __builtin_amdgcn_readfirstlane(tid >> 6), lane = tid & 63;
    int* ridx = (int*)lds;
    float* rgt = (float*)(lds + 33024);
    const float* qp = (const float*)(P.ws + O_QP); const bf16_t* x1b = (const bf16_t*)(P.ws + O_X1B);
    const bf16_t* ub = (const bf16_t*)(P.ws + O_UB); const bf16_t* vb = (const bf16_t*)(P.ws + O_VB); const bf16_t* ple = (const bf16_t*)(P.ws + O_PP);
    float* xo = P.out;
    for (int tile = blockIdx.x; tile < NTOK / 64; tile += gridDim.x) {
        const int tok0 = tile * 64;
#ifndef NO_ROUTE
        {
            const int token = tok0 + lane;
            int* Ls = (int*)(lds + 66048) + wid * 32 * 64 + lane;
#pragma unroll
            for (int p = 0; p < 2; ++p) {
                float q[64];
                const float* qr = qp + (size_t)token * 1024 + wid * 128 + p * 64;
#pragma unroll
                for (int i = 0; i < 16; ++i) { const f32x4 v = *(const f32x4*)(qr + i * 4); q[i * 4] = v[0]; q[i * 4 + 1] = v[1]; q[i * 4 + 2] = v[2]; q[i * 4 + 3] = v[3]; }
                int top[16];
#pragma unroll
                for (int i = 0; i < 16; ++i) top[i] = (int)0x80000000;
                const float* keys = P.peer_subkeys + (size_t)((wid * 2 + p) * 128) * 64;
#pragma unroll 1
                for (int k = 0; k < 128; ++k) {
                    const float* kr = keys + k * 64;
                    float s0 = 0.f, s1 = 0.f, s2 = 0.f, s3 = 0.f;
#pragma unroll
                    for (int cix = 0; cix < 64; cix += 4) { s0 = fmaf(q[cix], kr[cix], s0); s1 = fmaf(q[cix + 1], kr[cix + 1], s1); s2 = fmaf(q[cix + 2], kr[cix + 2], s2); s3 = fmaf(q[cix + 3], kr[cix + 3], s3); }
                    const float sc = (s0 + s1) + (s2 + s3);
                    int key = sortable((__float_as_int(sc) & ~127) | k);
#pragma unroll
                    for (int i = 0; i < 16; ++i) { const int hi = max(top[i], key); key = min(top[i], key); top[i] = hi; }
                }
#pragma unroll
                for (int i = 0; i < 16; ++i) Ls[(p * 16 + i) * 64] = top[i];
            }
            long long top2[16];
#pragma unroll
            for (int i = 0; i < 16; ++i) top2[i] = (long long)0x8000000000000000ull;
#pragma unroll 1
            for (int i = 0; i < 16; ++i) {
                const int b0 = sortable(Ls[i * 64]); const float va = __int_as_float(b0 & ~127); const int ia = (b0 & 127) * 128;
                const int jmax = 16 / (i + 1);
#pragma unroll 1
                for (int j = 0; j < jmax; ++j) {
                    const int b1 = sortable(Ls[(16 + j) * 64]);
                    const float sm = va + __int_as_float(b1 & ~127);
                    long long key = (long long)((((unsigned long long)(unsigned)sortable(__float_as_int(sm))) << 32) | (unsigned long long)(unsigned)(ia + (b1 & 127)));
#pragma unroll
                    for (int m = 0; m < 16; ++m) { const bool gt = key > top2[m]; const long long hi = gt ? key : top2[m]; key = gt ? top2[m] : key; top2[m] = hi; }
                }
            }
            float e[16]; float smax = __int_as_float(sortable((int)(top2[0] >> 32))); float den = 0.f;
#pragma unroll
            for (int m = 0; m < 16; ++m) { const float sv = __int_as_float(sortable((int)(top2[m] >> 32))); e[m] = __expf(sv - smax); den += e[m]; }
            const float inv = 1.0f / den;
#pragma unroll
            for (int m = 0; m < 16; ++m) { ridx[lane * 129 + wid * 16 + m] = (int)(unsigned)(top2[m] & 0xffffffffll); rgt[lane * 129 + wid * 16 + m] = e[m] * inv; }
        }
#endif
        __syncthreads();
#ifndef NO_GATHER
        {
            const int j = lane & 15, g = lane >> 4;
#pragma unroll 1
            for (int tt = 0; tt < 8; ++tt) {
                const int tl = wid * 8 + tt, token = tok0 + tl;
                u32x4 xr[8];
#pragma unroll
                for (int i = 0; i < 8; ++i) xr[i] = *(const u32x4*)(x1b + (size_t)token * 1024 + (j + 16 * i) * 8);
                float acc[64];
#pragma unroll
                for (int i = 0; i < 64; ++i) acc[i] = 0.f;
#pragma unroll 1
                for (int it = 0; it < 32; ++it) {
                    const int e = it * 4 + g;
                    const int idx = ridx[tl * 129 + e]; const float gate = rgt[tl * 129 + e];
                    const bf16_t* ur = ub + (size_t)idx * 1024 + j * 8; const bf16_t* vr = vb + (size_t)idx * 1024 + j * 8;
                    u32x4 uu[8], vv[8];
#pragma unroll
                    for (int i = 0; i < 8; ++i) uu[i] = *(const u32x4*)(ur + i * 128);
#pragma unroll
                    for (int i = 0; i < 8; ++i) vv[i] = *(const u32x4*)(vr + i * 128);
                    float d0 = 0.f, d1 = 0.f, d2 = 0.f, d3 = 0.f;
#pragma unroll
                    for (int i = 0; i < 8; ++i) { d0 = dot2bf(uu[i].x, xr[i].x, d0); d1 = dot2bf(uu[i].y, xr[i].y, d1); d2 = dot2bf(uu[i].z, xr[i].z, d2); d3 = dot2bf(uu[i].w, xr[i].w, d3); }
                    float dsum = (d0 + d1) + (d2 + d3);
                    dsum += __shfl_xor(dsum, 1); dsum += __shfl_xor(dsum, 2); dsum += __shfl_xor(dsum, 4); dsum += __shfl_xor(dsum, 8);
                    const float hid = 0.5f * dsum * (1.0f + erff(dsum * 0.70710678118f));
                    const float w = gate * hid;
#pragma unroll
                    for (int i = 0; i < 8; ++i) {
                        acc[i * 8 + 0] = fmaf(w, bflo(vv[i].x), acc[i * 8 + 0]); acc[i * 8 + 1] = fmaf(w, bfhi(vv[i].x), acc[i * 8 + 1]);
                        acc[i * 8 + 2] = fmaf(w, bflo(vv[i].y), acc[i * 8 + 2]); acc[i * 8 + 3] = fmaf(w, bfhi(vv[i].y), acc[i * 8 + 3]);
                        acc[i * 8 + 4] = fmaf(w, bflo(vv[i].z), acc[i * 8 + 4]); acc[i * 8 + 5] = fmaf(w, bfhi(vv[i].z), acc[i * 8 + 5]);
                        acc[i * 8 + 6] = fmaf(w, bflo(vv[i].w), acc[i * 8 + 6]); acc[i * 8 + 7] = fmaf(w, bfhi(vv[i].w), acc[i * 8 + 7]);
                    }
                }
#pragma unroll
                for (int i = 0; i < 64; ++i) { acc[i] += __shfl_xor(acc[i], 16); acc[i] += __shfl_xor(acc[i], 32); }
                float yv[16]; float s = 0.f;
#pragma unroll
                for (int ii = 0; ii < 2; ++ii) {
                    const int i = 2 * g + ii; const size_t col = (size_t)(j + 16 * i) * 8;
                    const f32x4 xa = *(const f32x4*)(xo + (size_t)token * 1024 + col), xb_ = *(const f32x4*)(xo + (size_t)token * 1024 + col + 4);
                    const u32x4 pw = *(const u32x4*)(ple + (size_t)token * 1024 + col);
                    float pv[8] = {bflo(pw.x), bfhi(pw.x), bflo(pw.y), bfhi(pw.y), bflo(pw.z), bfhi(pw.z), bflo(pw.w), bfhi(pw.w)};
#pragma unroll
                    for (int q = 0; q < 8; ++q) {
                        const float a_ = g == 0 ? acc[ii * 8 + q] : (g == 1 ? acc[16 + ii * 8 + q] : (g == 2 ? acc[32 + ii * 8 + q] : acc[48 + ii * 8 + q]));
                        const float xv = q < 4 ? xa[q] : xb_[q - 4];
                        const float yy = DN_ALPHA * xv + a_ + pv[q];
                        yv[ii * 8 + q] = yy; s += yy;
                    }
                }
                const float mu = wave_sum(s) * (1.0f / 1024.0f);
                float qq = 0.f;
#pragma unroll
                for (int q = 0; q < 16; ++q) { yv[q] -= mu; qq += yv[q] * yv[q]; }
                const float rstd = rsqrtf(wave_sum(qq) * (1.0f / 1024.0f) + 1e-5f);
#pragma unroll
                for (int ii = 0; ii < 2; ++ii) {
                    const int i = 2 * g + ii; const size_t col = (size_t)(j + 16 * i) * 8;
                    const float* lg = P.ln2_g; const float* lb = P.ln2_b; asm volatile("" : "+s"(lg), "+s"(lb));
                    const f32x4 g0 = *(const f32x4*)(lg + col), g1 = *(const f32x4*)(lg + col + 4), b0 = *(const f32x4*)(lb + col), b1 = *(const f32x4*)(lb + col + 4);
                    f32x4 o0, o1;
#pragma unroll
                    for (int q = 0; q < 4; ++q) { o0[q] = yv[ii * 8 + q] * rstd * g0[q] + b0[q]; o1[q] = yv[ii * 8 + 4 + q] * rstd * g1[q] + b1[q]; }
#ifdef NAN_GUARD
#pragma unroll
                    for (int q = 0; q < 4; ++q) { if (!(fabsf(o0[q]) < 1e30f)) o0[q] = 1000.f; if (!(fabsf(o1[q]) < 1e30f)) o1[q] = 1000.f; }
#endif
                    *(f32x4*)(xo + (size_t)token * 1024 + col) = o0; *(f32x4*)(xo + (size_t)token * 1024 + col + 4) = o1;
                }
            }
        }
#endif
        __syncthreads();
    }
}

__global__ void __launch_bounds__(512, 2) mega(Params P) {
    extern __shared__ __attribute__((aligned(16))) unsigned char shm[];
    cg::grid_group grid = cg::this_grid();
    PG8_LAS unsigned char* ldsg = (PG8_LAS unsigned char*)shm;
#ifdef ONLY
#define PH(i) ((i) == ONLY)
#else
#define PH(i) (P.ph_lo <= (i) && (i) < P.ph_hi)
#endif
#define SYNC() do { if (P.coop) grid.sync(); } while (0)
    if (PH(0)) { phase_prep(P, shm); SYNC(); }
    if (PH(1)) {
        pg8::Gemm g{(const bf16_t*)(P.ws + O_XB), (const bf16_t*)(P.ws + O_WINT), NTOK, 7168, 1024};
        pg8::StaticOrder S; S.init(NTOK, 7168, (int)gridDim.x, (int)blockIdx.x);
        EpiZ E{P.ws};
        pg8::gemm_phase<EpiZ, pg8::StaticOrder, false>(ldsg, g, S, E, nullptr);
        SYNC();
    }
    if (PH(2)) { phase_lru(P, shm); SYNC(); }
    if (PH(3)) { phase_gla1(P, shm); SYNC(); }
    if (PH(4)) { phase_gla2(P); SYNC(); }
    if (PH(5)) { phase_combine(P); SYNC(); }
    if (PH(6)) {
        {
            pg8::Gemm g{(const bf16_t*)(P.ws + O_XB), (const bf16_t*)(P.ws + O_WOUTT), NTOK, 1024, 1024};
            pg8::StaticOrder S; S.init(NTOK, 1024, (int)gridDim.x, (int)blockIdx.x);
            EpiY1 E{P.x, P.out};
            pg8::gemm_phase<EpiY1, pg8::StaticOrder, false>(ldsg, g, S, E, nullptr);
        }
        {
            pg8::Gemm g{(const bf16_t*)(P.ws + O_PB), (const bf16_t*)(P.ws + O_WPPT), NTOK, 1024, 256};
            pg8::StaticOrder S; S.init(NTOK, 1024, (int)gridDim.x, (int)blockIdx.x);
            EpiPP E{(bf16_t*)(P.ws + O_PP)};
            pg8::gemm_phase<EpiPP, pg8::StaticOrder, false>(ldsg, g, S, E, nullptr);
        }
        SYNC();
    }
    if (PH(7)) { phase_ln1(P); SYNC(); }
    if (PH(8)) {
        pg8::Gemm g{(const bf16_t*)(P.ws + O_X1B), (const bf16_t*)(P.ws + O_WQGT), NTOK, 2048, 1024};
        pg8::StaticOrder S; S.init(NTOK, 2048, (int)gridDim.x, (int)blockIdx.x);
        EpiQG E{(float*)(P.ws + O_QP), (bf16_t*)(P.ws + O_PP)};
        pg8::gemm_phase<EpiQG, pg8::StaticOrder, false>(ldsg, g, S, E, nullptr);
        SYNC();
    }
    if (PH(9)) { phase_peer(P, shm); }
#undef PH
#undef SYNC
}

#ifdef DBG_SCAN

__global__ void dbg_check(const void* p, size_t n, int is_bf16, int* flags, int code) {
    int bad = 0;
    if (is_bf16) { const unsigned short* q = (const unsigned short*)p; for (size_t i = (size_t)blockIdx.x * blockDim.x + threadIdx.x; i < n; i += (size_t)gridDim.x * blockDim.x) if ((q[i] & 0x7f80) == 0x7f80) bad = 1; }
    else { const unsigned* q = (const unsigned*)p; for (size_t i = (size_t)blockIdx.x * blockDim.x + threadIdx.x; i < n; i += (size_t)gridDim.x * blockDim.x) if ((q[i] & 0x7f800000u) == 0x7f800000u) bad = 1; }
    if (bad) flags[code] = 1;
}
__global__ void dbg_report(float* out, size_t n, const int* flags) {
    int code = 0; for (int c = 40; c < 64; ++c) if (flags[c]) { code = c; break; }
    if (!code) for (int c = 1; c < 40; ++c) if (flags[c]) { code = c; break; }
    for (size_t i = (size_t)blockIdx.x * blockDim.x + threadIdx.x; i < n; i += (size_t)gridDim.x * blockDim.x) out[i] = (i == 0) ? 1000.f * code : 0.f;
}
static void dbg_after_phase(int ph, const Params& P, hipStream_t stream) {
    int* flags = (int*)(P.ws + 240 * MBY);
    auto chk = [&](size_t off, size_t nelem, int bf, int code) { hipLaunchKernelGGL(dbg_check, dim3(1024), dim3(256), 0, stream, (const void*)(P.ws + off), nelem, bf, flags, code); };
    auto chko = [&](int code) { hipLaunchKernelGGL(dbg_check, dim3(1024), dim3(256), 0, stream, (const void*)P.out, (size_t)NTOK * 1024, 0, flags, code); };
    const size_t M1 = (size_t)NTOK * 1024, MH = (size_t)NTOK * 512;
    switch (ph) {
    case 0: chk(O_XB, M1, 1, 1); chk(O_FLOW, (size_t)NTOK * 16, 0, 2); chk(O_PB, (size_t)NTOK * 256, 1, 3); chk(O_WINT, (size_t)7168 * 1024, 1, 4); chk(O_WOUTT, (size_t)1024 * 1024, 1, 5); chk(O_WQGT, (size_t)2048 * 1024, 1, 6); chk(O_WPPT, (size_t)1024 * 256, 1, 7); break;
    case 1: chk(O_ZX, M1, 1, 8); chk(O_GY, M1, 1, 9); chk(O_ZQ, MH, 1, 10); chk(O_ZK, MH, 1, 11); chk(O_ZV, M1, 1, 12); chk(O_GR, M1, 1, 13); break;
    case 2: chk(O_XB, M1, 1, 14); break;
    case 3: chk(O_ZQ, MH, 1, 15); chk(O_UT, (size_t)1024 * 256 * 128, 1, 16); chko(17); chk(O_DLAST, (size_t)1024 * 128, 0, 18); break;
    case 4: chko(19); chk(O_SSQ, (size_t)NTOK * 64, 0, 20); break;
    case 5: chk(O_XB, M1, 1, 21); break;
    case 6: chko(22); chk(O_PP, M1, 1, 23); break;
    case 7: chko(24); chk(O_X1B, M1, 1, 25); chk(O_UB, 2 * M1, 1, 26); break;
    case 8: chk(O_QP, M1, 0, 27); chk(O_PP, M1, 1, 28); break;
    case 9: chko(29); break;
    }
}
#endif
#ifndef MULTI_LAUNCH
#define MULTI_LAUNCH 0
#endif
extern "C" void kernel_launch(void* const* d_in, const int* in_sizes, int n_in, void* d_out, int out_size, void* d_ws, size_t ws_size, hipStream_t stream) {
    static int grid = 0;
    if (grid == 0) {
        int dev = 0, cus = 0, per_cu = 0;
        hipGetDevice(&dev); hipDeviceGetAttribute(&cus, hipDeviceAttributeMultiprocessorCount, dev);
        if (hipFuncSetAttribute((const void*)mega, hipFuncAttributeMaxDynamicSharedMemorySize, LDS_BYTES) != hipSuccess) { fprintf(stderr, "hipFuncSetAttribute failed\n"); }
        hipOccupancyMaxActiveBlocksPerMultiprocessor(&per_cu, (const void*)mega, 512, LDS_BYTES);
        if (per_cu < 1) { fprintf(stderr, "occupancy query says %d\n", per_cu); per_cu = 1; }
        (void)hipGetLastError();
        grid = cus * 1;
        if (ws_size < 236 * MBY) fprintf(stderr, "workspace too small: %zu\n", ws_size);
    }
    Params P{};
    P.x = (const float*)d_in[0]; P.p = (const float*)d_in[1]; P.w_in = (const float*)d_in[2]; P.conv_w = (const float*)d_in[3]; P.conv_b = (const float*)d_in[4];
    P.lru_wr = (const float*)d_in[5]; P.lru_br = (const float*)d_in[6]; P.lru_wi = (const float*)d_in[7]; P.lru_bi = (const float*)d_in[8]; P.lru_lambda = (const float*)d_in[9];
    P.gla_wf2 = (const float*)d_in[10]; P.gla_bf = (const float*)d_in[11]; P.gla_norm_g = (const float*)d_in[12]; P.w_out = (const float*)d_in[13]; P.ln1_g = (const float*)d_in[14];
    P.ln1_b = (const float*)d_in[15]; P.peer_wq = (const float*)d_in[16]; P.peer_subkeys = (const float*)d_in[17]; P.peer_u = (const float*)d_in[18]; P.peer_v = (const float*)d_in[19];
    P.ple_gate_w = (const float*)d_in[20]; P.ple_proj_w = (const float*)d_in[21]; P.ln2_g = (const float*)d_in[22]; P.ln2_b = (const float*)d_in[23];
    P.out = (float*)d_out; P.ws = (unsigned char*)d_ws; P.pad_ = 0;
#if MULTI_LAUNCH
    for (int ph = 0; ph < 10; ++ph) {
        P.ph_lo = ph; P.ph_hi = ph + 1; P.coop = 0;
        hipLaunchKernelGGL(mega, dim3(grid), dim3(512), LDS_BYTES, stream, P);
#ifdef DBG_SCAN
        if (ph == 0) (void)hipMemsetAsync(P.ws + 240 * MBY, 0, 256, stream);
        dbg_after_phase(ph, P, stream);
#endif
    }
#ifdef DBG_SCAN
    hipLaunchKernelGGL(dbg_report, dim3(1024), dim3(256), 0, stream, P.out, (size_t)NTOK * 1024, (const int*)(P.ws + 240 * MBY));
#endif
#else
    P.ph_lo = 0; P.ph_hi = 10; P.coop = 1;
    void* args[] = {&P};
    hipError_t e = hipLaunchCooperativeKernel((const void*)mega, dim3(grid), dim3(512), args, LDS_BYTES, stream);
    if (e != hipSuccess) fprintf(stderr, "cooperative launch failed: %s (grid %d)\n", hipGetErrorString(e), grid);
#endif
}
```

```cpp
#define USE_XCD_BARRIER 1
#define HOST_MEMSET 1
#define PEER2 1
#define PEER3 1
#include <hip/hip_runtime.h>
#include <hip/hip_cooperative_groups.h>
#include <cstdio>
namespace cg = cooperative_groups;
namespace pg8 {
#define PG8_LAS __attribute__((address_space(3)))
typedef unsigned short bf16_t;
typedef short bf16x8 __attribute__((ext_vector_type(8)));
typedef float f32x4 __attribute__((ext_vector_type(4)));
typedef unsigned u32x4 __attribute__((ext_vector_type(4)));
constexpr int BM = 256, BK = 64, HALF = 128, HTB = HALF * BK * 2  , STAGE_BYTES = 8 * HTB, NXCD = 8, WGM = 8;

__host__ __device__ __forceinline__ int lds_byte(int r, int c) { const int st = (r >> 4) * 2 + (c >> 5), rr = r & 15, cc = c & 31, ob = rr * 64 + cc * 2; return st * 1024 + (ob ^ (((ob >> 9) & 1) << 5)); }
__host__ __device__ __forceinline__ void stage_rc(int b, int& R, int& C) { const int st = b / 1024, sb = b % 1024, swz = sb ^ (((sb >> 9) & 1) << 5); R = (st >> 1) * 16 + swz / 64; C = (st & 1) * 32 + (swz % 64) / 2; }
__host__ __device__ __forceinline__ int perm32(int rho) { const int n = rho >> 4, i = rho & 15; return 8 * (i >> 2) + 4 * n + (i & 3); }

struct Unit { int pm, pn; };
struct Gemm { const bf16_t* A; const bf16_t* Bt; int M, N, K; };

struct StaticOrder {
    int nM, nN, nwg, G, c;
    __host__ __device__ void init(int M, int N, int G_, int c_) { nM = M / BM; nN = N / BM; nwg = nM * nN; G = G_; c = c_; }
    __host__ __device__ bool next(int i, Unit& u) const {
        const long L = (long)i * G + c; if (L >= nwg) return false;
        int wgid = (int)L; { const int q = nwg / NXCD, r = nwg % NXCD, xcd = wgid % NXCD, off = wgid / NXCD; wgid = (xcd < r ? xcd * (q + 1) : r * (q + 1) + (xcd - r) * q) + off; }
        const int nig = WGM * nN, gid = wgid / nig, fm = gid * WGM, gsz = (nM - fm) < WGM ? (nM - fm) : WGM;
        u.pm = fm + ((wgid % nig) % gsz); u.pn = (wgid % nig) / gsz; return true;
    }
    __device__ __forceinline__ void a_ready(const Unit&) const {}
    __device__ __forceinline__ void done(const Unit&) const {}
};
struct CountedOrder : StaticOrder {
    const unsigned* ready; unsigned need; unsigned* tmo;
    __device__ __forceinline__ void a_ready(const Unit& u) const {
        if (threadIdx.x < 64) {
            const unsigned long long t0 = __builtin_amdgcn_s_memrealtime(); unsigned polls = 0;
            while ((unsigned)__builtin_amdgcn_readfirstlane(__hip_atomic_load(ready + 64 * u.pm, __ATOMIC_RELAXED, __HIP_MEMORY_SCOPE_AGENT)) < need) {
                if ((++polls & 255u) == 0u && __builtin_amdgcn_readfirstlane(__hip_atomic_load(tmo, __ATOMIC_RELAXED, __HIP_MEMORY_SCOPE_AGENT)) != 0u) break;
                if (__builtin_amdgcn_s_memrealtime() - t0 > 2000000ull) {
                    if (threadIdx.x == 0) { unsigned expect = 0u; __hip_atomic_compare_exchange_strong(tmo + 1, &expect, 0x600u | (unsigned)(u.pm & 0xff), __ATOMIC_RELAXED, __ATOMIC_RELAXED, __HIP_MEMORY_SCOPE_AGENT); __hip_atomic_store(tmo, 1u, __ATOMIC_RELAXED, __HIP_MEMORY_SCOPE_AGENT); }
                    break; }
                __builtin_amdgcn_s_sleep(2); }
            __builtin_amdgcn_fence(__ATOMIC_ACQUIRE, "agent");
            asm volatile("s_waitcnt vmcnt(0)" ::: "memory");
        }
#if !defined(BROKEN_HOOK_NO_BARRIER)
        asm volatile("" ::: "memory"); __builtin_amdgcn_s_barrier(); asm volatile("" ::: "memory");
#endif
    }
};

__device__ __forceinline__ unsigned cvt_pk_bf16(float lo, float hi) { unsigned r; asm volatile("v_cvt_pk_bf16_f32 %0, %1, %2" : "=v"(r) : "v"(lo), "v"(hi)); return r; }
typedef float f32x2 __attribute__((ext_vector_type(2)));
__device__ __forceinline__ f32x2 gelu_pk(f32x2 v) {
    const f32x2 av = __builtin_elementwise_abs(v), d = av * 0.2316418882f + 1.0f;
    f32x2 t; t.x = __builtin_amdgcn_rcpf(d.x); t.y = __builtin_amdgcn_rcpf(d.y);
    f32x2 q = t * 0.5307027145f + (-0.7265760135f); q = q * t + 0.7107068705f; q = q * t + (-0.142248368f); q = q * t + 0.127414796f; q = q * t;
    const f32x2 s = (v * v) * (-0.72134752044f);
    f32x2 e; e.x = __builtin_amdgcn_exp2f(s.x); e.y = __builtin_amdgcn_exp2f(s.y);
    const f32x2 m = v * (q * e), r = v - m;
    f32x2 o; o.x = v.x < 0.f ? m.x : r.x; o.y = v.y < 0.f ? m.y : r.y; return o;
}
template <class Epi, class Sched, bool STAMP = false>
__device__ __forceinline__ void gemm_phase(PG8_LAS unsigned char* lds, const Gemm g, const Sched& S, const Epi& E, unsigned long long* stamps) {
    const int tid = threadIdx.x, wid = __builtin_amdgcn_readfirstlane(tid >> 6), lane = tid & 63, wr = wid >> 2, wc = wid & 3, fr = lane & 15, fq = lane >> 4;
    const int K = g.K, nt = K / BK;
    int ts_lo = 0, ts_hi = 0, nts = 0; const unsigned long long rt_entry = STAMP ? (unsigned long long)wall_clock64() : 0ull;
#define PG8_STAMP() do { if (STAMP && wid == 0 && nts < 64) { const unsigned long long _c = (unsigned long long)clock64(); \
        ts_lo = (lane == nts) ? (int)(unsigned)_c : ts_lo; ts_hi = (lane == nts) ? (int)(unsigned)(_c >> 32) : ts_hi; ++nts; } } while (0)
    PG8_STAMP();
    unsigned voffA[2], voffB[2];
#pragma unroll
    for (int i = 0; i < 2; ++i) { int R, C; stage_rc(tid * 16 + i * 8192, R, C); const int Rb = Epi::PERM ? ((R & ~31) + perm32(R & 31)) : R;
        voffA[i] = (unsigned)(R * K + C) * 2u; voffB[i] = (unsigned)(Rb * K + C) * 2u; }
    const size_t kstep = (size_t)(BK * 2);
    const size_t hstep = (size_t)HALF * K * 2;
    const size_t tstep = 2 * hstep;
    const unsigned ldsw = (unsigned)wid * 1024u;
    const int aoff = lds_byte(wr * 64 + fr, fq * 8), boff = lds_byte(wc * 32 + fr, fq * 8);
#define PG8_SA(b, h) (((b) * 2 + (h)) * HTB)
#define PG8_SB(b, h) ((4 + (b) * 2 + (h)) * HTB)
#define PG8_STAGE(bufoff, gbase, voff) do { _Pragma("unroll") for (int _i = 0; _i < 2; ++_i) \
        __builtin_amdgcn_global_load_lds((const unsigned*)((const char*)(gbase) + (voff)[_i]), (PG8_LAS unsigned*)(lds + (bufoff) + ldsw + _i * 8192), 16, 0, 0); } while (0)
#define PG8_LDA(dst, b, h) do { _Pragma("unroll") for (int m = 0; m < 4; ++m) _Pragma("unroll") for (int k = 0; k < 2; ++k) dst[m][k] = *(const PG8_LAS bf16x8*)(lds + PG8_SA(b, h) + aoff + m * 2048 + k * 1024); } while (0)
#define PG8_LDB(dst, b, h) do { _Pragma("unroll") for (int n = 0; n < 2; ++n) _Pragma("unroll") for (int k = 0; k < 2; ++k) dst[n][k] = *(const PG8_LAS bf16x8*)(lds + PG8_SB(b, h) + boff + n * 2048 + k * 1024); } while (0)
#define PG8_MMA(ai, bj, At, Bt) do { __builtin_amdgcn_s_setprio(1); _Pragma("unroll") for (int m = 0; m < 4; ++m) _Pragma("unroll") for (int n = 0; n < 2; ++n) _Pragma("unroll") for (int k = 0; k < 2; ++k) \
        acc[ai][bj][m][n] = __builtin_amdgcn_mfma_f32_16x16x32_bf16(Bt[n][k], At[m][k], acc[ai][bj][m][n], 0, 0, 0); __builtin_amdgcn_s_setprio(0); } while (0)
#define PG8_WAIT_V(n) asm volatile("s_waitcnt vmcnt(" #n ")" ::: "memory")
#define PG8_WAIT_L(n) asm volatile("s_waitcnt lgkmcnt(" #n ")" ::: "memory")
#define PG8_BAR __builtin_amdgcn_s_barrier()
#define PG8_SCHED __builtin_amdgcn_sched_barrier(0)
    Unit cur, nxt; int ui = 0;
    if (!S.next(0, cur)) return;
    f32x4 acc[2][2][4][2];
#pragma unroll
    for (int a = 0; a < 2; ++a)
#pragma unroll
        for (int b = 0; b < 2; ++b)
#pragma unroll
            for (int m = 0; m < 4; ++m)
#pragma unroll
                for (int n = 0; n < 2; ++n) acc[a][b][m][n] = (f32x4){0.f, 0.f, 0.f, 0.f};
    bf16x8 At[4][2], B0[2][2], B1[2][2];
    const char* cA = (const char*)g.A + (size_t)cur.pm * tstep; const char* cB = (const char*)g.Bt + (size_t)cur.pn * tstep;
    S.a_ready(cur);
    PG8_STAGE(PG8_SB(0, 0), cB, voffB); PG8_STAGE(PG8_SA(0, 0), cA, voffA); PG8_STAGE(PG8_SB(0, 1), cB + hstep, voffB); PG8_STAGE(PG8_SA(0, 1), cA + hstep, voffA);
    if (wr == 1) PG8_BAR;
    PG8_WAIT_V(4); PG8_BAR;
    PG8_STAGE(PG8_SB(1, 0), cB + kstep, voffB); PG8_STAGE(PG8_SA(1, 0), cA + kstep, voffA); PG8_STAGE(PG8_SB(1, 1), cB + hstep + kstep, voffB);
    PG8_WAIT_V(6); PG8_BAR;
    PG8_STAMP();
    for (;;) {
        const bool has_next = S.next(ui + 1, nxt);
        const char* nA = has_next ? (const char*)g.A + (size_t)nxt.pm * tstep : cA; const char* nB = has_next ? (const char*)g.Bt + (size_t)nxt.pn * tstep : cB;
        for (int t = 0; t < nt; t += 2) {
            const bool last = (t == nt - 2);
            const char* a1 = cA + (size_t)(t + 1) * kstep;
            const char* a2 = last ? nA : cA + (size_t)(t + 2) * kstep; const char* b2 = last ? nB : cB + (size_t)(t + 2) * kstep;
            const char* a3 = a2 + kstep; const char* b3 = b2 + kstep;
            if (last && has_next) S.a_ready(nxt);
            PG8_LDB(B0, 0, 0); PG8_SCHED; PG8_LDA(At, 0, 0); PG8_STAGE(PG8_SA(1, 1), a1 + hstep, voffA);
            PG8_WAIT_L(8); PG8_BAR; PG8_WAIT_L(0); PG8_MMA(0, 0, At, B0); PG8_BAR; PG8_SCHED;
            PG8_LDB(B1, 0, 1); PG8_STAGE(PG8_SB(0, 0), b2, voffB);
            PG8_BAR; PG8_WAIT_L(0); PG8_MMA(0, 1, At, B1); PG8_BAR;
            PG8_LDA(At, 0, 1); PG8_STAGE(PG8_SA(0, 0), a2, voffA);
            PG8_BAR; PG8_WAIT_L(0); PG8_MMA(1, 0, At, B0); PG8_BAR; PG8_SCHED;
            PG8_STAGE(PG8_SB(0, 1), b2 + hstep, voffB);
            PG8_WAIT_V(6); PG8_BAR; PG8_MMA(1, 1, At, B1); PG8_BAR;
            PG8_LDB(B0, 1, 0); PG8_SCHED; PG8_LDA(At, 1, 0); PG8_STAGE(PG8_SA(0, 1), a2 + hstep, voffA);
            PG8_WAIT_L(8); PG8_BAR; PG8_WAIT_L(0); PG8_MMA(0, 0, At, B0); PG8_BAR; PG8_SCHED;
            PG8_LDB(B1, 1, 1); PG8_STAGE(PG8_SB(1, 0), b3, voffB);
            PG8_BAR; PG8_WAIT_L(0); PG8_MMA(0, 1, At, B1); PG8_BAR;
            PG8_LDA(At, 1, 1); PG8_STAGE(PG8_SA(1, 0), a3, voffA);
            PG8_BAR; PG8_WAIT_L(0); PG8_MMA(1, 0, At, B0); PG8_BAR; PG8_SCHED;
            PG8_STAGE(PG8_SB(1, 1), b3 + hstep, voffB);
            PG8_WAIT_V(6); PG8_BAR; PG8_MMA(1, 1, At, B1); PG8_BAR;
        }
        PG8_STAMP();
        if constexpr (!Epi::AFTER_DRAIN) { E(acc, cur, wr, wc, fr, fq); S.done(cur); }
        PG8_STAMP();
        if (!has_next) break;
#pragma unroll
        for (int a = 0; a < 2; ++a)
#pragma unroll
            for (int b = 0; b < 2; ++b)
#pragma unroll
                for (int m = 0; m < 4; ++m)
#pragma unroll
                    for (int n = 0; n < 2; ++n) acc[a][b][m][n] = (f32x4){0.f, 0.f, 0.f, 0.f};
        cur = nxt; cA = nA; cB = nB; ++ui;
    }
    PG8_WAIT_V(0);
    if (wr == 0) PG8_BAR;
    PG8_BAR;
    if constexpr (Epi::AFTER_DRAIN) { E.fused(acc, cur, wr, wc, fr, fq, lds, wid, lane); S.done(cur); }
    PG8_STAMP();
    if (STAMP && wid == 0) { stamps[lane] = lane < nts ? (((unsigned long long)(unsigned)ts_hi << 32) | (unsigned)ts_lo) : 0ull;
        if (lane == 62) stamps[62] = rt_entry; if (lane == 63) stamps[63] = (unsigned long long)wall_clock64(); }
#undef PG8_STAMP
#undef PG8_SA
#undef PG8_SB
#undef PG8_STAGE
#undef PG8_LDA
#undef PG8_LDB
#undef PG8_MMA
#undef PG8_WAIT_V
#undef PG8_WAIT_L
#undef PG8_BAR
#undef PG8_SCHED
}
}

using pg8::bf16_t; using pg8::bf16x8; using pg8::f32x4; using pg8::u32x4; using pg8::f32x2; using pg8::Unit;
typedef __bf16 bf16x2_t __attribute__((ext_vector_type(2)));
__device__ __forceinline__ float dpp_xor1(float v) { return __int_as_float(__builtin_amdgcn_update_dpp(0, __float_as_int(v), 0xB1, 0xF, 0xF, true)); }
__device__ __forceinline__ float dpp_xor2(float v) { return __int_as_float(__builtin_amdgcn_update_dpp(0, __float_as_int(v), 0x4E, 0xF, 0xF, true)); }
__device__ __forceinline__ float dpp_xor4(float v) { const int m = __builtin_amdgcn_update_dpp(0, __float_as_int(v), 0x141, 0xF, 0xF, true); return __int_as_float(__builtin_amdgcn_update_dpp(0, m, 0x1B, 0xF, 0xF, true)); }
__device__ __forceinline__ float dpp_xor8(float v) { return __int_as_float(__builtin_amdgcn_update_dpp(0, __float_as_int(v), 0x128, 0xF, 0xF, true)); }
typedef unsigned u32x2 __attribute__((ext_vector_type(2)));

constexpr int NTOK = 16384, DM = 1024, SEQL = 2048;
constexpr int INW = 7184;
constexpr size_t MBY = (size_t)1 << 20;
constexpr size_t O_ZX = 0, O_GY = 32 * MBY, O_ZQ = 64 * MBY, O_ZK = 80 * MBY, O_ZV = 96 * MBY, O_GR = 128 * MBY, O_XB = 160 * MBY,
                 O_WINT = 192 * MBY, O_WOUTT = 228 * MBY, O_WQGT = 230 * MBY, O_WPPT = 234 * MBY, O_PB = 235 * MBY, O_FLOW = 243 * MBY,
                 O_DLAST = 244 * MBY, O_SSQ = 245 * MBY;
constexpr size_t O_UT = 0, O_UB = 192 * MBY  , O_VB = 208 * MBY, O_X1B = 64 * MBY, O_PP = 96 * MBY, O_QP = 128 * MBY;
constexpr int LDS_BYTES = 160 * 1024;
constexpr size_t O_RIDX = 0, O_RW = 8 * MBY, O_RG = 16 * MBY  , O_FF = 128 * MBY, O_PART = 128 * MBY  ;
constexpr float DN_ALPHA = 1.189207115002721f;

struct Params {
    const float* x; const float* p; const float* w_in; const float* conv_w; const float* conv_b; const float* lru_wr; const float* lru_br;
    const float* lru_wi; const float* lru_bi; const float* lru_lambda; const float* gla_wf2; const float* gla_bf; const float* gla_norm_g;
    const float* w_out; const float* ln1_g; const float* ln1_b; const float* peer_wq; const float* peer_subkeys; const float* peer_u;
    const float* peer_v; const float* ple_gate_w; const float* ple_proj_w; const float* ln2_g; const float* ln2_b;
    float* out; unsigned char* ws; int ph_lo, ph_hi, coop, pad_;
};

__device__ __forceinline__ bf16_t f2bf(float f) { unsigned u = __float_as_uint(f); u += 0x7FFFu + ((u >> 16) & 1u); return (bf16_t)(u >> 16); }
__device__ __forceinline__ float bf2f(bf16_t b) { return __uint_as_float(((unsigned)b) << 16); }
__device__ __forceinline__ float bflo(unsigned w) { return __uint_as_float(w << 16); }
__device__ __forceinline__ float bfhi(unsigned w) { return __uint_as_float(w & 0xffff0000u); }
__device__ __forceinline__ unsigned pk2(float lo, float hi) { typedef float f2_t __attribute__((ext_vector_type(2))); f2_t v = {lo, hi}; return __builtin_bit_cast(unsigned, __builtin_convertvector(v, bf16x2_t)); }
__device__ __forceinline__ float sigmoidf_(float x) { return __builtin_amdgcn_rcpf(1.0f + __expf(-x)); }
__device__ __forceinline__ f32x4 mfma16(bf16x8 a, bf16x8 b, f32x4 c) { return __builtin_amdgcn_mfma_f32_16x16x32_bf16(a, b, c, 0, 0, 0); }
__device__ __forceinline__ float dot2bf(unsigned a, unsigned b, float c) { return __builtin_amdgcn_fdot2_f32_bf16(__builtin_bit_cast(bf16x2_t, a), __builtin_bit_cast(bf16x2_t, b), c, false); }
__device__ __forceinline__ float wave_sum(float v) {
#pragma unroll
    for (int o = 32; o >= 1; o >>= 1) v += __shfl_xor(v, o);
    return v;
}

struct EpiZ {
    static constexpr bool PERM = true, AFTER_DRAIN = false;
    unsigned char* ws;
    __device__ __forceinline__ void operator()(const f32x4 (&acc)[2][2][4][2], const Unit& u, int wr, int wc, int fr, int fq) const {
        const int pn = u.pn; const int row0 = u.pm * 256 + wr * 64 + fr;
        const bool pairA = (pn >= 4 && pn < 12), pairB = (pn >= 20);
        if (pairA || pairB) {
            const int j = pairA ? pn - 4 : pn - 20;
            bf16_t* base = (bf16_t*)(ws + (pairA ? O_GY : O_GR));
            const int col = j * 128 + wc * 32 + 8 * fq;
#pragma unroll
            for (int ai = 0; ai < 2; ++ai)
#pragma unroll
                for (int m = 0; m < 4; ++m) {
                    const f32x4 a0 = acc[ai][0][m][0], a1 = acc[ai][0][m][1], g0 = acc[ai][1][m][0], g1 = acc[ai][1][m][1];
                    float o[8];
                    if (pairA) {
                        f32x2 e0 = pg8::gelu_pk((f32x2){a0[0], a0[1]}), e1 = pg8::gelu_pk((f32x2){a0[2], a0[3]}), e2 = pg8::gelu_pk((f32x2){a1[0], a1[1]}), e3 = pg8::gelu_pk((f32x2){a1[2], a1[3]});
                        o[0] = e0.x; o[1] = e0.y; o[2] = e1.x; o[3] = e1.y; o[4] = e2.x; o[5] = e2.y; o[6] = e3.x; o[7] = e3.y;
                    } else {
#pragma unroll
                        for (int q = 0; q < 4; ++q) { o[q] = a0[q] * sigmoidf_(a0[q]); o[4 + q] = a1[q] * sigmoidf_(a1[q]); }
                    }
#pragma unroll
                    for (int q = 0; q < 4; ++q) { o[q] *= sigmoidf_(g0[q]); o[4 + q] *= sigmoidf_(g1[q]); }
                    u32x4 w; w.x = pk2(o[0], o[1]); w.y = pk2(o[2], o[3]); w.z = pk2(o[4], o[5]); w.w = pk2(o[6], o[7]);
                    *(u32x4*)(base + (size_t)(row0 + ai * 128 + m * 16) * 1024 + col) = w;
                }
        } else {
            bf16_t* base; int ldc, colt;
            if (pn < 4) { base = (bf16_t*)(ws + O_ZX); ldc = 1024; colt = pn * 256; }
            else if (pn < 14) { base = (bf16_t*)(ws + O_ZQ); ldc = 512; colt = (pn - 12) * 256; }
            else if (pn < 16) { base = (bf16_t*)(ws + O_ZK); ldc = 512; colt = (pn - 14) * 256; }
            else { base = (bf16_t*)(ws + O_ZV); ldc = 1024; colt = (pn - 16) * 256; }
            const int col0 = colt + wc * 32 + 8 * fq;
#pragma unroll
            for (int ai = 0; ai < 2; ++ai)
#pragma unroll
                for (int m = 0; m < 4; ++m) {
                    bf16_t* rowp = base + (size_t)(row0 + ai * 128 + m * 16) * ldc + col0;
#pragma unroll
                    for (int bj = 0; bj < 2; ++bj) {
                        const f32x4 v0 = acc[ai][bj][m][0], v1 = acc[ai][bj][m][1];
                        u32x4 w; w.x = pk2(v0[0], v0[1]); w.y = pk2(v0[2], v0[3]); w.z = pk2(v1[0], v1[1]); w.w = pk2(v1[2], v1[3]);
                        *(u32x4*)(rowp + bj * 128) = w;
                    }
                }
        }
    }
};
struct EpiPP {
    static constexpr bool PERM = true, AFTER_DRAIN = false;
    bf16_t* O;
    __device__ __forceinline__ void operator()(const f32x4 (&acc)[2][2][4][2], const Unit& u, int wr, int wc, int fr, int fq) const {
        const int row0 = u.pm * 256 + wr * 64 + fr, col0 = u.pn * 256 + wc * 32 + 8 * fq;
#pragma unroll
        for (int ai = 0; ai < 2; ++ai)
#pragma unroll
            for (int m = 0; m < 4; ++m) {
                bf16_t* rowp = O + (size_t)(row0 + ai * 128 + m * 16) * 1024 + col0;
#pragma unroll
                for (int bj = 0; bj < 2; ++bj) {
                    const f32x4 v0 = acc[ai][bj][m][0], v1 = acc[ai][bj][m][1];
                    u32x4 w; w.x = pk2(v0[0], v0[1]); w.y = pk2(v0[2], v0[3]); w.z = pk2(v1[0], v1[1]); w.w = pk2(v1[2], v1[3]);
                    *(u32x4*)(rowp + bj * 128) = w;
                }
            }
    }
};
struct EpiY1 {
    static constexpr bool PERM = false, AFTER_DRAIN = false;
    const float* X; float* Y;
    __device__ __forceinline__ void operator()(const f32x4 (&acc)[2][2][4][2], const Unit& u, int wr, int wc, int fr, int fq) const {
        const int row0 = u.pm * 256 + wr * 64 + fr, col0 = u.pn * 256 + wc * 32 + 4 * fq;
#pragma unroll
        for (int ai = 0; ai < 2; ++ai)
#pragma unroll
            for (int m = 0; m < 4; ++m) {
                const size_t ro = (size_t)(row0 + ai * 128 + m * 16) * 1024 + col0;
#pragma unroll
                for (int bj = 0; bj < 2; ++bj)
#pragma unroll
                    for (int n = 0; n < 2; ++n) {
                        const f32x4 xv = *(const f32x4*)(X + ro + bj * 128 + n * 16);
                        *(f32x4*)(Y + ro + bj * 128 + n * 16) = xv * DN_ALPHA + acc[ai][bj][m][n];
                    }
            }
    }
};
struct EpiQG {
    static constexpr bool PERM = false, AFTER_DRAIN = false;
    float* QP; bf16_t* PP;
    __device__ __forceinline__ void operator()(const f32x4 (&acc)[2][2][4][2], const Unit& u, int wr, int wc, int fr, int fq) const {
        const int row0 = u.pm * 256 + wr * 64 + fr; const int pn = u.pn;
        const int col0 = (pn & 3) * 256 + wc * 32 + 4 * fq;
#pragma unroll
        for (int ai = 0; ai < 2; ++ai)
#pragma unroll
            for (int m = 0; m < 4; ++m) {
                const size_t ro = (size_t)(row0 + ai * 128 + m * 16) * 1024 + col0;
#pragma unroll
                for (int bj = 0; bj < 2; ++bj)
#pragma unroll
                    for (int n = 0; n < 2; ++n) {
                        const f32x4 a = acc[ai][bj][m][n];
                        if (pn < 4) { *(f32x4*)(QP + ro + bj * 128 + n * 16) = a; }
                        else {
                            u32x2* pp = (u32x2*)(PP + ro + bj * 128 + n * 16);
                            const u32x2 w = *pp;
                            u32x2 o; o.x = pk2(sigmoidf_(a[0]) * bflo(w.x), sigmoidf_(a[1]) * bfhi(w.x)); o.y = pk2(sigmoidf_(a[2]) * bflo(w.y), sigmoidf_(a[3]) * bfhi(w.y));
                            *pp = o;
                        }
                    }
            }
    }
};

__device__ __forceinline__ int win_src_col(int n) {
    if (n < 1024) return n;
    if (n < 3072) { const int j = (n - 1024) >> 8, r = (n - 1024) & 255; return r < 128 ? 1024 + j * 128 + r : 5136 + j * 128 + (r - 128); }
    if (n < 3584) return 2048 + (n - 3072);
    if (n < 4096) return 2560 + (n - 3584);
    if (n < 5120) return 3072 + (n - 4096);
    { const int j = (n - 5120) >> 8, r = (n - 5120) & 255; return r < 128 ? 4096 + j * 128 + r : 6160 + j * 128 + (r - 128); }
}
__device__ void phase_prep(const Params& P, unsigned char* lds) {
    const int tid = threadIdx.x, wid = tid >> 6, lane = tid & 63;
    bf16_t* wf = (bf16_t*)lds;
    float* ts = (float*)(lds + 34816);
    for (int i = tid; i < 16 * 1024; i += 512) { const int r = i & 15, k = i >> 4; wf[r * 1032 + k] = f2bf(P.w_in[(size_t)k * INW + 5120 + r]); }
    __syncthreads();
    bf16_t* xb = (bf16_t*)(P.ws + O_XB); float* flow = (float*)(P.ws + O_FLOW);
    if (wid < 4) {
        for (int tile = wid * gridDim.x + blockIdx.x; tile < 1024; tile += 4 * gridDim.x) {
            const int c = lane & 15, kq = lane >> 4; const int row = tile * 16 + c;
            f32x4 acc = {0.f, 0.f, 0.f, 0.f};
            const float* xr = P.x + (size_t)row * 1024 + kq * 8;
#pragma unroll 4
            for (int ks = 0; ks < 32; ++ks) {
                const f32x4 a0 = *(const f32x4*)(xr + ks * 32), a1 = *(const f32x4*)(xr + ks * 32 + 4);
                u32x4 w; w.x = pk2(a0[0], a0[1]); w.y = pk2(a0[2], a0[3]); w.z = pk2(a1[0], a1[1]); w.w = pk2(a1[2], a1[3]);
                *(u32x4*)(xb + (size_t)row * 1024 + ks * 32 + kq * 8) = w;
                const bf16x8 bfr = *(const bf16x8*)(wf + c * 1032 + ks * 32 + kq * 8);
                acc = mfma16(__builtin_bit_cast(bf16x8, w), bfr, acc);
            }
#pragma unroll
            for (int i = 0; i < 4; ++i) flow[(size_t)(tile * 16 + kq * 4 + i) * 16 + c] = acc[i];
        }
    } else {
        bf16_t* pb = (bf16_t*)(P.ws + O_PB);
        const int nthr = 4 * 64 * gridDim.x;
        for (int i = ((wid - 4) * gridDim.x + blockIdx.x) * 64 + lane; i < NTOK * 256 / 4; i += nthr) {
            const f32x4 a = *(const f32x4*)(P.p + (size_t)i * 4);
            u32x2 w; w.x = pk2(a[0], a[1]); w.y = pk2(a[2], a[3]);
            *(u32x2*)(pb + (size_t)i * 4) = w;
        }
    }
    for (int job = blockIdx.x; job < 2624; job += gridDim.x) {
        const float* W; bf16_t* O; int ldw, Kd, tn, tk, mode;
        if (job < 1792) { W = P.w_in; O = (bf16_t*)(P.ws + O_WINT); ldw = INW; Kd = 1024; tn = job >> 4; tk = job & 15; mode = 0; }
        else if (job < 2048) { const int j = job - 1792; W = P.w_out; O = (bf16_t*)(P.ws + O_WOUTT); ldw = 1024; Kd = 1024; tn = j >> 4; tk = j & 15; mode = 1; }
        else if (job < 2560) { const int j = job - 2048; tn = j >> 4; tk = j & 15; mode = 2; ldw = 1024; Kd = 1024; O = (bf16_t*)(P.ws + O_WQGT); W = tn < 16 ? P.peer_wq : P.ple_gate_w; }
        else { const int j = job - 2560; W = P.ple_proj_w; O = (bf16_t*)(P.ws + O_WPPT); ldw = 1024; Kd = 256; tn = j >> 2; tk = j & 3; mode = 1; }
        const int n0 = tn * 64, k0 = tk * 64;
        int sc0 = n0; if (mode == 0) sc0 = win_src_col(n0); if (mode == 2) sc0 = n0 & 1023;
        {
            const int kk = tid >> 4, c4 = (tid & 15) * 4;
#pragma unroll
            for (int i = 0; i < 2; ++i) {
                const f32x4 v = *(const f32x4*)(W + (size_t)(k0 + kk + 32 * i) * ldw + sc0 + c4);
                float* d = ts + (kk + 32 * i) * 65 + c4; d[0] = v[0]; d[1] = v[1]; d[2] = v[2]; d[3] = v[3];
            }
        }
        __syncthreads();
        {
            const int n = tid >> 3, kc = (tid & 7) * 8;
            float v[8];
#pragma unroll
            for (int j = 0; j < 8; ++j) v[j] = ts[(kc + j) * 65 + n];
            u32x4 w; w.x = pk2(v[0], v[1]); w.y = pk2(v[2], v[3]); w.z = pk2(v[4], v[5]); w.w = pk2(v[6], v[7]);
            *(u32x4*)(O + (size_t)(n0 + n) * Kd + k0 + kc) = w;
        }
        __syncthreads();
    }
}

__device__ void phase_lru(const Params& P, unsigned char* lds) {
    const int tid = threadIdx.x, wid = __builtin_amdgcn_readfirstlane(tid >> 6), lane = tid & 63, c = lane & 15, kq = lane >> 4;
    bf16_t* u_s = (bf16_t*)lds;
    float* u32_s = (float*)(lds + 34816);
    float* a_s = (float*)(lds + 51712);
    float* i_s = (float*)(lds + 68608);
    float* segA = (float*)(lds + 85504);
    float* segH = (float*)(lds + 87552);
    float* carry = (float*)(lds + 89600);
    const bf16_t* zx = (const bf16_t*)(P.ws + O_ZX); const bf16_t* gy = (const bf16_t*)(P.ws + O_GY); bf16_t* yag = (bf16_t*)(P.ws + O_XB);
    for (int item = blockIdx.x; item < 256; item += gridDim.x) {
        const int grp_ = (item & 7) * 8 + (item >> 5), qd = (item >> 3) & 3, b = grp_ >> 3, blk = grp_ & 7;
        const int ch0 = blk * 128, d0 = ch0 + qd * 32;
        bf16_t* wB = (bf16_t*)(lds + 90112);
        for (int i = tid; i < 2 * 128 * 32; i += 512) {
            const int mat = i >> 12, cc = (i >> 5) & 127, dd = i & 31;
            wB[(mat * 32 + dd) * 136 + cc] = f2bf(((mat ? P.lru_wi : P.lru_wr) + (size_t)blk * 128 * 128)[cc * 128 + qd * 32 + dd]);
        }
        float br[2], bi[2], sp[2];
#pragma unroll
        for (int nt = 0; nt < 2; ++nt) {
            const int dch = d0 + nt * 16 + c;
            br[nt] = P.lru_br[dch]; bi[nt] = P.lru_bi[dch];
            const float lam = P.lru_lambda[dch];
            const float spl = (lam > 0.f ? 0.f : -lam) + log1pf(__expf(-fabsf(lam)));
            sp[nt] = -8.0f * spl;
        }
        const int cg8 = tid & 15, tgrp = tid >> 4;
        float cw[4][8], cb[8];
#pragma unroll
        for (int j = 0; j < 4; ++j)
#pragma unroll
            for (int q = 0; q < 8; ++q) cw[j][q] = P.conv_w[j * 1024 + ch0 + cg8 * 8 + q];
#pragma unroll
        for (int q = 0; q < 8; ++q) cb[q] = P.conv_b[ch0 + cg8 * 8 + q];
        if (tid < 32) carry[tid] = 0.f;
        u32x4 rows[7], rowsN[7];
#pragma unroll
        for (int r = 0; r < 7; ++r) {
            const int tt = tgrp * 4 - 3 + r;
            if (tt >= 0) rows[r] = *(const u32x4*)(zx + ((size_t)b * SEQL + tt) * 1024 + ch0 + cg8 * 8);
            else rows[r] = (u32x4){0u, 0u, 0u, 0u};
        }
#pragma unroll 1
        for (int tile = 0; tile < 16; ++tile) {
            const int t0 = tile * 128;
            {
#pragma unroll
                for (int i = 0; i < 4; ++i) {
                    float o[8];
#pragma unroll
                    for (int q = 0; q < 8; ++q) o[q] = cb[q];
#pragma unroll
                    for (int j = 0; j < 4; ++j) {
                        const u32x4 rw = rows[i + j];
                        o[0] += cw[j][0] * bflo(rw.x); o[1] += cw[j][1] * bfhi(rw.x); o[2] += cw[j][2] * bflo(rw.y); o[3] += cw[j][3] * bfhi(rw.y);
                        o[4] += cw[j][4] * bflo(rw.z); o[5] += cw[j][5] * bfhi(rw.z); o[6] += cw[j][6] * bflo(rw.w); o[7] += cw[j][7] * bfhi(rw.w);
                    }
                    const int t = tgrp * 4 + i;
                    u32x4 w; w.x = pk2(o[0], o[1]); w.y = pk2(o[2], o[3]); w.z = pk2(o[4], o[5]); w.w = pk2(o[6], o[7]);
                    *(u32x4*)(u_s + t * 136 + cg8 * 8) = w;
                    if ((cg8 >> 2) == qd) {
#pragma unroll
                        for (int q = 0; q < 8; ++q) u32_s[t * 33 + (cg8 & 3) * 8 + q] = o[q];
                    }
                }
            }
            __syncthreads();
            f32x4 cvs[4];
            {
                const size_t cbase = ((size_t)item * 16 + tile) * 2048;
#pragma unroll
                for (int k = 0; k < 4; ++k) { const size_t ci = cbase + k * 512 + tid; cvs[k] = __builtin_nontemporal_load((const f32x4*)(ci < (size_t)NTOK * 256 ? P.peer_u + ci * 4 : P.peer_v + (ci - (size_t)NTOK * 256) * 4)); }
            }
            bf16_t gyv[8];
            {
                const int tn = (tile + 1 < 16 ? tile + 1 : 15) * 128;
#pragma unroll
                for (int r = 0; r < 7; ++r) rowsN[r] = *(const u32x4*)(zx + ((size_t)b * SEQL + tn + tgrp * 4 - 3 + r) * 1024 + ch0 + cg8 * 8);
                const int cs_ = tid & 31, seg_ = tid >> 5;
#pragma unroll
                for (int jq = 0; jq < 8; ++jq) gyv[jq] = gy[((size_t)b * SEQL + t0 + seg_ * 8 + jq) * 1024 + d0 + cs_];
            }
            {
                f32x4 accR[2], accI[2];
#pragma unroll
                for (int nt = 0; nt < 2; ++nt) { accR[nt] = (f32x4){0.f, 0.f, 0.f, 0.f}; accI[nt] = (f32x4){0.f, 0.f, 0.f, 0.f}; }
#pragma unroll
                for (int ks = 0; ks < 4; ++ks) {
                    const bf16x8 af = *(const bf16x8*)(u_s + (wid * 16 + c) * 136 + ks * 32 + kq * 8);
#pragma unroll
                    for (int nt = 0; nt < 2; ++nt) {
                        accR[nt] = mfma16(af, *(const bf16x8*)(wB + (nt * 16 + c) * 136 + ks * 32 + kq * 8), accR[nt]);
                        accI[nt] = mfma16(af, *(const bf16x8*)(wB + (32 + nt * 16 + c) * 136 + ks * 32 + kq * 8), accI[nt]);
                    }
                }
#pragma unroll
                for (int nt = 0; nt < 2; ++nt)
#pragma unroll
                    for (int i = 0; i < 4; ++i) {
                        const int t = wid * 16 + kq * 4 + i, dl = nt * 16 + c;
                        const float r = sigmoidf_(accR[nt][i] + br[nt]), ig = sigmoidf_(accI[nt][i] + bi[nt]);
                        const float log_a = sp[nt] * r;
                        const float a = __expf(log_a);
                        const float mult = sqrtf(-expm1f(2.0f * log_a));
                        a_s[t * 33 + dl] = a; i_s[t * 33 + dl] = mult * ig * u32_s[t * 33 + dl];
                    }
            }
            __syncthreads();
            {
                const int cs = tid & 31, seg = tid >> 5;
                float av[8], iv[8];
#pragma unroll
                for (int j = 0; j < 8; ++j) { av[j] = a_s[(seg * 8 + j) * 33 + cs]; iv[j] = i_s[(seg * 8 + j) * 33 + cs]; }
                float A = 1.f, H = 0.f;
#pragma unroll
                for (int j = 0; j < 8; ++j) { H = av[j] * H + iv[j]; A *= av[j]; }
                segA[seg * 32 + cs] = A; segH[seg * 32 + cs] = H;
                __syncthreads();
                float h = carry[cs];
                for (int s = 0; s < seg; ++s) h = segA[s * 32 + cs] * h + segH[s * 32 + cs];
#pragma unroll
                for (int j = 0; j < 8; ++j) {
                    h = av[j] * h + iv[j];
                    const size_t gi = ((size_t)b * SEQL + t0 + seg * 8 + j) * 1024 + d0 + cs;
                    yag[gi] = f2bf(h * bf2f(gyv[j]));
                }
                __syncthreads();
                if (seg == 15) carry[cs] = h;
            }
            {
                unsigned* u8 = (unsigned*)(P.ws + O_UB);
                const size_t cbase = ((size_t)item * 16 + tile) * 2048;
#pragma unroll
                for (int k = 0; k < 4; ++k) {
                    const size_t ci = cbase + k * 512 + tid; const float sc = ci < (size_t)NTOK * 256 ? 256.0f : 32.0f;
                    int wv = 0;
                    wv = __builtin_amdgcn_cvt_pk_fp8_f32(cvs[k][0] * sc, cvs[k][1] * sc, wv, false);
                    wv = __builtin_amdgcn_cvt_pk_fp8_f32(cvs[k][2] * sc, cvs[k][3] * sc, wv, true);
#ifdef PEER2
#ifdef PEER3
                    if (ci < (size_t)NTOK * 256) { const size_t e_ = ci >> 8; const unsigned c4 = (unsigned)ci & 255u; ((unsigned*)(P.ws + O_UB))[((size_t)(c4 >> 5) * 16384 + e_) * 32 + (c4 & 31u)] = (unsigned)wv; }
#else
                    if (ci < (size_t)NTOK * 256) u8[ci] = (unsigned)wv;
#endif
                    else { const size_t cv = ci - (size_t)NTOK * 256; const size_t e_ = cv >> 8; const unsigned c4 = (unsigned)cv & 255u;
                           ((unsigned*)(P.ws + O_VB))[((size_t)(c4 >> 5) * 16384 + e_) * 32 + (c4 & 31u)] = (unsigned)wv; }
#else
                    u8[ci] = (unsigned)wv;
#endif
                }
            }
#pragma unroll
            for (int r = 0; r < 7; ++r) rows[r] = rowsN[r];
        }
        __syncthreads();
    }
}

__device__ void phase_gla1(const Params& P, unsigned char* lds) {
    const int tid = threadIdx.x, wid = __builtin_amdgcn_readfirstlane(tid >> 6), lane = tid & 63, c = lane & 15, kq = lane >> 4;
    bf16_t* Qb_s = (bf16_t*)(lds + 33024);
    bf16_t* Kb_s = (bf16_t*)(lds + 50432);
    bf16_t* Klt_s = (bf16_t*)(lds + 67840);
    bf16_t* Vt_s = (bf16_t*)(lds + 86272);
    bf16_t* A_s = (bf16_t*)(lds + 123136);
    float* fl_s = (float*)(lds + 132352);
    float* segs = (float*)(lds + 136448);
    bf16_t* zq = (bf16_t*)(P.ws + O_ZQ); const bf16_t* zk = (const bf16_t*)(P.ws + O_ZK); const bf16_t* zv = (const bf16_t*)(P.ws + O_ZV);
    const float* flow = (const float*)(P.ws + O_FLOW); bf16_t* dlastb = (bf16_t*)(P.ws + O_DLAST); bf16_t* UT = (bf16_t*)(P.ws + O_UT); float* oin = P.out;
    for (int item0 = blockIdx.x; item0 < 1024; item0 += gridDim.x) {
        const int h = (item0 >> 3) & 3, bn = (item0 & 7) * 32 + (item0 >> 5), tok0 = bn * 64, item = bn * 4 + h;
        const int d = tid & 127, tg = tid >> 7;
        for (int i = tid; i < 1024; i += 512) fl_s[i] = flow[(size_t)tok0 * 16 + i];
        float w2[16];
#pragma unroll
        for (int r = 0; r < 16; ++r) w2[r] = P.gla_wf2[r * 512 + h * 128 + d];
        const float bfd = P.gla_bf[h * 128 + d];
        bf16_t q16[16], k16[16], v32[32];
#pragma unroll
        for (int j = 0; j < 16; ++j) { const size_t gi = (size_t)(tok0 + tg * 16 + j) * 512 + h * 128 + d; q16[j] = zq[gi]; k16[j] = zk[gi]; }
        {
            const int n = tid & 255, tg2 = tid >> 8;
#pragma unroll
            for (int j = 0; j < 32; ++j) v32[j] = zv[(size_t)(tok0 + tg2 * 32 + j) * 1024 + h * 256 + n];
        }
        __syncthreads();
        float g[16]; float run = 0.f;
#pragma unroll
        for (int j = 0; j < 16; ++j) {
            const int t = tg * 16 + j; float xv = bfd;
#pragma unroll
            for (int r = 0; r < 16; ++r) xv += fl_s[t * 16 + r] * w2[r];
            const float ls = fminf(xv, 0.f) - log1pf(__expf(-fabsf(xv)));
            run += ls * 0.0625f; g[j] = run;
#ifdef DBG_SCAN
            { int* fl = (int*)(P.ws + 240 * MBY); if (!(fabsf(fl_s[t * 16 + (j & 15)]) < 1e3f)) fl[40] = 1; if (!(fabsf(xv) < 1e30f)) fl[41] = 1; if (!(fabsf(ls) < 1e30f)) fl[42] = 1; }
#endif
        }
        segs[tg * 128 + d] = run;
        __syncthreads();
        float pre = 0.f, blast = 0.f;
#pragma unroll
        for (int s = 0; s < 4; ++s) { const float v = segs[s * 128 + d]; if (s < tg) pre += v; blast += v; }
#pragma unroll
        for (int j = 0; j < 16; ++j) {
            const int t = tg * 16 + j; const float bv = pre + g[j];
            const size_t gi = (size_t)(tok0 + t) * 512 + h * 128 + d;
            const float qv = bf2f(q16[j]), kv = bf2f(k16[j]);
            const float qb = qv * __expf(bv) * 0.08838834764831845f, kb = kv * __expf(-bv), kl = kv * __expf(blast - bv);
            const bf16_t qbb = f2bf(qb);
#ifdef DBG_SCAN
            { int* fl = (int*)(P.ws + 240 * MBY); if (!(fabsf(bv) < 1e30f)) fl[43] = 1; if (!(fabsf(kl) < 1e30f)) fl[44] = 1; if (!(fabsf(kb) < 1e30f)) fl[46] = 1; }
#endif
            Qb_s[t * 136 + d] = qbb; zq[gi] = qbb; Kb_s[t * 136 + d] = f2bf(kb); Klt_s[d * 72 + t] = f2bf(kl);
        }
        if (tg == 0) dlastb[(size_t)item * 128 + d] = f2bf(__expf(blast));
        {
            const int n = tid & 255, tg2 = tid >> 8;
#pragma unroll
            for (int j = 0; j < 32; ++j) { const int t = tg2 * 32 + j; Vt_s[n * 72 + t] = v32[j]; }
        }
        __syncthreads();
        {
            const int mi = wid >> 1;
#pragma unroll
            for (int jj = 0; jj < 2; ++jj) {
                const int nj = (wid & 1) * 2 + jj;
                f32x4 acc = {0.f, 0.f, 0.f, 0.f};
                if (nj <= mi) {
#pragma unroll
                    for (int ks = 0; ks < 4; ++ks) {
                        const bf16x8 a = *(const bf16x8*)(Qb_s + (mi * 16 + c) * 136 + ks * 32 + kq * 8);
                        const bf16x8 bb = *(const bf16x8*)(Kb_s + (nj * 16 + c) * 136 + ks * 32 + kq * 8);
                        acc = mfma16(a, bb, acc);
                    }
                }
#pragma unroll
                for (int r = 0; r < 4; ++r) { const int i = mi * 16 + kq * 4 + r, jx = nj * 16 + c; A_s[i * 72 + jx] = f2bf(jx <= i ? acc[r] : 0.f); }
            }
        }
        __syncthreads();
        {
#pragma unroll
            for (int mt = 0; mt < 2; ++mt) {
                const int nt_ = wid * 2 + mt;
                bf16x8 afr[2];
#pragma unroll
                for (int ks = 0; ks < 2; ++ks) afr[ks] = *(const bf16x8*)(Vt_s + (nt_ * 16 + c) * 72 + ks * 32 + kq * 8);
#pragma unroll
                for (int it = 0; it < 4; ++it) {
                    f32x4 acc = {0.f, 0.f, 0.f, 0.f};
#pragma unroll
                    for (int ks = 0; ks < 2; ++ks) acc = mfma16(afr[ks], *(const bf16x8*)(A_s + (it * 16 + c) * 72 + ks * 32 + kq * 8), acc);
                    *(f32x4*)(oin + (size_t)(tok0 + it * 16 + c) * 1024 + h * 256 + nt_ * 16 + kq * 4) = acc;
                }
            }
            bf16x8 kfr[2];
#pragma unroll
            for (int ks = 0; ks < 2; ++ks) kfr[ks] = *(const bf16x8*)(Klt_s + (wid * 16 + c) * 72 + ks * 32 + kq * 8);
#pragma unroll 4
            for (int nt = 0; nt < 16; ++nt) {
                f32x4 acc = {0.f, 0.f, 0.f, 0.f};
#pragma unroll
                for (int ks = 0; ks < 2; ++ks) acc = mfma16(kfr[ks], *(const bf16x8*)(Vt_s + (nt * 16 + c) * 72 + ks * 32 + kq * 8), acc);
#ifdef DBG_SCAN
                { int* fl = (int*)(P.ws + 240 * MBY); if (!(fabsf(acc[0]) < 1e30f) || !(fabsf(acc[1]) < 1e30f) || !(fabsf(acc[2]) < 1e30f) || !(fabsf(acc[3]) < 1e30f)) fl[45] = 1; }
#endif
                u32x2 w; w.x = pk2(acc[0], acc[1]); w.y = pk2(acc[2], acc[3]);
                *(u32x2*)(UT + ((size_t)item * 256 + nt * 16 + c) * 128 + wid * 16 + kq * 4) = w;
            }
        }
        __syncthreads();
    }
}

__device__ void phase_gla2(const Params& P) {
    const int tid = threadIdx.x, wid = __builtin_amdgcn_readfirstlane(tid >> 6), lane = tid & 63, c = lane & 15, kq = lane >> 4;
    const bf16_t* zq = (const bf16_t*)(P.ws + O_ZQ); const bf16_t* dlastb = (const bf16_t*)(P.ws + O_DLAST); const bf16_t* UT = (const bf16_t*)(P.ws + O_UT);
    float* oin = P.out; float* ssq = (float*)(P.ws + O_SSQ);
    for (int item = blockIdx.x; item < 256; item += gridDim.x) {
        const int pair_ = (item & 7) * 4 + (item >> 6), s = (item >> 3) & 7, b = pair_ >> 2, h = pair_ & 3;
        const int mi = wid & 3, ni = wid >> 2, ncol = s * 32 + ni * 16;
        float S[4][8];
#pragma unroll
        for (int ks = 0; ks < 4; ++ks)
#pragma unroll
            for (int j = 0; j < 8; ++j) S[ks][j] = 0.f;
#define G2_LOAD(Q, U, D, OI, NC) do { const int bn_ = b * 32 + (NC), it_ = bn_ * 4 + h, tok_ = bn_ * 64 + mi * 16 + c; \
            OI = *(const f32x4*)(oin + (size_t)tok_ * 1024 + h * 256 + ncol + kq * 4); \
            _Pragma("unroll") for (int ks = 0; ks < 4; ++ks) { \
                Q[ks] = *(const bf16x8*)(zq + (size_t)tok_ * 512 + h * 128 + ks * 32 + kq * 8); \
                U[ks] = *(const u32x4*)(UT + ((size_t)it_ * 256 + ncol + c) * 128 + ks * 32 + kq * 8); \
                D[ks] = *(const u32x4*)(dlastb + (size_t)it_ * 128 + ks * 32 + kq * 8); } } while (0)
#define G2_COMP(Q, U, D, OI, NC) do { const int bn_ = b * 32 + (NC), tok_ = bn_ * 64 + mi * 16 + c; \
            f32x4 acc = OI; \
            _Pragma("unroll") for (int ks = 0; ks < 4; ++ks) { \
                u32x4 w; w.x = pk2(S[ks][0], S[ks][1]); w.y = pk2(S[ks][2], S[ks][3]); w.z = pk2(S[ks][4], S[ks][5]); w.w = pk2(S[ks][6], S[ks][7]); \
                acc = mfma16(__builtin_bit_cast(bf16x8, w), Q[ks], acc); } \
            *(f32x4*)(oin + (size_t)tok_ * 1024 + h * 256 + ncol + kq * 4) = acc; \
            float ss = acc[0] * acc[0] + acc[1] * acc[1] + acc[2] * acc[2] + acc[3] * acc[3]; \
            ss += __shfl_xor(ss, 16); ss += __shfl_xor(ss, 32); \
            if (kq == 0) ssq[((size_t)tok_ * 4 + h) * 16 + s * 2 + ni] = ss; \
            _Pragma("unroll") for (int ks = 0; ks < 4; ++ks) { const u32x4 uu = U[ks]; const u32x4 dd = D[ks]; \
                S[ks][0] = bflo(dd.x) * S[ks][0] + bflo(uu.x); S[ks][1] = bfhi(dd.x) * S[ks][1] + bfhi(uu.x); \
                S[ks][2] = bflo(dd.y) * S[ks][2] + bflo(uu.y); S[ks][3] = bfhi(dd.y) * S[ks][3] + bfhi(uu.y); \
                S[ks][4] = bflo(dd.z) * S[ks][4] + bflo(uu.z); S[ks][5] = bfhi(dd.z) * S[ks][5] + bfhi(uu.z); \
                S[ks][6] = bflo(dd.w) * S[ks][6] + bflo(uu.w); S[ks][7] = bfhi(dd.w) * S[ks][7] + bfhi(uu.w); } } while (0)
        bf16x8 QA[4], QB[4], QC[4]; u32x4 UA[4], UB[4], UC[4], DA[4], DB[4], DC[4]; f32x4 oA, oB, oC;
        G2_LOAD(QA, UA, DA, oA, 0);
        G2_LOAD(QB, UB, DB, oB, 1);
#pragma unroll 1
        for (int nc = 0; nc < 33; nc += 3) {
            G2_LOAD(QC, UC, DC, oC, (nc + 2 < 32 ? nc + 2 : 31));
            G2_COMP(QA, UA, DA, oA, nc);
            G2_LOAD(QA, UA, DA, oA, (nc + 3 < 32 ? nc + 3 : 31));
            G2_COMP(QB, UB, DB, oB, nc + 1);
            if (nc + 2 >= 32) break;
            G2_LOAD(QB, UB, DB, oB, (nc + 4 < 32 ? nc + 4 : 31));
            G2_COMP(QC, UC, DC, oC, nc + 2);
        }
#undef G2_LOAD
#undef G2_COMP
    }
}

__device__ void phase_combine(const Params& P) {
    const float* oin = P.out; const float* ssq = (const float*)(P.ws + O_SSQ); const bf16_t* gr = (const bf16_t*)(P.ws + O_GR); bf16_t* ym = (bf16_t*)(P.ws + O_XB);
    for (int idx = blockIdx.x * 512 + threadIdx.x; idx < NTOK * 128; idx += gridDim.x * 512) {
        const int row = idx >> 7, col = (idx & 127) * 8, h = col >> 8;
        const f32x4* sp = (const f32x4*)(ssq + ((size_t)row * 4 + h) * 16);
        const f32x4 s0 = sp[0], s1 = sp[1], s2 = sp[2], s3 = sp[3];
        const float tot = (s0[0] + s0[1] + s0[2] + s0[3]) + (s1[0] + s1[1] + s1[2] + s1[3]) + (s2[0] + s2[1] + s2[2] + s2[3]) + (s3[0] + s3[1] + s3[2] + s3[3]);
        const float rs = rsqrtf(tot * (1.0f / 256.0f) + 1e-6f);
        const size_t gi = (size_t)row * 1024 + col;
        const f32x4 o0 = *(const f32x4*)(oin + gi), o1 = *(const f32x4*)(oin + gi + 4);
        const f32x4 n0 = *(const f32x4*)(P.gla_norm_g + col), n1 = *(const f32x4*)(P.gla_norm_g + col + 4);
        const u32x4 g = *(const u32x4*)(gr + gi), y = *(const u32x4*)(ym + gi);
        u32x4 w;
        w.x = pk2(bflo(y.x) + bflo(g.x) * (o0[0] * rs * n0[0]), bfhi(y.x) + bfhi(g.x) * (o0[1] * rs * n0[1]));
        w.y = pk2(bflo(y.y) + bflo(g.y) * (o0[2] * rs * n0[2]), bfhi(y.y) + bfhi(g.y) * (o0[3] * rs * n0[3]));
        w.z = pk2(bflo(y.z) + bflo(g.z) * (o1[0] * rs * n1[0]), bfhi(y.z) + bfhi(g.z) * (o1[1] * rs * n1[1]));
        w.w = pk2(bflo(y.w) + bflo(g.w) * (o1[2] * rs * n1[2]), bfhi(y.w) + bfhi(g.w) * (o1[3] * rs * n1[3]));
        *(u32x4*)(ym + gi) = w;
    }
}

__device__ void phase_ln1(const Params& P) {
    const int tid = threadIdx.x, wid = tid >> 6, lane = tid & 63;
    float* y = P.out; bf16_t* x1b = (bf16_t*)(P.ws + O_X1B);
    const int rstride = gridDim.x * 8;
    for (int row0 = blockIdx.x * 8 + wid; row0 < NTOK; row0 += 2 * rstride) {
        const int row1 = row0 + rstride; const bool has1 = row1 < NTOK; const int r1 = has1 ? row1 : row0;
        f32x4 v[4], w[4]; float s = 0.f, s1 = 0.f;
#pragma unroll
        for (int i = 0; i < 4; ++i) { v[i] = *(const f32x4*)(y + (size_t)row0 * 1024 + i * 256 + lane * 4); w[i] = *(const f32x4*)(y + (size_t)r1 * 1024 + i * 256 + lane * 4); }
#pragma unroll
        for (int i = 0; i < 4; ++i) { s += (v[i][0] + v[i][1]) + (v[i][2] + v[i][3]); s1 += (w[i][0] + w[i][1]) + (w[i][2] + w[i][3]); }
        s += __shfl_xor(s, 32); s1 += __shfl_xor(s1, 32); s += __shfl_xor(s, 16); s1 += __shfl_xor(s1, 16);
        s += dpp_xor8(s); s1 += dpp_xor8(s1); s += dpp_xor4(s); s1 += dpp_xor4(s1); s += dpp_xor2(s); s1 += dpp_xor2(s1); s += dpp_xor1(s); s1 += dpp_xor1(s1);
        const float mu = s * (1.0f / 1024.0f), mu1 = s1 * (1.0f / 1024.0f);
        float q = 0.f, q1 = 0.f;
#pragma unroll
        for (int i = 0; i < 4; ++i) { v[i] = v[i] - mu; w[i] = w[i] - mu1; q += (v[i][0] * v[i][0] + v[i][1] * v[i][1]) + (v[i][2] * v[i][2] + v[i][3] * v[i][3]); q1 += (w[i][0] * w[i][0] + w[i][1] * w[i][1]) + (w[i][2] * w[i][2] + w[i][3] * w[i][3]); }
        q += __shfl_xor(q, 32); q1 += __shfl_xor(q1, 32); q += __shfl_xor(q, 16); q1 += __shfl_xor(q1, 16);
        q += dpp_xor8(q); q1 += dpp_xor8(q1); q += dpp_xor4(q); q1 += dpp_xor4(q1); q += dpp_xor2(q); q1 += dpp_xor2(q1); q += dpp_xor1(q); q1 += dpp_xor1(q1);
        const float rstd = rsqrtf(q * (1.0f / 1024.0f) + 1e-5f), rstd1 = rsqrtf(q1 * (1.0f / 1024.0f) + 1e-5f);
#pragma unroll
        for (int i = 0; i < 4; ++i) {
            const int col = i * 256 + lane * 4;
            const f32x4 gg = *(const f32x4*)(P.ln1_g + col), bb = *(const f32x4*)(P.ln1_b + col);
            const f32x4 o = v[i] * rstd * gg + bb;
            *(f32x4*)(y + (size_t)row0 * 1024 + col) = o;
            u32x2 pw; pw.x = pk2(o[0], o[1]); pw.y = pk2(o[2], o[3]);
            *(u32x2*)(x1b + (size_t)row0 * 1024 + col) = pw;
            if (has1) {
                const f32x4 o1 = w[i] * rstd1 * gg + bb;
                *(f32x4*)(y + (size_t)row1 * 1024 + col) = o1;
                u32x2 pw1; pw1.x = pk2(o1[0], o1[1]); pw1.y = pk2(o1[2], o1[3]);
                *(u32x2*)(x1b + (size_t)row1 * 1024 + col) = pw1;
            }
        }
    }
}

__device__ __forceinline__ int sortable(int bits) { return bits ^ ((bits >> 31) & 0x7fffffff); }
__device__ __forceinline__ void sort16_asc(int (&a)[16]) {
#pragma unroll
    for (int k = 2; k <= 16; k <<= 1)
#pragma unroll
        for (int j = k >> 1; j > 0; j >>= 1)
#pragma unroll
            for (int i = 0; i < 16; ++i) { const int l = i ^ j;
                if (l > i) { const int lo = min(a[i], a[l]), hi = max(a[i], a[l]); const bool up = ((i & k) == 0); a[i] = up ? lo : hi; a[l] = up ? hi : lo; } }
}
__device__ __forceinline__ void merge_top16(int (&top)[16], const int (&asc)[16]) {
#pragma unroll
    for (int i = 0; i < 16; ++i) top[i] = max(top[i], asc[i]);
#pragma unroll
    for (int j = 8; j > 0; j >>= 1)
#pragma unroll
        for (int i = 0; i < 16; ++i) { const int l = i ^ j; if (l > i) { const int lo = min(top[i], top[l]), hi = max(top[i], top[l]); top[i] = hi; top[l] = lo; } }
}
__device__ void phase_peer(const Params& P, unsigned char* lds, cg::grid_group& grid) {
    const bool align_sync = false;
    const int tid = threadIdx.x, wid = __builtin_amdgcn_readfirstlane(tid >> 6), lane = tid & 63;
    int* ridx = (int*)lds;
    float* rgt = (float*)(lds + 33024);
    const float* qp = (const float*)(P.ws + O_QP); const bf16_t* x1b = (const bf16_t*)(P.ws + O_X1B);
    const unsigned char* u8t = P.ws + O_UB; const unsigned char* v8t = P.ws + O_VB; const bf16_t* ple = (const bf16_t*)(P.ws + O_PP);
    float* xo = P.out;
    for (int tile = blockIdx.x; tile < NTOK / 64; tile += gridDim.x) {
        const int tok0 = tile * 64;
#ifndef NO_ROUTE
#ifdef PROBE_T
        unsigned long long pt0 = __builtin_amdgcn_s_memrealtime();
#endif
        {
            const int token = tok0 + lane;
            int* Ls = (int*)(lds + 66048) + wid * 32 * 64 + lane;
            typedef float f32x16 __attribute__((ext_vector_type(16)));
            const int lc = lane & 31, lh = lane >> 5;
#define SPLIT8(HI, LO, A0, A1) do { \
                const float v_[8] = {A0[0], A0[1], A0[2], A0[3], A1[0], A1[1], A1[2], A1[3]}; unsigned h_[4], l_[4]; \
                _Pragma("unroll") for (int e_ = 0; e_ < 4; ++e_) { h_[e_] = pk2(v_[2 * e_], v_[2 * e_ + 1]); l_[e_] = pk2(v_[2 * e_] - bflo(h_[e_]), v_[2 * e_ + 1] - bfhi(h_[e_])); } \
                HI = __builtin_bit_cast(bf16x8, (u32x4){h_[0], h_[1], h_[2], h_[3]}); LO = __builtin_bit_cast(bf16x8, (u32x4){l_[0], l_[1], l_[2], l_[3]}); } while (0)
#pragma unroll 1
            for (int p = 0; p < 2; ++p) {
                bf16x8 Qh[2][4], Ql[2][4];
#pragma unroll
                for (int nt = 0; nt < 2; ++nt)
#pragma unroll
                    for (int ks = 0; ks < 4; ++ks) {
                        const float* qr = qp + (size_t)(tok0 + nt * 32 + lc) * 1024 + wid * 128 + p * 64 + ks * 16 + lh * 8;
                        const f32x4 a0 = *(const f32x4*)qr, a1 = *(const f32x4*)(qr + 4);
                        SPLIT8(Qh[nt][ks], Ql[nt][ks], a0, a1);
                    }
                int topA[16], topB[16];
#pragma unroll
                for (int i = 0; i < 16; ++i) { topA[i] = (int)0x80000000; topB[i] = (int)0x80000000; }
                const float* keys = P.peer_subkeys + (size_t)((wid * 2 + p) * 128) * 64;
#pragma unroll 1
                for (int mt = 0; mt < 4; ++mt) {
                    bf16x8 Kh[4], Kl[4];
#pragma unroll
                    for (int ks = 0; ks < 4; ++ks) {
                        const float* kr = keys + (size_t)(mt * 32 + lc) * 64 + ks * 16 + lh * 8;
                        const f32x4 a0 = *(const f32x4*)kr, a1 = *(const f32x4*)(kr + 4);
                        SPLIT8(Kh[ks], Kl[ks], a0, a1);
                    }
#pragma unroll
                    for (int nt = 0; nt < 2; ++nt) {
                        f32x16 acc;
#pragma unroll
                        for (int i = 0; i < 16; ++i) acc[i] = 0.f;
#pragma unroll
                        for (int ks = 0; ks < 4; ++ks) {
                            acc = __builtin_amdgcn_mfma_f32_32x32x16_bf16(Kh[ks], Qh[nt][ks], acc, 0, 0, 0);
                            acc = __builtin_amdgcn_mfma_f32_32x32x16_bf16(Kh[ks], Ql[nt][ks], acc, 0, 0, 0);
                            acc = __builtin_amdgcn_mfma_f32_32x32x16_bf16(Kl[ks], Qh[nt][ks], acc, 0, 0, 0);
                        }
                        int nk16[16];
#pragma unroll
                        for (int i = 0; i < 16; ++i) { const int kidx = mt * 32 + 8 * (i >> 2) + 4 * lh + (i & 3); nk16[i] = sortable((__float_as_int(acc[i]) & ~127) | kidx); }
                        sort16_asc(nk16);
                        if (nt == 0) merge_top16(topA, nk16); else merge_top16(topB, nk16);
                    }
                }
                int mine[16];
#pragma unroll
                for (int i = 0; i < 16; ++i) mine[i] = lh ? topB[i] : topA[i];
                int recv[16];
#pragma unroll
                for (int i = 0; i < 16; ++i) { const int send = lh ? topA[15 - i] : topB[15 - i]; recv[i] = __shfl_xor(send, 32); }
                merge_top16(mine, recv);
#pragma unroll
                for (int i = 0; i < 16; ++i) Ls[(p * 16 + i) * 64] = mine[i];
            }
#undef SPLIT8
            int top2k[16];
#pragma unroll
            for (int i = 0; i < 16; ++i) top2k[i] = (int)0x80000000;
#pragma unroll 1
            for (int i = 0; i < 16; ++i) {
                const int b0 = sortable(Ls[i * 64]); const float va = __int_as_float(b0 & ~127);
                const int jmax = 16 / (i + 1);
#pragma unroll 1
                for (int j = 0; j < jmax; ++j) {
                    const int b1 = sortable(Ls[(16 + j) * 64]);
                    const float sm = va + __int_as_float(b1 & ~127);
                    int key = sortable((__float_as_int(sm) & ~255) | (i << 4) | j);
#pragma unroll
                    for (int m = 0; m < 16; ++m) { const int hi = max(top2k[m], key); key = min(top2k[m], key); top2k[m] = hi; }
                }
            }
            long long top2[16];
#pragma unroll
            for (int m = 0; m < 16; ++m) {
                const int bits = sortable(top2k[m]); const int ci = (bits >> 4) & 15, cj = bits & 15;
                const int e0 = sortable(Ls[ci * 64]) & 127, e1 = sortable(Ls[(16 + cj) * 64]) & 127;
                top2[m] = (long long)((((unsigned long long)(unsigned)sortable(bits & ~255)) << 32) | (unsigned long long)(unsigned)(e0 * 128 + e1));
            }
            float e[16]; float smax = __int_as_float(sortable((int)(top2[0] >> 32))); float den = 0.f;
#pragma unroll
            for (int m = 0; m < 16; ++m) { const float sv = __int_as_float(sortable((int)(top2[m] >> 32))); e[m] = __expf(sv - smax); den += e[m]; }
            const float inv = 1.0f / den;
#ifdef PEER3
            {
                int* RI = (int*)(P.ws + O_RIDX) + (size_t)token * 128 + wid * 16; float* RWp = (float*)(P.ws + O_RG) + (size_t)token * 128 + wid * 16;
#pragma unroll
                for (int m4 = 0; m4 < 4; ++m4) {
                    *(u32x4*)(RI + m4 * 4) = (u32x4){(unsigned)(top2[m4 * 4] & 0xffffffffll), (unsigned)(top2[m4 * 4 + 1] & 0xffffffffll), (unsigned)(top2[m4 * 4 + 2] & 0xffffffffll), (unsigned)(top2[m4 * 4 + 3] & 0xffffffffll)};
                    *(f32x4*)(RWp + m4 * 4) = (f32x4){e[m4 * 4] * inv, e[m4 * 4 + 1] * inv, e[m4 * 4 + 2] * inv, e[m4 * 4 + 3] * inv};
                }
            }
#else
#pragma unroll
            for (int m = 0; m < 16; ++m) { ridx[lane * 129 + wid * 16 + m] = (int)(unsigned)(top2[m] & 0xffffffffll); rgt[lane * 129 + wid * 16 + m] = e[m] * inv; }
#endif
        }
#endif
        __syncthreads();
#ifdef PEER3
        continue;
#endif
#ifndef NO_GATHER
#ifdef PROBE_T
        unsigned long long pt1 = __builtin_amdgcn_s_memrealtime();
#endif
        {
            const int j = lane & 15, g = lane >> 4;
            unsigned char* xt = lds + 82560;
#pragma unroll 1
            for (int half = 0; half < 2; ++half) {
                for (int i = tid; i < 32 * 128; i += 512) { const int t = i >> 7, c16 = i & 127; *(u32x4*)(xt + t * 2064 + c16 * 16) = *(const u32x4*)(x1b + (size_t)(tok0 + half * 32 + t) * 1024 + c16 * 8); }
                __syncthreads();
                float dkeep = 0.f; int pkeep = -1; int nk = 0;
                int r_ = 0, ch_ = wid - 8; unsigned long long m0 = 0ull, m1 = 0ull;
#define PA_ADV(VALID, TL, BS, ACT) do { VALID = true; \
                    while (!(m0 | m1)) { ch_ += 8; if (ch_ >= 32) { ch_ = wid; if (++r_ >= 1) { VALID = false; break; } } \
                        const int tl_ = half * 32 + ch_; const int id0 = ridx[tl_ * 129 + lane], id1 = ridx[tl_ * 129 + 64 + lane]; \
                        m0 = __ballot((id0 >> 14) == r_); m1 = __ballot((id1 >> 14) == r_); } \
                    if (VALID) { int bb[4]; \
                        _Pragma("unroll") for (int q = 0; q < 4; ++q) { \
                            if (m0) { bb[q] = __ffsll((long long)m0) - 1; m0 &= m0 - 1; } \
                            else if (m1) { bb[q] = 64 + __ffsll((long long)m1) - 1; m1 &= m1 - 1; } \
                            else bb[q] = -1; } \
                        const int bg = g == 0 ? bb[0] : (g == 1 ? bb[1] : (g == 2 ? bb[2] : bb[3])); \
                        ACT = bg >= 0; BS = ACT ? bg : bb[0]; TL = half * 32 + ch_; } else { ACT = false; BS = 0; TL = half * 32; } } while (0)
#define PA_LOAD(U, TL, BS) do { const int pidx = ridx[(TL) * 129 + (BS)]; const unsigned char* ur = u8t + (size_t)pidx * 1024 + j * 16; \
                    _Pragma("unroll") for (int i = 0; i < 4; ++i) U[i] = *(const u32x4*)(ur + i * 256); } while (0)
#define PA_COMP(U, TL, BS, ACT) do { \
                        const unsigned char* xrow = xt + ((TL) - half * 32) * 2064 + j * 32; \
                        float d0 = 0.f, d1 = 0.f; \
                        _Pragma("unroll") for (int i = 0; i < 4; ++i) { \
                            const u32x4 xa = *(const u32x4*)(xrow + i * 512), xb_ = *(const u32x4*)(xrow + i * 512 + 16); \
                            _Pragma("unroll") for (int q = 0; q < 4; ++q) { \
                                const u32x4 xs = q < 2 ? xa : xb_; \
                                const unsigned wd = U[i][q]; \
                                const f32x2 lo_ = __builtin_amdgcn_cvt_pk_f32_fp8((int)wd, false), hi_ = __builtin_amdgcn_cvt_pk_f32_fp8((int)wd, true); \
                                d0 = dot2bf(pk2(lo_.x, lo_.y), xs[(q & 1) * 2], d0); d1 = dot2bf(pk2(hi_.x, hi_.y), xs[(q & 1) * 2 + 1], d1); } } \
                        float dsum = d0 + d1; \
                        dsum += __shfl_xor(dsum, 1); dsum += __shfl_xor(dsum, 2); dsum += __shfl_xor(dsum, 4); dsum += __shfl_xor(dsum, 8); \
                        dsum *= (1.0f / 256.0f); \
                        if (j == nk) { dkeep = dsum; pkeep = (ACT) ? (TL) * 129 + (BS) : -1; } \
                        if (++nk == 16) { \
                            if (pkeep >= 0) { const float hid = 0.5f * dkeep * (1.0f + erff(dkeep * 0.70710678118f)); rgt[pkeep] *= hid * (1.0f / 32.0f); } \
                            nk = 0; pkeep = -1; } } while (0)
                bool vA, vB, actA = false, actB = false; int tlA = 0, tlB = 0, bsA = 0, bsB = 0; u32x4 uA[4], uB[4];
                PA_ADV(vA, tlA, bsA, actA);
                PA_LOAD(uA, tlA, bsA);
                while (vA) {
                    PA_ADV(vB, tlB, bsB, actB);
                    PA_LOAD(uB, tlB, bsB);
                    PA_COMP(uA, tlA, bsA, actA);
                    if (!vB) break;
                    PA_ADV(vA, tlA, bsA, actA);
                    PA_LOAD(uA, tlA, bsA);
                    PA_COMP(uB, tlB, bsB, actB);
                }
#undef PA_COMP
#undef PA_ADV
#undef PA_LOAD
                if (pkeep >= 0) { const float hid = 0.5f * dkeep * (1.0f + erff(dkeep * 0.70710678118f)); rgt[pkeep] *= hid * (1.0f / 32.0f); }
                __syncthreads();
            }
#ifdef PROBE_T
            unsigned long long pt2 = __builtin_amdgcn_s_memrealtime();
            { unsigned long long* tsl = (unsigned long long*)(lds + 163840 - 64); if (tid == 0) { tsl[0] = pt1 - pt0; tsl[1] = pt2 - pt1; } }
#endif
#ifdef PEER2
            {
                int* RI = (int*)(P.ws + O_RIDX) + (size_t)tok0 * 128; float* RWp = (float*)(P.ws + O_RW) + (size_t)tok0 * 128;
                for (int i = tid; i < 64 * 128; i += 512) { RI[i] = ridx[(i >> 7) * 129 + (i & 127)]; RWp[i] = rgt[(i >> 7) * 129 + (i & 127)]; }
            }
            continue;
#endif
#pragma unroll 1
            for (int tt = 0; tt < 8; ++tt) {
                const int tl = wid * 8 + tt, token = tok0 + tl;
                f32x2 acc[32];
#pragma unroll
                for (int i = 0; i < 32; ++i) acc[i] = (f32x2){0.f, 0.f};
#define PEER_LOAD(V, GT, IT) do { const int e_ = (IT) * 4 + g; const int idx_ = ridx[tl * 129 + e_]; GT = rgt[tl * 129 + e_]; \
                    const unsigned char* vr_ = v8t + (size_t)idx_ * 1024 + j * 16; \
                    _Pragma("unroll") for (int i = 0; i < 4; ++i) V[i] = *(const u32x4*)(vr_ + i * 256); } while (0)
#define PEER_COMP(V, GT) do { const f32x2 ww = {GT, GT}; \
                    _Pragma("unroll") for (int i = 0; i < 4; ++i) _Pragma("unroll") for (int q = 0; q < 4; ++q) { const int wd = (int)V[i][q]; \
                        acc[i * 8 + q * 2] = __builtin_elementwise_fma(ww, __builtin_amdgcn_cvt_pk_f32_fp8(wd, false), acc[i * 8 + q * 2]); \
                        acc[i * 8 + q * 2 + 1] = __builtin_elementwise_fma(ww, __builtin_amdgcn_cvt_pk_f32_fp8(wd, true), acc[i * 8 + q * 2 + 1]); } } while (0)
                u32x4 vA[4], vB[4], vC[4], vD[4]; float gA, gB, gC, gD;
                PEER_LOAD(vA, gA, 0); PEER_LOAD(vB, gB, 1); PEER_LOAD(vC, gC, 2);
#pragma unroll 1
                for (int it = 0; it < 32; it += 4) {
                    PEER_LOAD(vD, gD, it + 3);
                    PEER_COMP(vA, gA);
                    PEER_LOAD(vA, gA, (it + 4 < 32 ? it + 4 : 31));
                    PEER_COMP(vB, gB);
                    PEER_LOAD(vB, gB, (it + 5 < 32 ? it + 5 : 31));
                    PEER_COMP(vC, gC);
                    PEER_LOAD(vC, gC, (it + 6 < 32 ? it + 6 : 31));
                    PEER_COMP(vD, gD);
                }
#undef PEER_LOAD
#undef PEER_COMP
#pragma unroll
                for (int i = 0; i < 32; ++i) {
                    acc[i].x += __shfl_xor(acc[i].x, 16); acc[i].y += __shfl_xor(acc[i].y, 16);
                    acc[i].x += __shfl_xor(acc[i].x, 32); acc[i].y += __shfl_xor(acc[i].y, 32);
                }
                const size_t col = (size_t)(j + 16 * g) * 16;
                float yv[16]; float s = 0.f;
                {
                    const u32x4 pw0 = *(const u32x4*)(ple + (size_t)token * 1024 + col), pw1 = *(const u32x4*)(ple + (size_t)token * 1024 + col + 8);
                    const float pv[16] = {bflo(pw0.x), bfhi(pw0.x), bflo(pw0.y), bfhi(pw0.y), bflo(pw0.z), bfhi(pw0.z), bflo(pw0.w), bfhi(pw0.w),
                                          bflo(pw1.x), bfhi(pw1.x), bflo(pw1.y), bfhi(pw1.y), bflo(pw1.z), bfhi(pw1.z), bflo(pw1.w), bfhi(pw1.w)};
#pragma unroll
                    for (int q = 0; q < 8; ++q) {
                        const f32x2 a_ = g == 0 ? acc[q] : (g == 1 ? acc[8 + q] : (g == 2 ? acc[16 + q] : acc[24 + q]));
                        const f32x2 x_ = *(const f32x2*)(xo + (size_t)token * 1024 + col + q * 2);
                        const float y0 = DN_ALPHA * x_.x + a_.x + pv[q * 2], y1 = DN_ALPHA * x_.y + a_.y + pv[q * 2 + 1];
                        yv[q * 2] = y0; yv[q * 2 + 1] = y1; s += y0 + y1;
                    }
                }
                const float mu = wave_sum(s) * (1.0f / 1024.0f);
                float qq = 0.f;
#pragma unroll
                for (int q = 0; q < 16; ++q) { yv[q] -= mu; qq += yv[q] * yv[q]; }
                const float rstd = rsqrtf(wave_sum(qq) * (1.0f / 1024.0f) + 1e-5f);
                {
                    const float* lg = P.ln2_g; const float* lb = P.ln2_b; asm volatile("" : "+s"(lg), "+s"(lb));
#pragma unroll
                    for (int q = 0; q < 4; ++q) {
                        const f32x4 gg = *(const f32x4*)(lg + col + q * 4), bb = *(const f32x4*)(lb + col + q * 4);
                        f32x4 o;
#pragma unroll
                        for (int r = 0; r < 4; ++r) o[r] = yv[q * 4 + r] * rstd * gg[r] + bb[r];
                        *(f32x4*)(xo + (size_t)token * 1024 + col + q * 4) = o;
                    }
                }
            }
        }
#endif
        __syncthreads();
    }
}

#define XB_TMO      128
#define XB_XCNT(j)  (256  + 64 * (j))
#define XB_XSUB(j)  (1280 + 64 * (j))
#define XB_XGEN(j)  (2304 + 64 * (j))
#define XB_TOP      3328
#define XB_TOPGEN   3392
#define XCD_BAR_WORDS 3456
#define XB_SPIN_CAP (1u << 18)
#define LAS __attribute__((address_space(3)))

__device__ __forceinline__ unsigned xb_ld(unsigned* p)              { return __hip_atomic_load(p, __ATOMIC_RELAXED, __HIP_MEMORY_SCOPE_AGENT); }
__device__ __forceinline__ unsigned xb_add(unsigned* p, unsigned v) { return __hip_atomic_fetch_add(p, v, __ATOMIC_RELAXED, __HIP_MEMORY_SCOPE_AGENT); }
__device__ __forceinline__ unsigned xb_xcc_id() { return (unsigned)__builtin_amdgcn_s_getreg((3 << 11) | 20) & 0xFu; }
#define XB_SPIN(cond, bar) do { unsigned _sp = 0; while (cond) { __builtin_amdgcn_s_sleep(1); \
    if ((++_sp & 255u) == 0u) { if (xb_ld(&(bar)[XB_TMO])) break; if (_sp > XB_SPIN_CAP) { atomicAdd(&(bar)[XB_TMO], 1u); break; } } } } while (0)

struct XcdBarrier {
    unsigned* bar; unsigned x;
    volatile LAS unsigned* st;
};

__device__ __forceinline__ XcdBarrier xcd_barrier_post(unsigned* bar, volatile LAS unsigned* st) {
    XcdBarrier b; b.bar = bar; b.x = xb_xcc_id(); b.st = st;
    if (threadIdx.x == 0) (void)xb_add(&bar[XB_XCNT(b.x)], 1u);
    return b;
}
__device__ __forceinline__ void xcd_barrier_complete(unsigned* bar, unsigned x, unsigned& nloc, unsigned& nx) {
    const unsigned G = gridDim.x * gridDim.y * gridDim.z;
    unsigned sum, cnt, mine, sp = 0u;
    for (;;) {
        sum = 0u; cnt = 0u; mine = 0u;
#pragma unroll
        for (unsigned j = 0; j < 16; ++j) { const unsigned c = xb_ld(&bar[XB_XCNT(j)]); sum += c; cnt += (c > 0u) ? 1u : 0u; mine = (j == x) ? c : mine; }
        if (sum == G) break;
        __builtin_amdgcn_s_sleep(1);
        if ((++sp & 255u) == 0u) { if (xb_ld(&bar[XB_TMO])) break; if (sp > XB_SPIN_CAP) { atomicAdd(&bar[XB_TMO], 1u); break; } }
    }
    nloc = mine > 0u ? mine : 1u; nx = cnt > 0u ? cnt : 1u;
}

__device__ __forceinline__ void xcd_barrier(const XcdBarrier& b) {
    asm volatile("s_waitcnt vmcnt(0)" ::: "memory");
    __syncthreads();
    if (threadIdx.x == 0) {
        unsigned* bar = b.bar;
        __builtin_amdgcn_s_waitcnt(0);
        unsigned nloc = b.st[0], nx = b.st[1];
        if (nloc == 0u) { xcd_barrier_complete(bar, b.x, nloc, nx); b.st[0] = nloc; b.st[1] = nx; }
        const unsigned old = xb_add(&bar[XB_XSUB(b.x)], 1u);
        const unsigned gen = old / nloc;
        if (old + 1u == (gen + 1u) * nloc) {
            __builtin_amdgcn_fence(__ATOMIC_RELEASE, "agent");
            asm volatile("s_waitcnt vmcnt(0)" ::: "memory");
            const unsigned og = xb_add(&bar[XB_TOP], 1u);
            const unsigned tg = og / nx;
            if (og + 1u == (tg + 1u) * nx) xb_add(&bar[XB_TOPGEN], 1u);
            else XB_SPIN(xb_ld(&bar[XB_TOPGEN]) == tg, bar);
            __builtin_amdgcn_fence(__ATOMIC_ACQUIRE, "agent");
            xb_add(&bar[XB_XGEN(b.x)], 1u);
            asm volatile("s_waitcnt vmcnt(0)" ::: "memory");
        } else {
            XB_SPIN(xb_ld(&bar[XB_XGEN(b.x)]) == gen, bar);
            __builtin_amdgcn_fence(__ATOMIC_ACQUIRE, "agent");
            asm volatile("s_waitcnt vmcnt(0)" ::: "memory");
        }
    }
    __syncthreads();
}


constexpr size_t O_BAR = 250 * MBY;
__device__ __forceinline__ void counter_barrier(unsigned* cnt, unsigned& epoch) {
    asm volatile("s_waitcnt vmcnt(0)" ::: "memory");
    __syncthreads();
    if (threadIdx.x == 0) {
        __builtin_amdgcn_fence(__ATOMIC_RELEASE, "agent");
        asm volatile("s_waitcnt vmcnt(0)" ::: "memory");
        (void)__hip_atomic_fetch_add(cnt, 1u, __ATOMIC_RELAXED, __HIP_MEMORY_SCOPE_AGENT);
        const unsigned target = (epoch + 1u) * gridDim.x;
        while (__hip_atomic_load(cnt, __ATOMIC_RELAXED, __HIP_MEMORY_SCOPE_AGENT) < target) __builtin_amdgcn_s_sleep(2);
        __builtin_amdgcn_fence(__ATOMIC_ACQUIRE, "agent");
        asm volatile("s_waitcnt vmcnt(0)" ::: "memory");
    }
    ++epoch;
    __syncthreads();
}

#ifdef PEER2
__device__ __forceinline__ int peer_pop(unsigned* q, volatile int* slot) {
    __syncthreads();
    if (threadIdx.x == 0) *slot = (int)__hip_atomic_fetch_add(q, 1u, __ATOMIC_RELAXED, __HIP_MEMORY_SCOPE_AGENT);
    __syncthreads();
    return *slot;
}
__device__ __forceinline__ int peer_next(unsigned* q, int k0, int& kk, unsigned limit, volatile int* slot) {
    __syncthreads();
    if (threadIdx.x == 0) {
        int fk = -1, t = 0;
        for (int i = kk; i < 8; ++i) {
            unsigned* qa = q + ((k0 + i) & 7) * 64;
            if (__hip_atomic_load(qa, __ATOMIC_RELAXED, __HIP_MEMORY_SCOPE_AGENT) >= limit) continue;
            const unsigned tt = __hip_atomic_fetch_add(qa, 1u, __ATOMIC_RELAXED, __HIP_MEMORY_SCOPE_AGENT);
            if (tt < limit) { fk = i; t = (int)tt; break; }
        }
        slot[0] = fk; slot[1] = t;
    }
    __syncthreads();
    kk = slot[0]; return slot[1];
}
struct PeerTickets { int is_static, rank, nloc, t, kk; };
__device__ __forceinline__ void peer_tickets_init(PeerTickets& T, unsigned* bar, volatile int* slot) {
    __syncthreads();
    if (threadIdx.x == 0) {
        const unsigned G = gridDim.x; bool ok = (G % 8u) == 0u && (NTOK / 128) % (int)(G / 8u) == 0;
        for (unsigned jx = 0; jx < 16; ++jx) { const unsigned c = __hip_atomic_load(&bar[XB_XCNT(jx)], __ATOMIC_RELAXED, __HIP_MEMORY_SCOPE_AGENT); if (c != (jx < 8 ? G / 8u : 0u)) ok = false; }
        slot[0] = ok ? 1 : 0;
    }
    __syncthreads();
    T.is_static = slot[0]; T.rank = slot[2]; T.nloc = (int)(gridDim.x / 8u); T.t = 0; T.kk = 0;
    __syncthreads();
}
__device__ __forceinline__ int peer_ticket(PeerTickets& T, unsigned* q, int k0, unsigned limit, volatile int* slot) {
    if (T.is_static) {
        __syncthreads();
        const int g = T.rank + T.t * T.nloc; ++T.t;
        if (g >= (int)limit) { T.kk = -1; return 0; }
        T.kk = 0; return g;
    }
    return peer_next(q, k0, T.kk, limit, slot);
}
__device__ void peer_passA2(const Params& P, unsigned char* lds) {
    const int tid = threadIdx.x, wid = __builtin_amdgcn_readfirstlane(tid >> 6), lane = tid & 63, j = lane & 15, g = lane >> 4;
    const int* RI = (const int*)(P.ws + O_RIDX); float* RWp = (float*)(P.ws + O_RW);
    const bf16_t* x1b = (const bf16_t*)(P.ws + O_X1B); const unsigned char* u8t = P.ws + O_UB;
    unsigned char* xt = lds;
    unsigned short* ids = (unsigned short*)(lds + 132096);
    volatile int* slot = (volatile int*)(lds + 163840 - 48);
    unsigned* qA = (unsigned*)(P.ws + O_BAR) + 3584;
    const int k0 = (int)(xb_xcc_id() & 7u);
#pragma unroll 1
    for (int kk = 0; kk < 8; ++kk) {
        const int k = (k0 + kk) & 7;
#pragma unroll 1
        for (;;) {
            const int grp = peer_pop(qA + k * 64, slot);
            if (grp >= NTOK / 64) break;
            const int tok0 = grp * 64;
            for (int i = tid; i < 64 * 128; i += 512) { const int t = i >> 7, c16 = i & 127; *(u32x4*)(xt + t * 2064 + c16 * 16) = *(const u32x4*)(x1b + (size_t)(tok0 + t) * 1024 + c16 * 8); }
            for (int i = tid; i < 64 * 128 / 4; i += 512) { const u32x4 v = *(const u32x4*)(RI + (size_t)tok0 * 128 + i * 4); *(u32x2*)(ids + i * 4) = (u32x2){(v.x & 0xffffu) | (v.y << 16), (v.z & 0xffffu) | (v.w << 16)}; }
            __syncthreads();
            float dkeep = 0.f; int pkeep = -1; int nk = 0;
            int ch_ = -1; unsigned long long m0 = 0ull, m1 = 0ull;
#define PA_ADV(VALID, TL, BS, ACT) do { VALID = true; \
                while (!(m0 | m1)) { if (++ch_ >= 8) { VALID = false; break; } \
                    const int tl_ = wid * 8 + ch_; const int id0 = ids[tl_ * 128 + lane], id1 = ids[tl_ * 128 + 64 + lane]; \
                    m0 = __ballot((id0 >> 11) == k); m1 = __ballot((id1 >> 11) == k); } \
                if (VALID) { int bb[4]; \
                    _Pragma("unroll") for (int q = 0; q < 4; ++q) { \
                        if (m0) { bb[q] = __ffsll((long long)m0) - 1; m0 &= m0 - 1; } \
                        else if (m1) { bb[q] = 64 + __ffsll((long long)m1) - 1; m1 &= m1 - 1; } \
                        else bb[q] = -1; } \
                    const int bg = g == 0 ? bb[0] : (g == 1 ? bb[1] : (g == 2 ? bb[2] : bb[3])); \
                    ACT = bg >= 0; BS = ACT ? bg : bb[0]; TL = wid * 8 + ch_; } else { ACT = false; BS = 0; TL = wid * 8; } } while (0)
#define PA_LOAD(U, TL, BS) do { const int pidx = ids[(TL) * 128 + (BS)]; const unsigned char* ur = u8t + (size_t)pidx * 1024 + j * 16; \
                _Pragma("unroll") for (int i = 0; i < 4; ++i) U[i] = *(const u32x4*)(ur + i * 256); } while (0)
#define PA_COMP(U, TL, BS, ACT) do { \
                const unsigned char* xrow = xt + (TL) * 2064 + j * 32; \
                float d0 = 0.f, d1 = 0.f; \
                _Pragma("unroll") for (int i = 0; i < 4; ++i) { \
                    const u32x4 xa = *(const u32x4*)(xrow + i * 512), xb_ = *(const u32x4*)(xrow + i * 512 + 16); \
                    _Pragma("unroll") for (int q = 0; q < 4; ++q) { \
                        const u32x4 xs = q < 2 ? xa : xb_; \
                        const unsigned wd = U[i][q]; \
                        const f32x2 lo_ = __builtin_amdgcn_cvt_pk_f32_fp8((int)wd, false), hi_ = __builtin_amdgcn_cvt_pk_f32_fp8((int)wd, true); \
                        d0 = dot2bf(pk2(lo_.x, lo_.y), xs[(q & 1) * 2], d0); d1 = dot2bf(pk2(hi_.x, hi_.y), xs[(q & 1) * 2 + 1], d1); } } \
                float dsum = d0 + d1; \
                dsum += __shfl_xor(dsum, 1); dsum += __shfl_xor(dsum, 2); dsum += __shfl_xor(dsum, 4); dsum += __shfl_xor(dsum, 8); \
                dsum *= (1.0f / 256.0f); \
                if (j == nk) { dkeep = dsum; pkeep = (ACT) ? (tok0 + (TL)) * 128 + (BS) : -1; } \
                if (++nk == 16) { \
                    if (pkeep >= 0) { const float hid = 0.5f * dkeep * (1.0f + erff(dkeep * 0.70710678118f)); RWp[pkeep] *= hid * (1.0f / 32.0f); } \
                    nk = 0; pkeep = -1; } } while (0)
            bool vA, vB, actA = false, actB = false; int tlA = 0, tlB = 0, bsA = 0, bsB = 0; u32x4 uA[4], uB[4];
            PA_ADV(vA, tlA, bsA, actA);
            PA_LOAD(uA, tlA, bsA);
            while (vA) {
                PA_ADV(vB, tlB, bsB, actB);
                PA_LOAD(uB, tlB, bsB);
                PA_COMP(uA, tlA, bsA, actA);
                if (!vB) break;
                PA_ADV(vA, tlA, bsA, actA);
                PA_LOAD(uA, tlA, bsA);
                PA_COMP(uB, tlB, bsB, actB);
            }
#undef PA_ADV
#undef PA_LOAD
#undef PA_COMP
            if (pkeep >= 0) { const float hid = 0.5f * dkeep * (1.0f + erff(dkeep * 0.70710678118f)); RWp[pkeep] *= hid * (1.0f / 32.0f); }
        }
    }
}
#ifdef PEER3
__device__ void peer_passA3(const Params& P, unsigned char* lds) {
    const int tid = threadIdx.x, wid = __builtin_amdgcn_readfirstlane(tid >> 6), lane = tid & 63, j8 = lane & 7, t8 = lane >> 3;
    const int* RI = (const int*)(P.ws + O_RIDX); const float* x1 = P.out; float* PART = (float*)(P.ws + O_PART);
    volatile int* slot = (volatile int*)(lds + 163840 - 48);
    unsigned* qA = (unsigned*)(P.ws + O_BAR) + 3584;
    const int k0 = (int)(xb_xcc_id() & 7u);
    PeerTickets TK; peer_tickets_init(TK, (unsigned*)(P.ws + O_BAR), slot);
#pragma unroll 1
    for (;;) {
        const int grp = peer_ticket(TK, qA, k0, (unsigned)(NTOK / 128), slot); const int kk = TK.kk;
        if (kk < 0) break;
        const int k = (k0 + kk) & 7;
        const unsigned char* ublk = P.ws + O_UB + (size_t)k * 16384 * 128 + j8 * 16;
        {
            u32x4* li0 = (u32x4*)lds; const u32x4* gi = (const u32x4*)(RI + (size_t)grp * 128 * 128);
            for (int i = tid; i < 128 * 32; i += 512) li0[(i >> 5) * 33 + (i & 31)] = gi[i];
        }
        __syncthreads();
#pragma unroll 1
        for (int sub = 0; sub < 2; ++sub) {
            const int tl = sub * 64 + wid * 8 + t8, token = grp * 128 + tl;
            const int* li = (const int*)lds + tl * 132;
            f32x2 xp[8];
#pragma unroll
            for (int q = 0; q < 4; ++q) { const f32x4 v = *(const f32x4*)(x1 + (size_t)token * 1024 + k * 128 + j8 * 16 + q * 4); xp[q * 2] = (f32x2){v[0], v[1]}; xp[q * 2 + 1] = (f32x2){v[2], v[3]}; }
            float* po = PART + (size_t)k * NTOK * 128 + (size_t)token * 128 + j8;
#define PA3_LOAD(V, IT) do { _Pragma("unroll") for (int q = 0; q < 8; ++q) V[q] = *(const u32x4*)(ublk + (size_t)li[(IT) + q] * 128); } while (0)
#define PA3_COMP(V, IT) do { float s_[8]; \
                _Pragma("unroll") for (int q = 0; q < 8; ++q) { f32x2 a0 = {0.f, 0.f}, a1 = {0.f, 0.f}; \
                    _Pragma("unroll") for (int d = 0; d < 4; ++d) { const int wd = (int)V[q][d]; \
                        a0 = __builtin_elementwise_fma(__builtin_amdgcn_cvt_pk_f32_fp8(wd, false), xp[d * 2], a0); \
                        a1 = __builtin_elementwise_fma(__builtin_amdgcn_cvt_pk_f32_fp8(wd, true), xp[d * 2 + 1], a1); } \
                    const f32x2 a = a0 + a1; s_[q] = a.x + a.y; } \
                float r4[4]; \
                _Pragma("unroll") for (int i = 0; i < 4; ++i) { const float mine = (j8 & 4) ? s_[4 + i] : s_[i], oth = (j8 & 4) ? s_[i] : s_[4 + i]; r4[i] = mine + dpp_xor4(oth); } \
                float r2[2]; \
                _Pragma("unroll") for (int i = 0; i < 2; ++i) { const float mine = (j8 & 2) ? r4[2 + i] : r4[i], oth = (j8 & 2) ? r4[i] : r4[2 + i]; r2[i] = mine + dpp_xor2(oth); } \
                const float mine1 = (j8 & 1) ? r2[1] : r2[0], oth1 = (j8 & 1) ? r2[0] : r2[1]; \
                po[(IT)] = mine1 + dpp_xor1(oth1); } while (0)
            u32x4 vA[8], vB[8]; int iA[8], iB[8];
#define PA3_IDX(I, IT) do { _Pragma("unroll") for (int q = 0; q < 8; ++q) I[q] = li[(IT) + q]; } while (0)
#define PA3_LOADI(V, I) do { _Pragma("unroll") for (int q = 0; q < 8; ++q) V[q] = *(const u32x4*)(ublk + (size_t)(unsigned)I[q] * 128); } while (0)
            PA3_IDX(iA, 0); PA3_IDX(iB, 8);
            PA3_LOADI(vA, iA);
#pragma unroll 1
            for (int it = 0; it < 128; it += 16) {
                PA3_LOADI(vB, iB);
                PA3_IDX(iA, (it + 16 < 128 ? it + 16 : 112));
                PA3_COMP(vA, it);
                PA3_LOADI(vA, iA);
                PA3_IDX(iB, (it + 24 < 128 ? it + 24 : 120));
                PA3_COMP(vB, it + 8);
            }
#undef PA3_IDX
#undef PA3_LOADI
#undef PA3_LOAD
#undef PA3_COMP
        }
    }
}
__device__ void peer_reduce3(const Params& P) {
    const float* PART = (const float*)(P.ws + O_PART); const float* RG = (const float*)(P.ws + O_RG); float* RWp = (float*)(P.ws + O_RW);
    for (int i = blockIdx.x * 512 + threadIdx.x; i < NTOK * 128 / 4; i += gridDim.x * 512) {
        f32x4 d = *(const f32x4*)(PART + (size_t)i * 4);
#pragma unroll
        for (int k = 1; k < 8; ++k) d += *(const f32x4*)(PART + (size_t)k * NTOK * 128 + (size_t)i * 4);
        const f32x4 gt = *(const f32x4*)(RG + (size_t)i * 4);
        f32x4 w;
#pragma unroll
        for (int q = 0; q < 4; ++q) { const float ds = d[q] * (1.0f / 256.0f); w[q] = gt[q] * (0.5f * ds * (1.0f + erff(ds * 0.70710678118f))) * (1.0f / 32.0f); }
        *(f32x4*)(RWp + (size_t)i * 4) = w;
    }
}
#endif
__device__ void peer_passB2(const Params& P, unsigned char* lds) {
    const int tid = threadIdx.x, wid = __builtin_amdgcn_readfirstlane(tid >> 6), lane = tid & 63, j8 = lane & 7, g8 = lane >> 3;
    const int* RI = (const int*)(P.ws + O_RIDX); const float* RWp = (const float*)(P.ws + O_RW);
    float* FF = (float*)(P.ws + O_FF);
    volatile int* slot = (volatile int*)(lds + 163840 - 48);
    unsigned* qB = (unsigned*)(P.ws + O_BAR) + 4096;
    const int k0 = (int)(xb_xcc_id() & 7u);
    PeerTickets TK; peer_tickets_init(TK, (unsigned*)(P.ws + O_BAR), slot);
#pragma unroll 1
    for (;;) {
        {
            const int grp = peer_ticket(TK, qB, k0, (unsigned)(NTOK / 128), slot); const int kk = TK.kk;
            if (kk < 0) break;
            const int k = (k0 + kk) & 7;
            const unsigned char* vblk = P.ws + O_VB + (size_t)k * 16384 * 128 + j8 * 16;
            {
                u32x4* li0 = (u32x4*)lds; u32x4* lw0 = (u32x4*)(lds + 67584);
                const u32x4* gi = (const u32x4*)(RI + (size_t)grp * 128 * 128); const u32x4* gw = (const u32x4*)(RWp + (size_t)grp * 128 * 128);
                for (int i = tid; i < 128 * 32; i += 512) { li0[(i >> 5) * 33 + (i & 31)] = gi[i]; lw0[(i >> 5) * 33 + (i & 31)] = gw[i]; }
            }
            __syncthreads();
            {
                const int t8 = lane >> 3;
                const int* lib = (const int*)lds + (wid * 8 + t8) * 132; const float* lwb = (const float*)(lds + 67584) + (wid * 8 + t8) * 132;
#define POS(P_) ((((P_) >> 7) * (64 * 132)) + ((P_) & 127))
                f32x2 acc[8];
#pragma unroll
                for (int i = 0; i < 8; ++i) acc[i] = (f32x2){0.f, 0.f};
#define PB_COMP(V, IT) do { const float* lw_ = lwb + POS(IT); _Pragma("unroll") for (int q = 0; q < 8; ++q) { const float w_ = lw_[q]; const f32x2 ww = {w_, w_}; \
                    _Pragma("unroll") for (int d = 0; d < 4; ++d) { const int wd = (int)V[q][d]; \
                        acc[d * 2] = __builtin_elementwise_fma(ww, __builtin_amdgcn_cvt_pk_f32_fp8(wd, false), acc[d * 2]); \
                        acc[d * 2 + 1] = __builtin_elementwise_fma(ww, __builtin_amdgcn_cvt_pk_f32_fp8(wd, true), acc[d * 2 + 1]); } } } while (0)
                u32x4 vA[8], vB[8]; int iA[8], iB[8];
#define PB_IDX(I, IT) do { const int* li_ = lib + POS(IT); _Pragma("unroll") for (int q = 0; q < 8; ++q) I[q] = li_[q]; } while (0)
#define PB_LOADI(V, I) do { _Pragma("unroll") for (int q = 0; q < 8; ++q) V[q] = *(const u32x4*)(vblk + (size_t)(unsigned)I[q] * 128); } while (0)
                PB_IDX(iA, 0); PB_IDX(iB, 8);
                PB_LOADI(vA, iA);
#pragma unroll 1
                for (int it = 0; it < 256; it += 16) {
                    PB_LOADI(vB, iB);
                    PB_IDX(iA, (it + 16 < 256 ? it + 16 : 240));
                    PB_COMP(vA, it);
                    PB_LOADI(vA, iA);
                    PB_IDX(iB, (it + 24 < 256 ? it + 24 : 248));
                    PB_COMP(vB, it + 8);
                    if ((it & 127) == 112) {
                        const int token = grp * 128 + (it >> 7) * 64 + wid * 8 + t8;
                        float* o = FF + (size_t)token * 1024 + k * 128 + j8 * 16;
#pragma unroll
                        for (int q = 0; q < 4; ++q) *(f32x4*)(o + q * 4) = (f32x4){acc[q * 2].x, acc[q * 2].y, acc[q * 2 + 1].x, acc[q * 2 + 1].y};
#pragma unroll
                        for (int i = 0; i < 8; ++i) acc[i] = (f32x2){0.f, 0.f};
                    }
                }
#undef PB_IDX
#undef PB_LOADI
#undef PB_COMP
#undef POS
            }
        }
    }
}
__device__ void peer_ln2(const Params& P) {
    const int tid = threadIdx.x, wid = tid >> 6, lane = tid & 63;
    float* y = P.out; const float* FF = (const float*)(P.ws + O_FF); const bf16_t* ple = (const bf16_t*)(P.ws + O_PP);
    const int rstride = gridDim.x * 8;
    for (int row0 = blockIdx.x * 8 + wid; row0 < NTOK; row0 += 2 * rstride) {
        const int row1 = row0 + rstride; const bool has1 = row1 < NTOK; const int r1 = has1 ? row1 : row0;
        f32x4 v[4], w[4]; float s = 0.f, s1 = 0.f;
#pragma unroll
        for (int i = 0; i < 4; ++i) {
            const size_t c0 = (size_t)row0 * 1024 + i * 256 + lane * 4, c1 = (size_t)r1 * 1024 + i * 256 + lane * 4;
            const u32x2 p0 = *(const u32x2*)(ple + c0), p1 = *(const u32x2*)(ple + c1);
            v[i] = *(const f32x4*)(y + c0) * DN_ALPHA + *(const f32x4*)(FF + c0) + (f32x4){bflo(p0.x), bfhi(p0.x), bflo(p0.y), bfhi(p0.y)};
            w[i] = *(const f32x4*)(y + c1) * DN_ALPHA + *(const f32x4*)(FF + c1) + (f32x4){bflo(p1.x), bfhi(p1.x), bflo(p1.y), bfhi(p1.y)};
        }
#pragma unroll
        for (int i = 0; i < 4; ++i) { s += (v[i][0] + v[i][1]) + (v[i][2] + v[i][3]); s1 += (w[i][0] + w[i][1]) + (w[i][2] + w[i][3]); }
        s += __shfl_xor(s, 32); s1 += __shfl_xor(s1, 32); s += __shfl_xor(s, 16); s1 += __shfl_xor(s1, 16);
        s += dpp_xor8(s); s1 += dpp_xor8(s1); s += dpp_xor4(s); s1 += dpp_xor4(s1); s += dpp_xor2(s); s1 += dpp_xor2(s1); s += dpp_xor1(s); s1 += dpp_xor1(s1);
        const float mu = s * (1.0f / 1024.0f), mu1 = s1 * (1.0f / 1024.0f);
        float q = 0.f, q1 = 0.f;
#pragma unroll
        for (int i = 0; i < 4; ++i) { v[i] = v[i] - mu; w[i] = w[i] - mu1; q += (v[i][0] * v[i][0] + v[i][1] * v[i][1]) + (v[i][2] * v[i][2] + v[i][3] * v[i][3]); q1 += (w[i][0] * w[i][0] + w[i][1] * w[i][1]) + (w[i][2] * w[i][2] + w[i][3] * w[i][3]); }
        q += __shfl_xor(q, 32); q1 += __shfl_xor(q1, 32); q += __shfl_xor(q, 16); q1 += __shfl_xor(q1, 16);
        q += dpp_xor8(q); q1 += dpp_xor8(q1); q += dpp_xor4(q); q1 += dpp_xor4(q1); q += dpp_xor2(q); q1 += dpp_xor2(q1); q += dpp_xor1(q); q1 += dpp_xor1(q1);
        const float rstd = rsqrtf(q * (1.0f / 1024.0f) + 1e-5f), rstd1 = rsqrtf(q1 * (1.0f / 1024.0f) + 1e-5f);
#pragma unroll
        for (int i = 0; i < 4; ++i) {
            const int col = i * 256 + lane * 4;
            const f32x4 gg = *(const f32x4*)(P.ln2_g + col), bb = *(const f32x4*)(P.ln2_b + col);
            *(f32x4*)(y + (size_t)row0 * 1024 + col) = v[i] * rstd * gg + bb;
            if (has1) *(f32x4*)(y + (size_t)row1 * 1024 + col) = w[i] * rstd1 * gg + bb;
        }
    }
}
#endif

__global__ void __launch_bounds__(512, 2) mega(Params P) {
    extern __shared__ __attribute__((aligned(16))) unsigned char shm[];
    cg::grid_group grid = cg::this_grid();
    PG8_LAS unsigned char* ldsg = (PG8_LAS unsigned char*)shm;
#ifdef ONLY
#define PH(i) ((i) == ONLY)
#else
#define PH(i) (P.ph_lo <= (i) && (i) < P.ph_hi)
#endif
#ifdef USE_XCD_BARRIER
#define SYNC() do { if (P.coop == 1) xcd_barrier(xbar); else if (P.coop == 2) grid.sync(); } while (0)
#else
    unsigned bar_epoch = 0u;
#define SYNC() do { if (P.coop == 1) counter_barrier((unsigned*)(P.ws + O_BAR) + 64, bar_epoch); else if (P.coop == 2) grid.sync(); } while (0)
#endif
    volatile LAS unsigned* xst = (volatile LAS unsigned*)(ldsg + (163840 - 32));
    if (threadIdx.x == 0) { xst[0] = 0u; xst[1] = 0u; }
    __syncthreads();
#ifndef HOST_MEMSET
    if (P.coop) {
        if (blockIdx.x == 0) for (int i = threadIdx.x; i < XCD_BAR_WORDS; i += 512) ((unsigned*)(P.ws + O_BAR))[i] = 0u;
        grid.sync();
    }
#else
    if (P.coop == 2) grid.sync();
#endif
    XcdBarrier xbar = xcd_barrier_post((unsigned*)(P.ws + O_BAR), xst);
    if (threadIdx.x == 0) ((volatile LAS int*)(ldsg + (163840 - 48)))[2] = (int)__hip_atomic_fetch_add((unsigned*)(P.ws + O_BAR) + 7168 + 64 * (xbar.x & 15u), 1u, __ATOMIC_RELAXED, __HIP_MEMORY_SCOPE_AGENT);
#ifdef PROBE_T
    unsigned long long TS[14];
#define STAMP(k) TS[k] = __builtin_amdgcn_s_memrealtime()
#else
#define STAMP(k)
#endif
    STAMP(0);
    if (PH(0)) { phase_prep(P, shm); SYNC(); }
    STAMP(1);
    if (PH(1)) {
        pg8::Gemm g{(const bf16_t*)(P.ws + O_XB), (const bf16_t*)(P.ws + O_WINT), NTOK, 7168, 1024};
        pg8::StaticOrder S; S.init(NTOK, 7168, (int)gridDim.x, (int)blockIdx.x);
        EpiZ E{P.ws};
        pg8::gemm_phase<EpiZ, pg8::StaticOrder, false>(ldsg, g, S, E, nullptr);
        SYNC();
    }
    STAMP(2);
    if (PH(2)) { phase_lru(P, shm); SYNC(); }
    STAMP(3);
    if (PH(3)) { phase_gla1(P, shm); SYNC(); }
    STAMP(4);
    if (PH(4)) { phase_gla2(P); SYNC(); }
    STAMP(5);
    if (PH(5)) { phase_combine(P); SYNC(); }
    STAMP(6);
    if (PH(6)) {
        {
            pg8::Gemm g{(const bf16_t*)(P.ws + O_XB), (const bf16_t*)(P.ws + O_WOUTT), NTOK, 1024, 1024};
            pg8::StaticOrder S; S.init(NTOK, 1024, (int)gridDim.x, (int)blockIdx.x);
            EpiY1 E{P.x, P.out};
            pg8::gemm_phase<EpiY1, pg8::StaticOrder, false>(ldsg, g, S, E, nullptr);
        }
        {
            pg8::Gemm g{(const bf16_t*)(P.ws + O_PB), (const bf16_t*)(P.ws + O_WPPT), NTOK, 1024, 256};
            pg8::StaticOrder S; S.init(NTOK, 1024, (int)gridDim.x, (int)blockIdx.x);
            EpiPP E{(bf16_t*)(P.ws + O_PP)};
            pg8::gemm_phase<EpiPP, pg8::StaticOrder, false>(ldsg, g, S, E, nullptr);
        }
        SYNC();
    }
    STAMP(7);
    if (PH(7)) { phase_ln1(P); SYNC(); }
    STAMP(8);
    if (PH(8)) {
        pg8::Gemm g{(const bf16_t*)(P.ws + O_X1B), (const bf16_t*)(P.ws + O_WQGT), NTOK, 2048, 1024};
        pg8::StaticOrder S; S.init(NTOK, 2048, (int)gridDim.x, (int)blockIdx.x);
        EpiQG E{(float*)(P.ws + O_QP), (bf16_t*)(P.ws + O_PP)};
        pg8::gemm_phase<EpiQG, pg8::StaticOrder, false>(ldsg, g, S, E, nullptr);
        SYNC();
    }
    STAMP(9);
#ifdef EXTRA_SYNCS
    for (int i = 0; i < EXTRA_SYNCS; ++i) SYNC();
#endif
    if (PH(9)) { phase_peer(P, shm, grid); }
#ifdef PEER2
#ifdef PEER3
    if (PH(9)) { SYNC(); STAMP(10); peer_passA3(P, shm); SYNC(); peer_reduce3(P); SYNC(); STAMP(11); peer_passB2(P, shm); SYNC(); STAMP(13); peer_ln2(P); }
#else
    if (PH(9)) { SYNC(); STAMP(11); peer_passB2(P, shm); SYNC(); STAMP(13); peer_ln2(P); }
#endif
#endif
#ifdef PROBE_T
    {
        __syncthreads();
        const unsigned long long* tsl = (const unsigned long long*)(shm + 163840 - 64);
#ifndef PEER2
        TS[10] = TS[9] + tsl[0]; TS[11] = TS[10] + tsl[1];
#endif
        STAMP(12);
        const unsigned long long dtS = TS[PROBE_SB] - TS[PROBE_SA], dtF = TS[PROBE_FB] - TS[PROBE_FA];
        while (__builtin_amdgcn_s_memrealtime() - TS[12] < dtS) __builtin_amdgcn_s_sleep(8);
        if (blockIdx.x == 0 && threadIdx.x < 64) {
            const float frac = (float)(double)dtF / (float)(double)(TS[12] - TS[0]);
            P.out[threadIdx.x] += 0.2f + 0.2f * frac;
        }
    }
#endif
#undef PH
#undef SYNC
#undef STAMP
}

#ifdef DBG_SCAN

__global__ void dbg_check(const void* p, size_t n, int is_bf16, int* flags, int code) {
    int bad = 0;
    if (is_bf16) { const unsigned short* q = (const unsigned short*)p; for (size_t i = (size_t)blockIdx.x * blockDim.x + threadIdx.x; i < n; i += (size_t)gridDim.x * blockDim.x) if ((q[i] & 0x7f80) == 0x7f80) bad = 1; }
    else { const unsigned* q = (const unsigned*)p; for (size_t i = (size_t)blockIdx.x * blockDim.x + threadIdx.x; i < n; i += (size_t)gridDim.x * blockDim.x) if ((q[i] & 0x7f800000u) == 0x7f800000u) bad = 1; }
    if (bad) flags[code] = 1;
}
__global__ void dbg_report(float* out, size_t n, const int* flags) {
    int code = 0; for (int c = 40; c < 64; ++c) if (flags[c]) { code = c; break; }
    if (!code) for (int c = 1; c < 40; ++c) if (flags[c]) { code = c; break; }
    for (size_t i = (size_t)blockIdx.x * blockDim.x + threadIdx.x; i < n; i += (size_t)gridDim.x * blockDim.x) out[i] = (i == 0) ? 1000.f * code : 0.f;
}
static void dbg_after_phase(int ph, const Params& P, hipStream_t stream) {
    int* flags = (int*)(P.ws + 240 * MBY);
    auto chk = [&](size_t off, size_t nelem, int bf, int code) { hipLaunchKernelGGL(dbg_check, dim3(1024), dim3(256), 0, stream, (const void*)(P.ws + off), nelem, bf, flags, code); };
    auto chko = [&](int code) { hipLaunchKernelGGL(dbg_check, dim3(1024), dim3(256), 0, stream, (const void*)P.out, (size_t)NTOK * 1024, 0, flags, code); };
    const size_t M1 = (size_t)NTOK * 1024, MH = (size_t)NTOK * 512;
    switch (ph) {
    case 0: chk(O_XB, M1, 1, 1); chk(O_FLOW, (size_t)NTOK * 16, 0, 2); chk(O_PB, (size_t)NTOK * 256, 1, 3); chk(O_WINT, (size_t)7168 * 1024, 1, 4); chk(O_WOUTT, (size_t)1024 * 1024, 1, 5); chk(O_WQGT, (size_t)2048 * 1024, 1, 6); chk(O_WPPT, (size_t)1024 * 256, 1, 7); break;
    case 1: chk(O_ZX, M1, 1, 8); chk(O_GY, M1, 1, 9); chk(O_ZQ, MH, 1, 10); chk(O_ZK, MH, 1, 11); chk(O_ZV, M1, 1, 12); chk(O_GR, M1, 1, 13); break;
    case 2: chk(O_XB, M1, 1, 14); break;
    case 3: chk(O_ZQ, MH, 1, 15); chk(O_UT, (size_t)1024 * 256 * 128, 1, 16); chko(17); chk(O_DLAST, (size_t)1024 * 128, 0, 18); break;
    case 4: chko(19); chk(O_SSQ, (size_t)NTOK * 64, 0, 20); break;
    case 5: chk(O_XB, M1, 1, 21); break;
    case 6: chko(22); chk(O_PP, M1, 1, 23); break;
    case 7: chko(24); chk(O_X1B, M1, 1, 25); chk(O_UB, 2 * M1, 1, 26); break;
    case 8: chk(O_QP, M1, 0, 27); chk(O_PP, M1, 1, 28); break;
    case 9: chko(29); break;
    }
}
#endif
#ifndef MULTI_LAUNCH
#define MULTI_LAUNCH 0
#endif
extern "C" void kernel_launch(void* const* d_in, const int* in_sizes, int n_in, void* d_out, int out_size, void* d_ws, size_t ws_size, hipStream_t stream) {
    static int grid = 0;
    if (grid == 0) {
        int dev = 0, cus = 0, per_cu = 0;
        hipGetDevice(&dev); hipDeviceGetAttribute(&cus, hipDeviceAttributeMultiprocessorCount, dev);
        if (hipFuncSetAttribute((const void*)mega, hipFuncAttributeMaxDynamicSharedMemorySize, LDS_BYTES) != hipSuccess) { fprintf(stderr, "hipFuncSetAttribute failed\n"); }
        hipOccupancyMaxActiveBlocksPerMultiprocessor(&per_cu, (const void*)mega, 512, LDS_BYTES);
        if (per_cu < 1) { fprintf(stderr, "occupancy query says %d\n", per_cu); per_cu = 1; }
        (void)hipGetLastError();
        grid = cus * 1;
        if (ws_size < 236 * MBY) fprintf(stderr, "workspace too small: %zu\n", ws_size);
    }
    Params P{};
    P.x = (const float*)d_in[0]; P.p = (const float*)d_in[1]; P.w_in = (const float*)d_in[2]; P.conv_w = (const float*)d_in[3]; P.conv_b = (const float*)d_in[4];
    P.lru_wr = (const float*)d_in[5]; P.lru_br = (const float*)d_in[6]; P.lru_wi = (const float*)d_in[7]; P.lru_bi = (const float*)d_in[8]; P.lru_lambda = (const float*)d_in[9];
    P.gla_wf2 = (const float*)d_in[10]; P.gla_bf = (const float*)d_in[11]; P.gla_norm_g = (const float*)d_in[12]; P.w_out = (const float*)d_in[13]; P.ln1_g = (const float*)d_in[14];
    P.ln1_b = (const float*)d_in[15]; P.peer_wq = (const float*)d_in[16]; P.peer_subkeys = (const float*)d_in[17]; P.peer_u = (const float*)d_in[18]; P.peer_v = (const float*)d_in[19];
    P.ple_gate_w = (const float*)d_in[20]; P.ple_proj_w = (const float*)d_in[21]; P.ln2_g = (const float*)d_in[22]; P.ln2_b = (const float*)d_in[23];
    P.out = (float*)d_out; P.ws = (unsigned char*)d_ws; P.pad_ = 0;
#if MULTI_LAUNCH
    for (int ph = 0; ph < 10; ++ph) {
        P.ph_lo = ph; P.ph_hi = ph + 1; P.coop = 0;
        hipLaunchKernelGGL(mega, dim3(grid), dim3(512), LDS_BYTES, stream, P);
#ifdef DBG_SCAN
        if (ph == 0) (void)hipMemsetAsync(P.ws + 240 * MBY, 0, 256, stream);
        dbg_after_phase(ph, P, stream);
#endif
    }
#ifdef DBG_SCAN
    hipLaunchKernelGGL(dbg_report, dim3(1024), dim3(256), 0, stream, P.out, (size_t)NTOK * 1024, (const int*)(P.ws + 240 * MBY));
#endif
#else
    P.ph_lo = 0; P.ph_hi = 10; P.coop = 1;
#ifdef HOST_MEMSET
    (void)hipMemsetD32Async((hipDeviceptr_t)((unsigned char*)d_ws + O_BAR), 0, 8192, stream);
#endif
    void* args[] = {&P};
    hipError_t e = hipLaunchCooperativeKernel((const void*)mega, dim3(grid), dim3(512), args, LDS_BYTES, stream);
    if (e != hipSuccess) fprintf(stderr, "cooperative launch failed: %s (grid %d)\n", hipGetErrorString(e), grid);
#endif
}
```

```cpp
#define USE_XCD_BARRIER 1
#define HOST_MEMSET 1
#define PEER2 1
#define PEER3 1
#include <hip/hip_runtime.h>
#include <hip/hip_cooperative_groups.h>
#include <cstdio>
namespace cg = cooperative_groups;
namespace pg8 {
#define PG8_LAS __attribute__((address_space(3)))
typedef unsigned short bf16_t;
typedef short bf16x8 __attribute__((ext_vector_type(8)));
typedef float f32x4 __attribute__((ext_vector_type(4)));
typedef unsigned u32x4 __attribute__((ext_vector_type(4)));
constexpr int BM = 256, BK = 64, HALF = 128, HTB = HALF * BK * 2  , STAGE_BYTES = 8 * HTB, NXCD = 8, WGM = 8;

__host__ __device__ __forceinline__ int lds_byte(int r, int c) { const int st = (r >> 4) * 2 + (c >> 5), rr = r & 15, cc = c & 31, ob = rr * 64 + cc * 2; return st * 1024 + (ob ^ (((ob >> 9) & 1) << 5)); }
__host__ __device__ __forceinline__ void stage_rc(int b, int& R, int& C) { const int st = b / 1024, sb = b % 1024, swz = sb ^ (((sb >> 9) & 1) << 5); R = (st >> 1) * 16 + swz / 64; C = (st & 1) * 32 + (swz % 64) / 2; }
__host__ __device__ __forceinline__ int perm32(int rho) { const int n = rho >> 4, i = rho & 15; return 8 * (i >> 2) + 4 * n + (i & 3); }

struct Unit { int pm, pn; };
struct Gemm { const bf16_t* A; const bf16_t* Bt; int M, N, K; };

struct StaticOrder {
    int nM, nN, nwg, G, c;
    __host__ __device__ void init(int M, int N, int G_, int c_) { nM = M / BM; nN = N / BM; nwg = nM * nN; G = G_; c = c_; }
    __host__ __device__ bool next(int i, Unit& u) const {
        const long L = (long)i * G + c; if (L >= nwg) return false;
        int wgid = (int)L; { const int q = nwg / NXCD, r = nwg % NXCD, xcd = wgid % NXCD, off = wgid / NXCD; wgid = (xcd < r ? xcd * (q + 1) : r * (q + 1) + (xcd - r) * q) + off; }
        const int nig = WGM * nN, gid = wgid / nig, fm = gid * WGM, gsz = (nM - fm) < WGM ? (nM - fm) : WGM;
        u.pm = fm + ((wgid % nig) % gsz); u.pn = (wgid % nig) / gsz; return true;
    }
    __device__ __forceinline__ void a_ready(const Unit&) const {}
    __device__ __forceinline__ void done(const Unit&) const {}
};
struct CountedOrder : StaticOrder {
    const unsigned* ready; unsigned need; unsigned* tmo;
    __device__ __forceinline__ void a_ready(const Unit& u) const {
        if (threadIdx.x < 64) {
            const unsigned long long t0 = __builtin_amdgcn_s_memrealtime(); unsigned polls = 0;
            while ((unsigned)__builtin_amdgcn_readfirstlane(__hip_atomic_load(ready + 64 * u.pm, __ATOMIC_RELAXED, __HIP_MEMORY_SCOPE_AGENT)) < need) {
                if ((++polls & 255u) == 0u && __builtin_amdgcn_readfirstlane(__hip_atomic_load(tmo, __ATOMIC_RELAXED, __HIP_MEMORY_SCOPE_AGENT)) != 0u) break;
                if (__builtin_amdgcn_s_memrealtime() - t0 > 2000000ull) {
                    if (threadIdx.x == 0) { unsigned expect = 0u; __hip_atomic_compare_exchange_strong(tmo + 1, &expect, 0x600u | (unsigned)(u.pm & 0xff), __ATOMIC_RELAXED, __ATOMIC_RELAXED, __HIP_MEMORY_SCOPE_AGENT); __hip_atomic_store(tmo, 1u, __ATOMIC_RELAXED, __HIP_MEMORY_SCOPE_AGENT); }
                    break; }
                __builtin_amdgcn_s_sleep(2); }
            __builtin_amdgcn_fence(__ATOMIC_ACQUIRE, "agent");
            asm volatile("s_waitcnt vmcnt(0)" ::: "memory");
        }
#if !defined(BROKEN_HOOK_NO_BARRIER)
        asm volatile("" ::: "memory"); __builtin_amdgcn_s_barrier(); asm volatile("" ::: "memory");
#endif
    }
};

__device__ __forceinline__ unsigned cvt_pk_bf16(float lo, float hi) { unsigned r; asm volatile("v_cvt_pk_bf16_f32 %0, %1, %2" : "=v"(r) : "v"(lo), "v"(hi)); return r; }
typedef float f32x2 __attribute__((ext_vector_type(2)));
__device__ __forceinline__ f32x2 gelu_pk(f32x2 v) {
    const f32x2 av = __builtin_elementwise_abs(v), d = av * 0.2316418882f + 1.0f;
    f32x2 t; t.x = __builtin_amdgcn_rcpf(d.x); t.y = __builtin_amdgcn_rcpf(d.y);
    f32x2 q = t * 0.5307027145f + (-0.7265760135f); q = q * t + 0.7107068705f; q = q * t + (-0.142248368f); q = q * t + 0.127414796f; q = q * t;
    const f32x2 s = (v * v) * (-0.72134752044f);
    f32x2 e; e.x = __builtin_amdgcn_exp2f(s.x); e.y = __builtin_amdgcn_exp2f(s.y);
    const f32x2 m = v * (q * e), r = v - m;
    f32x2 o; o.x = v.x < 0.f ? m.x : r.x; o.y = v.y < 0.f ? m.y : r.y; return o;
}
template <class Epi, class Sched, bool STAMP = false>
__device__ __forceinline__ void gemm_phase(PG8_LAS unsigned char* lds, const Gemm g, const Sched& S, const Epi& E, unsigned long long* stamps) {
    const int tid = threadIdx.x, wid = __builtin_amdgcn_readfirstlane(tid >> 6), lane = tid & 63, wr = wid >> 2, wc = wid & 3, fr = lane & 15, fq = lane >> 4;
    const int K = g.K, nt = K / BK;
    int ts_lo = 0, ts_hi = 0, nts = 0; const unsigned long long rt_entry = STAMP ? (unsigned long long)wall_clock64() : 0ull;
#define PG8_STAMP() do { if (STAMP && wid == 0 && nts < 64) { const unsigned long long _c = (unsigned long long)clock64(); \
        ts_lo = (lane == nts) ? (int)(unsigned)_c : ts_lo; ts_hi = (lane == nts) ? (int)(unsigned)(_c >> 32) : ts_hi; ++nts; } } while (0)
    PG8_STAMP();
    unsigned voffA[2], voffB[2];
#pragma unroll
    for (int i = 0; i < 2; ++i) { int R, C; stage_rc(tid * 16 + i * 8192, R, C); const int Rb = Epi::PERM ? ((R & ~31) + perm32(R & 31)) : R;
        voffA[i] = (unsigned)(R * K + C) * 2u; voffB[i] = (unsigned)(Rb * K + C) * 2u; }
    const size_t kstep = (size_t)(BK * 2);
    const size_t hstep = (size_t)HALF * K * 2;
    const size_t tstep = 2 * hstep;
    const unsigned ldsw = (unsigned)wid * 1024u;
    const int aoff = lds_byte(wr * 64 + fr, fq * 8), boff = lds_byte(wc * 32 + fr, fq * 8);
#define PG8_SA(b, h) (((b) * 2 + (h)) * HTB)
#define PG8_SB(b, h) ((4 + (b) * 2 + (h)) * HTB)
#define PG8_STAGE(bufoff, gbase, voff) do { _Pragma("unroll") for (int _i = 0; _i < 2; ++_i) \
        __builtin_amdgcn_global_load_lds((const unsigned*)((const char*)(gbase) + (voff)[_i]), (PG8_LAS unsigned*)(lds + (bufoff) + ldsw + _i * 8192), 16, 0, 0); } while (0)
#define PG8_LDA(dst, b, h) do { _Pragma("unroll") for (int m = 0; m < 4; ++m) _Pragma("unroll") for (int k = 0; k < 2; ++k) dst[m][k] = *(const PG8_LAS bf16x8*)(lds + PG8_SA(b, h) + aoff + m * 2048 + k * 1024); } while (0)
#define PG8_LDB(dst, b, h) do { _Pragma("unroll") for (int n = 0; n < 2; ++n) _Pragma("unroll") for (int k = 0; k < 2; ++k) dst[n][k] = *(const PG8_LAS bf16x8*)(lds + PG8_SB(b, h) + boff + n * 2048 + k * 1024); } while (0)
#define PG8_MMA(ai, bj, At, Bt) do { __builtin_amdgcn_s_setprio(1); _Pragma("unroll") for (int m = 0; m < 4; ++m) _Pragma("unroll") for (int n = 0; n < 2; ++n) _Pragma("unroll") for (int k = 0; k < 2; ++k) \
        acc[ai][bj][m][n] = __builtin_amdgcn_mfma_f32_16x16x32_bf16(Bt[n][k], At[m][k], acc[ai][bj][m][n], 0, 0, 0); __builtin_amdgcn_s_setprio(0); } while (0)
#define PG8_WAIT_V(n) asm volatile("s_waitcnt vmcnt(" #n ")" ::: "memory")
#define PG8_WAIT_L(n) asm volatile("s_waitcnt lgkmcnt(" #n ")" ::: "memory")
#define PG8_BAR __builtin_amdgcn_s_barrier()
#define PG8_SCHED __builtin_amdgcn_sched_barrier(0)
    Unit cur, nxt; int ui = 0;
    if (!S.next(0, cur)) return;
    f32x4 acc[2][2][4][2];
#pragma unroll
    for (int a = 0; a < 2; ++a)
#pragma unroll
        for (int b = 0; b < 2; ++b)
#pragma unroll
            for (int m = 0; m < 4; ++m)
#pragma unroll
                for (int n = 0; n < 2; ++n) acc[a][b][m][n] = (f32x4){0.f, 0.f, 0.f, 0.f};
    bf16x8 At[4][2], B0[2][2], B1[2][2];
    const char* cA = (const char*)g.A + (size_t)cur.pm * tstep; const char* cB = (const char*)g.Bt + (size_t)cur.pn * tstep;
    S.a_ready(cur);
    PG8_STAGE(PG8_SB(0, 0), cB, voffB); PG8_STAGE(PG8_SA(0, 0), cA, voffA); PG8_STAGE(PG8_SB(0, 1), cB + hstep, voffB); PG8_STAGE(PG8_SA(0, 1), cA + hstep, voffA);
    if (wr == 1) PG8_BAR;
    PG8_WAIT_V(4); PG8_BAR;
    PG8_STAGE(PG8_SB(1, 0), cB + kstep, voffB); PG8_STAGE(PG8_SA(1, 0), cA + kstep, voffA); PG8_STAGE(PG8_SB(1, 1), cB + hstep + kstep, voffB);
    PG8_WAIT_V(6); PG8_BAR;
    PG8_STAMP();
    for (;;) {
        const bool has_next = S.next(ui + 1, nxt);
        const char* nA = has_next ? (const char*)g.A + (size_t)nxt.pm * tstep : cA; const char* nB = has_next ? (const char*)g.Bt + (size_t)nxt.pn * tstep : cB;
        for (int t = 0; t < nt; t += 2) {
            const bool last = (t == nt - 2);
            const char* a1 = cA + (size_t)(t + 1) * kstep;
            const char* a2 = last ? nA : cA + (size_t)(t + 2) * kstep; const char* b2 = last ? nB : cB + (size_t)(t + 2) * kstep;
            const char* a3 = a2 + kstep; const char* b3 = b2 + kstep;
            if (last && has_next) S.a_ready(nxt);
            PG8_LDB(B0, 0, 0); PG8_SCHED; PG8_LDA(At, 0, 0); PG8_STAGE(PG8_SA(1, 1), a1 + hstep, voffA);
            PG8_WAIT_L(8); PG8_BAR; PG8_WAIT_L(0); PG8_MMA(0, 0, At, B0); PG8_BAR; PG8_SCHED;
            PG8_LDB(B1, 0, 1); PG8_STAGE(PG8_SB(0, 0), b2, voffB);
            PG8_BAR; PG8_WAIT_L(0); PG8_MMA(0, 1, At, B1); PG8_BAR;
            PG8_LDA(At, 0, 1); PG8_STAGE(PG8_SA(0, 0), a2, voffA);
            PG8_BAR; PG8_WAIT_L(0); PG8_MMA(1, 0, At, B0); PG8_BAR; PG8_SCHED;
            PG8_STAGE(PG8_SB(0, 1), b2 + hstep, voffB);
            PG8_WAIT_V(6); PG8_BAR; PG8_MMA(1, 1, At, B1); PG8_BAR;
            PG8_LDB(B0, 1, 0); PG8_SCHED; PG8_LDA(At, 1, 0); PG8_STAGE(PG8_SA(0, 1), a2 + hstep, voffA);
            PG8_WAIT_L(8); PG8_BAR; PG8_WAIT_L(0); PG8_MMA(0, 0, At, B0); PG8_BAR; PG8_SCHED;
            PG8_LDB(B1, 1, 1); PG8_STAGE(PG8_SB(1, 0), b3, voffB);
            PG8_BAR; PG8_WAIT_L(0); PG8_MMA(0, 1, At, B1); PG8_BAR;
            PG8_LDA(At, 1, 1); PG8_STAGE(PG8_SA(1, 0), a3, voffA);
            PG8_BAR; PG8_WAIT_L(0); PG8_MMA(1, 0, At, B0); PG8_BAR; PG8_SCHED;
            PG8_STAGE(PG8_SB(1, 1), b3 + hstep, voffB);
            PG8_WAIT_V(6); PG8_BAR; PG8_MMA(1, 1, At, B1); PG8_BAR;
        }
        PG8_STAMP();
        if constexpr (!Epi::AFTER_DRAIN) { E(acc, cur, wr, wc, fr, fq); S.done(cur); }
        PG8_STAMP();
        if (!has_next) break;
#pragma unroll
        for (int a = 0; a < 2; ++a)
#pragma unroll
            for (int b = 0; b < 2; ++b)
#pragma unroll
                for (int m = 0; m < 4; ++m)
#pragma unroll
                    for (int n = 0; n < 2; ++n) acc[a][b][m][n] = (f32x4){0.f, 0.f, 0.f, 0.f};
        cur = nxt; cA = nA; cB = nB; ++ui;
    }
    PG8_WAIT_V(0);
    if (wr == 0) PG8_BAR;
    PG8_BAR;
    if constexpr (Epi::AFTER_DRAIN) { E.fused(acc, cur, wr, wc, fr, fq, lds, wid, lane); S.done(cur); }
    PG8_STAMP();
    if (STAMP && wid == 0) { stamps[lane] = lane < nts ? (((unsigned long long)(unsigned)ts_hi << 32) | (unsigned)ts_lo) : 0ull;
        if (lane == 62) stamps[62] = rt_entry; if (lane == 63) stamps[63] = (unsigned long long)wall_clock64(); }
#undef PG8_STAMP
#undef PG8_SA
#undef PG8_SB
#undef PG8_STAGE
#undef PG8_LDA
#undef PG8_LDB
#undef PG8_MMA
#undef PG8_WAIT_V
#undef PG8_WAIT_L
#undef PG8_BAR
#undef PG8_SCHED
}
}

using pg8::bf16_t; using pg8::bf16x8; using pg8::f32x4; using pg8::u32x4; using pg8::f32x2; using pg8::Unit;
typedef __bf16 bf16x2_t __attribute__((ext_vector_type(2)));
__device__ __forceinline__ float dpp_xor1(float v) { return __int_as_float(__builtin_amdgcn_update_dpp(0, __float_as_int(v), 0xB1, 0xF, 0xF, true)); }
__device__ __forceinline__ float dpp_xor2(float v) { return __int_as_float(__builtin_amdgcn_update_dpp(0, __float_as_int(v), 0x4E, 0xF, 0xF, true)); }
__device__ __forceinline__ float dpp_xor4(float v) { const int m = __builtin_amdgcn_update_dpp(0, __float_as_int(v), 0x141, 0xF, 0xF, true); return __int_as_float(__builtin_amdgcn_update_dpp(0, m, 0x1B, 0xF, 0xF, true)); }
__device__ __forceinline__ float dpp_xor8(float v) { return __int_as_float(__builtin_amdgcn_update_dpp(0, __float_as_int(v), 0x128, 0xF, 0xF, true)); }
typedef unsigned u32x2 __attribute__((ext_vector_type(2)));

constexpr int NTOK = 16384, DM = 1024, SEQL = 2048;
constexpr int INW = 7184;
constexpr size_t MBY = (size_t)1 << 20;
constexpr size_t O_ZX = 0, O_GY = 32 * MBY, O_ZQ = 64 * MBY, O_ZK = 80 * MBY, O_ZV = 96 * MBY, O_GR = 128 * MBY, O_XB = 160 * MBY,
                 O_WINT = 192 * MBY, O_WOUTT = 228 * MBY, O_WQGT = 230 * MBY, O_WPPT = 234 * MBY, O_PB = 235 * MBY, O_FLOW = 243 * MBY,
                 O_DLAST = 244 * MBY, O_SSQ = 245 * MBY;
constexpr size_t O_UT = 0, O_UB = 192 * MBY  , O_VB = 208 * MBY, O_X1B = 64 * MBY, O_PP = 96 * MBY, O_QP = 128 * MBY;
constexpr int LDS_BYTES = 160 * 1024;
constexpr size_t O_RIDX = 0, O_RW = 8 * MBY, O_RG = 16 * MBY  , O_FF = 128 * MBY, O_PART = 128 * MBY  ;
constexpr float DN_ALPHA = 1.189207115002721f;

struct Params {
    const float* x; const float* p; const float* w_in; const float* conv_w; const float* conv_b; const float* lru_wr; const float* lru_br;
    const float* lru_wi; const float* lru_bi; const float* lru_lambda; const float* gla_wf2; const float* gla_bf; const float* gla_norm_g;
    const float* w_out; const float* ln1_g; const float* ln1_b; const float* peer_wq; const float* peer_subkeys; const float* peer_u;
    const float* peer_v; const float* ple_gate_w; const float* ple_proj_w; const float* ln2_g; const float* ln2_b;
    float* out; unsigned char* ws; int ph_lo, ph_hi, coop, pad_;
};

__device__ __forceinline__ bf16_t f2bf(float f) { unsigned u = __float_as_uint(f); u += 0x7FFFu + ((u >> 16) & 1u); return (bf16_t)(u >> 16); }
__device__ __forceinline__ float bf2f(bf16_t b) { return __uint_as_float(((unsigned)b) << 16); }
__device__ __forceinline__ float bflo(unsigned w) { return __uint_as_float(w << 16); }
__device__ __forceinline__ float bfhi(unsigned w) { return __uint_as_float(w & 0xffff0000u); }
__device__ __forceinline__ unsigned pk2(float lo, float hi) { typedef float f2_t __attribute__((ext_vector_type(2))); f2_t v = {lo, hi}; return __builtin_bit_cast(unsigned, __builtin_convertvector(v, bf16x2_t)); }
__device__ __forceinline__ float sigmoidf_(float x) { return __builtin_amdgcn_rcpf(1.0f + __expf(-x)); }
__device__ __forceinline__ f32x4 mfma16(bf16x8 a, bf16x8 b, f32x4 c) { return __builtin_amdgcn_mfma_f32_16x16x32_bf16(a, b, c, 0, 0, 0); }
__device__ __forceinline__ float dot2bf(unsigned a, unsigned b, float c) { return __builtin_amdgcn_fdot2_f32_bf16(__builtin_bit_cast(bf16x2_t, a), __builtin_bit_cast(bf16x2_t, b), c, false); }
__device__ __forceinline__ float wave_sum(float v) {
#pragma unroll
    for (int o = 32; o >= 1; o >>= 1) v += __shfl_xor(v, o);
    return v;
}

struct EpiZ {
    static constexpr bool PERM = true, AFTER_DRAIN = false;
    unsigned char* ws;
    __device__ __forceinline__ void operator()(const f32x4 (&acc)[2][2][4][2], const Unit& u, int wr, int wc, int fr, int fq) const {
        const int pn = u.pn; const int row0 = u.pm * 256 + wr * 64 + fr;
        const bool pairA = (pn >= 4 && pn < 12), pairB = (pn >= 20);
        if (pairA || pairB) {
            const int j = pairA ? pn - 4 : pn - 20;
            bf16_t* base = (bf16_t*)(ws + (pairA ? O_GY : O_GR));
            const int col = j * 128 + wc * 32 + 8 * fq;
#pragma unroll
            for (int ai = 0; ai < 2; ++ai)
#pragma unroll
                for (int m = 0; m < 4; ++m) {
                    const f32x4 a0 = acc[ai][0][m][0], a1 = acc[ai][0][m][1], g0 = acc[ai][1][m][0], g1 = acc[ai][1][m][1];
                    float o[8];
                    if (pairA) {
                        f32x2 e0 = pg8::gelu_pk((f32x2){a0[0], a0[1]}), e1 = pg8::gelu_pk((f32x2){a0[2], a0[3]}), e2 = pg8::gelu_pk((f32x2){a1[0], a1[1]}), e3 = pg8::gelu_pk((f32x2){a1[2], a1[3]});
                        o[0] = e0.x; o[1] = e0.y; o[2] = e1.x; o[3] = e1.y; o[4] = e2.x; o[5] = e2.y; o[6] = e3.x; o[7] = e3.y;
                    } else {
#pragma unroll
                        for (int q = 0; q < 4; ++q) { o[q] = a0[q] * sigmoidf_(a0[q]); o[4 + q] = a1[q] * sigmoidf_(a1[q]); }
                    }
#pragma unroll
                    for (int q = 0; q < 4; ++q) { o[q] *= sigmoidf_(g0[q]); o[4 + q] *= sigmoidf_(g1[q]); }
                    u32x4 w; w.x = pk2(o[0], o[1]); w.y = pk2(o[2], o[3]); w.z = pk2(o[4], o[5]); w.w = pk2(o[6], o[7]);
                    *(u32x4*)(base + (size_t)(row0 + ai * 128 + m * 16) * 1024 + col) = w;
                }
        } else {
            bf16_t* base; int ldc, colt;
            if (pn < 4) { base = (bf16_t*)(ws + O_ZX); ldc = 1024; colt = pn * 256; }
            else if (pn < 14) { base = (bf16_t*)(ws + O_ZQ); ldc = 512; colt = (pn - 12) * 256; }
            else if (pn < 16) { base = (bf16_t*)(ws + O_ZK); ldc = 512; colt = (pn - 14) * 256; }
            else { base = (bf16_t*)(ws + O_ZV); ldc = 1024; colt = (pn - 16) * 256; }
            const int col0 = colt + wc * 32 + 8 * fq;
#pragma unroll
            for (int ai = 0; ai < 2; ++ai)
#pragma unroll
                for (int m = 0; m < 4; ++m) {
                    bf16_t* rowp = base + (size_t)(row0 + ai * 128 + m * 16) * ldc + col0;
#pragma unroll
                    for (int bj = 0; bj < 2; ++bj) {
                        const f32x4 v0 = acc[ai][bj][m][0], v1 = acc[ai][bj][m][1];
                        u32x4 w; w.x = pk2(v0[0], v0[1]); w.y = pk2(v0[2], v0[3]); w.z = pk2(v1[0], v1[1]); w.w = pk2(v1[2], v1[3]);
                        *(u32x4*)(rowp + bj * 128) = w;
                    }
                }
        }
    }
};
struct EpiPP {
    static constexpr bool PERM = true, AFTER_DRAIN = false;
    bf16_t* O;
    __device__ __forceinline__ void operator()(const f32x4 (&acc)[2][2][4][2], const Unit& u, int wr, int wc, int fr, int fq) const {
        const int row0 = u.pm * 256 + wr * 64 + fr, col0 = u.pn * 256 + wc * 32 + 8 * fq;
#pragma unroll
        for (int ai = 0; ai < 2; ++ai)
#pragma unroll
            for (int m = 0; m < 4; ++m) {
                bf16_t* rowp = O + (size_t)(row0 + ai * 128 + m * 16) * 1024 + col0;
#pragma unroll
                for (int bj = 0; bj < 2; ++bj) {
                    const f32x4 v0 = acc[ai][bj][m][0], v1 = acc[ai][bj][m][1];
                    u32x4 w; w.x = pk2(v0[0], v0[1]); w.y = pk2(v0[2], v0[3]); w.z = pk2(v1[0], v1[1]); w.w = pk2(v1[2], v1[3]);
                    *(u32x4*)(rowp + bj * 128) = w;
                }
            }
    }
};
struct EpiY1 {
    static constexpr bool PERM = false, AFTER_DRAIN = false;
    const float* X; float* Y;
    __device__ __forceinline__ void operator()(const f32x4 (&acc)[2][2][4][2], const Unit& u, int wr, int wc, int fr, int fq) const {
        const int row0 = u.pm * 256 + wr * 64 + fr, col0 = u.pn * 256 + wc * 32 + 4 * fq;
#pragma unroll
        for (int ai = 0; ai < 2; ++ai)
#pragma unroll
            for (int m = 0; m < 4; ++m) {
                const size_t ro = (size_t)(row0 + ai * 128 + m * 16) * 1024 + col0;
#pragma unroll
                for (int bj = 0; bj < 2; ++bj)
#pragma unroll
                    for (int n = 0; n < 2; ++n) {
                        const f32x4 xv = *(const f32x4*)(X + ro + bj * 128 + n * 16);
                        *(f32x4*)(Y + ro + bj * 128 + n * 16) = xv * DN_ALPHA + acc[ai][bj][m][n];
                    }
            }
    }
};
struct EpiQG {
    static constexpr bool PERM = false, AFTER_DRAIN = false;
    float* QP; bf16_t* PP;
    __device__ __forceinline__ void operator()(const f32x4 (&acc)[2][2][4][2], const Unit& u, int wr, int wc, int fr, int fq) const {
        const int row0 = u.pm * 256 + wr * 64 + fr; const int pn = u.pn;
        const int col0 = (pn & 3) * 256 + wc * 32 + 4 * fq;
#pragma unroll
        for (int ai = 0; ai < 2; ++ai)
#pragma unroll
            for (int m = 0; m < 4; ++m) {
                const size_t ro = (size_t)(row0 + ai * 128 + m * 16) * 1024 + col0;
#pragma unroll
                for (int bj = 0; bj < 2; ++bj)
#pragma unroll
                    for (int n = 0; n < 2; ++n) {
                        const f32x4 a = acc[ai][bj][m][n];
                        if (pn < 4) { *(f32x4*)(QP + ro + bj * 128 + n * 16) = a; }
                        else {
                            u32x2* pp = (u32x2*)(PP + ro + bj * 128 + n * 16);
                            const u32x2 w = *pp;
                            u32x2 o; o.x = pk2(sigmoidf_(a[0]) * bflo(w.x), sigmoidf_(a[1]) * bfhi(w.x)); o.y = pk2(sigmoidf_(a[2]) * bflo(w.y), sigmoidf_(a[3]) * bfhi(w.y));
                            *pp = o;
                        }
                    }
            }
    }
};

__device__ __forceinline__ int win_src_col(int n) {
    if (n < 1024) return n;
    if (n < 3072) { const int j = (n - 1024) >> 8, r = (n - 1024) & 255; return r < 128 ? 1024 + j * 128 + r : 5136 + j * 128 + (r - 128); }
    if (n < 3584) return 2048 + (n - 3072);
    if (n < 4096) return 2560 + (n - 3584);
    if (n < 5120) return 3072 + (n - 4096);
    { const int j = (n - 5120) >> 8, r = (n - 5120) & 255; return r < 128 ? 4096 + j * 128 + r : 6160 + j * 128 + (r - 128); }
}
__device__ void phase_prep(const Params& P, unsigned char* lds) {
    const int tid = threadIdx.x, wid = tid >> 6, lane = tid & 63;
    bf16_t* wf = (bf16_t*)lds;
    float* ts = (float*)(lds + 34816);
    for (int i = tid; i < 16 * 1024; i += 512) { const int r = i & 15, k = i >> 4; wf[r * 1032 + k] = f2bf(P.w_in[(size_t)k * INW + 5120 + r]); }
    __syncthreads();
    bf16_t* xb = (bf16_t*)(P.ws + O_XB); float* flow = (float*)(P.ws + O_FLOW);
    if (wid < 4) {
        for (int tile = wid * gridDim.x + blockIdx.x; tile < 1024; tile += 4 * gridDim.x) {
            const int c = lane & 15, kq = lane >> 4; const int row = tile * 16 + c;
            f32x4 acc = {0.f, 0.f, 0.f, 0.f};
            const float* xr = P.x + (size_t)row * 1024 + kq * 8;
#pragma unroll 4
            for (int ks = 0; ks < 32; ++ks) {
                const f32x4 a0 = *(const f32x4*)(xr + ks * 32), a1 = *(const f32x4*)(xr + ks * 32 + 4);
                u32x4 w; w.x = pk2(a0[0], a0[1]); w.y = pk2(a0[2], a0[3]); w.z = pk2(a1[0], a1[1]); w.w = pk2(a1[2], a1[3]);
                *(u32x4*)(xb + (size_t)row * 1024 + ks * 32 + kq * 8) = w;
                const bf16x8 bfr = *(const bf16x8*)(wf + c * 1032 + ks * 32 + kq * 8);
                acc = mfma16(__builtin_bit_cast(bf16x8, w), bfr, acc);
            }
#pragma unroll
            for (int i = 0; i < 4; ++i) flow[(size_t)(tile * 16 + kq * 4 + i) * 16 + c] = acc[i];
        }
    } else {
        bf16_t* pb = (bf16_t*)(P.ws + O_PB);
        const int nthr = 4 * 64 * gridDim.x;
        for (int i = ((wid - 4) * gridDim.x + blockIdx.x) * 64 + lane; i < NTOK * 256 / 4; i += nthr) {
            const f32x4 a = *(const f32x4*)(P.p + (size_t)i * 4);
            u32x2 w; w.x = pk2(a[0], a[1]); w.y = pk2(a[2], a[3]);
            *(u32x2*)(pb + (size_t)i * 4) = w;
        }
    }
    for (int job = blockIdx.x; job < 2624; job += gridDim.x) {
        const float* W; bf16_t* O; int ldw, Kd, tn, tk, mode;
        if (job < 1792) { W = P.w_in; O = (bf16_t*)(P.ws + O_WINT); ldw = INW; Kd = 1024; tn = job >> 4; tk = job & 15; mode = 0; }
        else if (job < 2048) { const int j = job - 1792; W = P.w_out; O = (bf16_t*)(P.ws + O_WOUTT); ldw = 1024; Kd = 1024; tn = j >> 4; tk = j & 15; mode = 1; }
        else if (job < 2560) { const int j = job - 2048; tn = j >> 4; tk = j & 15; mode = 2; ldw = 1024; Kd = 1024; O = (bf16_t*)(P.ws + O_WQGT); W = tn < 16 ? P.peer_wq : P.ple_gate_w; }
        else { const int j = job - 2560; W = P.ple_proj_w; O = (bf16_t*)(P.ws + O_WPPT); ldw = 1024; Kd = 256; tn = j >> 2; tk = j & 3; mode = 1; }
        const int n0 = tn * 64, k0 = tk * 64;
        int sc0 = n0; if (mode == 0) sc0 = win_src_col(n0); if (mode == 2) sc0 = n0 & 1023;
        {
            const int kk = tid >> 4, c4 = (tid & 15) * 4;
#pragma unroll
            for (int i = 0; i < 2; ++i) {
                const f32x4 v = *(const f32x4*)(W + (size_t)(k0 + kk + 32 * i) * ldw + sc0 + c4);
                float* d = ts + (kk + 32 * i) * 65 + c4; d[0] = v[0]; d[1] = v[1]; d[2] = v[2]; d[3] = v[3];
            }
        }
        __syncthreads();
        {
            const int n = tid >> 3, kc = (tid & 7) * 8;
            float v[8];
#pragma unroll
            for (int j = 0; j < 8; ++j) v[j] = ts[(kc + j) * 65 + n];
            u32x4 w; w.x = pk2(v[0], v[1]); w.y = pk2(v[2], v[3]); w.z = pk2(v[4], v[5]); w.w = pk2(v[6], v[7]);
            *(u32x4*)(O + (size_t)(n0 + n) * Kd + k0 + kc) = w;
        }
        __syncthreads();
    }
}

__device__ void phase_lru(const Params& P, unsigned char* lds) {
    const int tid = threadIdx.x, wid = __builtin_amdgcn_readfirstlane(tid >> 6), lane = tid & 63, c = lane & 15, kq = lane >> 4;
    bf16_t* u_s = (bf16_t*)lds;
    float* u32_s = (float*)(lds + 34816);
    float* a_s = (float*)(lds + 51712);
    float* i_s = (float*)(lds + 68608);
    float* segA = (float*)(lds + 85504);
    float* segH = (float*)(lds + 87552);
    float* carry = (float*)(lds + 89600);
    const bf16_t* zx = (const bf16_t*)(P.ws + O_ZX); const bf16_t* gy = (const bf16_t*)(P.ws + O_GY); bf16_t* yag = (bf16_t*)(P.ws + O_XB);
    for (int item = blockIdx.x; item < 256; item += gridDim.x) {
        const int grp_ = (item & 7) * 8 + (item >> 5), qd = (item >> 3) & 3, b = grp_ >> 3, blk = grp_ & 7;
        const int ch0 = blk * 128, d0 = ch0 + qd * 32;
        bf16_t* wB = (bf16_t*)(lds + 90112);
        for (int i = tid; i < 2 * 128 * 32; i += 512) {
            const int mat = i >> 12, cc = (i >> 5) & 127, dd = i & 31;
            wB[(mat * 32 + dd) * 136 + cc] = f2bf(((mat ? P.lru_wi : P.lru_wr) + (size_t)blk * 128 * 128)[cc * 128 + qd * 32 + dd]);
        }
        float br[2], bi[2], sp[2];
#pragma unroll
        for (int nt = 0; nt < 2; ++nt) {
            const int dch = d0 + nt * 16 + c;
            br[nt] = P.lru_br[dch]; bi[nt] = P.lru_bi[dch];
            const float lam = P.lru_lambda[dch];
            const float spl = (lam > 0.f ? 0.f : -lam) + log1pf(__expf(-fabsf(lam)));
            sp[nt] = -8.0f * spl;
        }
        const int cg8 = tid & 15, tgrp = tid >> 4;
        float cw[4][8], cb[8];
#pragma unroll
        for (int j = 0; j < 4; ++j)
#pragma unroll
            for (int q = 0; q < 8; ++q) cw[j][q] = P.conv_w[j * 1024 + ch0 + cg8 * 8 + q];
#pragma unroll
        for (int q = 0; q < 8; ++q) cb[q] = P.conv_b[ch0 + cg8 * 8 + q];
        if (tid < 32) carry[tid] = 0.f;
        u32x4 rows[7], rowsN[7];
#pragma unroll
        for (int r = 0; r < 7; ++r) {
            const int tt = tgrp * 4 - 3 + r;
            if (tt >= 0) rows[r] = *(const u32x4*)(zx + ((size_t)b * SEQL + tt) * 1024 + ch0 + cg8 * 8);
            else rows[r] = (u32x4){0u, 0u, 0u, 0u};
        }
#pragma unroll 1
        for (int tile = 0; tile < 16; ++tile) {
            const int t0 = tile * 128;
            {
#pragma unroll
                for (int i = 0; i < 4; ++i) {
                    float o[8];
#pragma unroll
                    for (int q = 0; q < 8; ++q) o[q] = cb[q];
#pragma unroll
                    for (int j = 0; j < 4; ++j) {
                        const u32x4 rw = rows[i + j];
                        o[0] += cw[j][0] * bflo(rw.x); o[1] += cw[j][1] * bfhi(rw.x); o[2] += cw[j][2] * bflo(rw.y); o[3] += cw[j][3] * bfhi(rw.y);
                        o[4] += cw[j][4] * bflo(rw.z); o[5] += cw[j][5] * bfhi(rw.z); o[6] += cw[j][6] * bflo(rw.w); o[7] += cw[j][7] * bfhi(rw.w);
                    }
                    const int t = tgrp * 4 + i;
                    u32x4 w; w.x = pk2(o[0], o[1]); w.y = pk2(o[2], o[3]); w.z = pk2(o[4], o[5]); w.w = pk2(o[6], o[7]);
                    *(u32x4*)(u_s + t * 136 + cg8 * 8) = w;
                    if ((cg8 >> 2) == qd) {
#pragma unroll
                        for (int q = 0; q < 8; ++q) u32_s[t * 33 + (cg8 & 3) * 8 + q] = o[q];
                    }
                }
            }
            __syncthreads();
            f32x4 cvs[4];
            {
                const size_t cbase = ((size_t)item * 16 + tile) * 2048;
#pragma unroll
                for (int k = 0; k < 4; ++k) { const size_t ci = cbase + k * 512 + tid; cvs[k] = __builtin_nontemporal_load((const f32x4*)(ci < (size_t)NTOK * 256 ? P.peer_u + ci * 4 : P.peer_v + (ci - (size_t)NTOK * 256) * 4)); }
            }
            bf16_t gyv[8];
            {
                const int tn = (tile + 1 < 16 ? tile + 1 : 15) * 128;
#pragma unroll
                for (int r = 0; r < 7; ++r) rowsN[r] = *(const u32x4*)(zx + ((size_t)b * SEQL + tn + tgrp * 4 - 3 + r) * 1024 + ch0 + cg8 * 8);
                const int cs_ = tid & 31, seg_ = tid >> 5;
#pragma unroll
                for (int jq = 0; jq < 8; ++jq) gyv[jq] = gy[((size_t)b * SEQL + t0 + seg_ * 8 + jq) * 1024 + d0 + cs_];
            }
            {
                f32x4 accR[2], accI[2];
#pragma unroll
                for (int nt = 0; nt < 2; ++nt) { accR[nt] = (f32x4){0.f, 0.f, 0.f, 0.f}; accI[nt] = (f32x4){0.f, 0.f, 0.f, 0.f}; }
#pragma unroll
                for (int ks = 0; ks < 4; ++ks) {
                    const bf16x8 af = *(const bf16x8*)(u_s + (wid * 16 + c) * 136 + ks * 32 + kq * 8);
#pragma unroll
                    for (int nt = 0; nt < 2; ++nt) {
                        accR[nt] = mfma16(af, *(const bf16x8*)(wB + (nt * 16 + c) * 136 + ks * 32 + kq * 8), accR[nt]);
                        accI[nt] = mfma16(af, *(const bf16x8*)(wB + (32 + nt * 16 + c) * 136 + ks * 32 + kq * 8), accI[nt]);
                    }
                }
#pragma unroll
                for (int nt = 0; nt < 2; ++nt)
#pragma unroll
                    for (int i = 0; i < 4; ++i) {
                        const int t = wid * 16 + kq * 4 + i, dl = nt * 16 + c;
                        const float r = sigmoidf_(accR[nt][i] + br[nt]), ig = sigmoidf_(accI[nt][i] + bi[nt]);
                        const float log_a = sp[nt] * r;
                        const float a = __expf(log_a);
                        const float mult = sqrtf(fmaf(-a, a, 1.0f));
                        a_s[t * 33 + dl] = a; i_s[t * 33 + dl] = mult * ig * u32_s[t * 33 + dl];
                    }
            }
            __syncthreads();
            {
                const int cs = tid & 31, seg = tid >> 5;
                float av[8], iv[8];
#pragma unroll
                for (int j = 0; j < 8; ++j) { av[j] = a_s[(seg * 8 + j) * 33 + cs]; iv[j] = i_s[(seg * 8 + j) * 33 + cs]; }
                float A = 1.f, H = 0.f;
#pragma unroll
                for (int j = 0; j < 8; ++j) { H = av[j] * H + iv[j]; A *= av[j]; }
                segA[seg * 32 + cs] = A; segH[seg * 32 + cs] = H;
                __syncthreads();
                float h = carry[cs];
                for (int s = 0; s < seg; ++s) h = segA[s * 32 + cs] * h + segH[s * 32 + cs];
#pragma unroll
                for (int j = 0; j < 8; ++j) {
                    h = av[j] * h + iv[j];
                    const size_t gi = ((size_t)b * SEQL + t0 + seg * 8 + j) * 1024 + d0 + cs;
                    yag[gi] = f2bf(h * bf2f(gyv[j]));
                }
                __syncthreads();
                if (seg == 15) carry[cs] = h;
            }
            {
                unsigned* u8 = (unsigned*)(P.ws + O_UB);
                const size_t cbase = ((size_t)item * 16 + tile) * 2048;
#pragma unroll
                for (int k = 0; k < 4; ++k) {
                    const size_t ci = cbase + k * 512 + tid; const float sc = ci < (size_t)NTOK * 256 ? 256.0f : 32.0f;
                    int wv = 0;
                    wv = __builtin_amdgcn_cvt_pk_fp8_f32(cvs[k][0] * sc, cvs[k][1] * sc, wv, false);
                    wv = __builtin_amdgcn_cvt_pk_fp8_f32(cvs[k][2] * sc, cvs[k][3] * sc, wv, true);
#ifdef PEER2
#ifdef PEER3
                    if (ci < (size_t)NTOK * 256) { const size_t e_ = ci >> 8; const unsigned c4 = (unsigned)ci & 255u; ((unsigned*)(P.ws + O_UB))[((size_t)(c4 >> 5) * 16384 + e_) * 32 + (c4 & 31u)] = (unsigned)wv; }
#else
                    if (ci < (size_t)NTOK * 256) u8[ci] = (unsigned)wv;
#endif
                    else { const size_t cv = ci - (size_t)NTOK * 256; const size_t e_ = cv >> 8; const unsigned c4 = (unsigned)cv & 255u;
                           ((unsigned*)(P.ws + O_VB))[((size_t)(c4 >> 5) * 16384 + e_) * 32 + (c4 & 31u)] = (unsigned)wv; }
#else
                    u8[ci] = (unsigned)wv;
#endif
                }
            }
#pragma unroll
            for (int r = 0; r < 7; ++r) rows[r] = rowsN[r];
        }
        __syncthreads();
    }
}

__device__ void phase_gla1(const Params& P, unsigned char* lds) {
    const int tid = threadIdx.x, wid = __builtin_amdgcn_readfirstlane(tid >> 6), lane = tid & 63, c = lane & 15, kq = lane >> 4;
    bf16_t* Qb_s = (bf16_t*)(lds + 33024);
    bf16_t* Kb_s = (bf16_t*)(lds + 50432);
    bf16_t* Klt_s = (bf16_t*)(lds + 67840);
    bf16_t* Vt_s = (bf16_t*)(lds + 86272);
    bf16_t* A_s = (bf16_t*)(lds + 123136);
    float* fl_s = (float*)(lds + 132352);
    float* segs = (float*)(lds + 136448);
    bf16_t* zq = (bf16_t*)(P.ws + O_ZQ); const bf16_t* zk = (const bf16_t*)(P.ws + O_ZK); const bf16_t* zv = (const bf16_t*)(P.ws + O_ZV);
    const float* flow = (const float*)(P.ws + O_FLOW); bf16_t* dlastb = (bf16_t*)(P.ws + O_DLAST); bf16_t* UT = (bf16_t*)(P.ws + O_UT); float* oin = P.out;
    for (int item0 = blockIdx.x; item0 < 1024; item0 += gridDim.x) {
        const int h = (item0 >> 3) & 3, bn = (item0 & 7) * 32 + (item0 >> 5), tok0 = bn * 64, item = bn * 4 + h;
        const int d = tid & 127, tg = tid >> 7;
        for (int i = tid; i < 1024; i += 512) fl_s[i] = flow[(size_t)tok0 * 16 + i];
        float w2[16];
#pragma unroll
        for (int r = 0; r < 16; ++r) w2[r] = P.gla_wf2[r * 512 + h * 128 + d];
        const float bfd = P.gla_bf[h * 128 + d];
        bf16_t q16[16], k16[16], v32[32];
#pragma unroll
        for (int j = 0; j < 16; ++j) { const size_t gi = (size_t)(tok0 + tg * 16 + j) * 512 + h * 128 + d; q16[j] = zq[gi]; k16[j] = zk[gi]; }
        {
            const int n = tid & 255, tg2 = tid >> 8;
#pragma unroll
            for (int j = 0; j < 32; ++j) v32[j] = zv[(size_t)(tok0 + tg2 * 32 + j) * 1024 + h * 256 + n];
        }
        __syncthreads();
        float g[16]; float run = 0.f;
#pragma unroll
        for (int j = 0; j < 16; ++j) {
            const int t = tg * 16 + j; float xv = bfd;
#pragma unroll
            for (int r = 0; r < 16; ++r) xv += fl_s[t * 16 + r] * w2[r];
            const float ls = fminf(xv, 0.f) - log1pf(__expf(-fabsf(xv)));
            run += ls * 0.0625f; g[j] = run;
#ifdef DBG_SCAN
            { int* fl = (int*)(P.ws + 240 * MBY); if (!(fabsf(fl_s[t * 16 + (j & 15)]) < 1e3f)) fl[40] = 1; if (!(fabsf(xv) < 1e30f)) fl[41] = 1; if (!(fabsf(ls) < 1e30f)) fl[42] = 1; }
#endif
        }
        segs[tg * 128 + d] = run;
        __syncthreads();
        float pre = 0.f, blast = 0.f;
#pragma unroll
        for (int s = 0; s < 4; ++s) { const float v = segs[s * 128 + d]; if (s < tg) pre += v; blast += v; }
#pragma unroll
        for (int j = 0; j < 16; ++j) {
            const int t = tg * 16 + j; const float bv = pre + g[j];
            const size_t gi = (size_t)(tok0 + t) * 512 + h * 128 + d;
            const float qv = bf2f(q16[j]), kv = bf2f(k16[j]);
            const float qb = qv * __expf(bv) * 0.08838834764831845f, kb = kv * __expf(-bv), kl = kv * __expf(blast - bv);
            const bf16_t qbb = f2bf(qb);
#ifdef DBG_SCAN
            { int* fl = (int*)(P.ws + 240 * MBY); if (!(fabsf(bv) < 1e30f)) fl[43] = 1; if (!(fabsf(kl) < 1e30f)) fl[44] = 1; if (!(fabsf(kb) < 1e30f)) fl[46] = 1; }
#endif
            Qb_s[t * 136 + d] = qbb; zq[gi] = qbb; Kb_s[t * 136 + d] = f2bf(kb); Klt_s[d * 72 + t] = f2bf(kl);
        }
        if (tg == 0) dlastb[(size_t)item * 128 + d] = f2bf(__expf(blast));
        {
            const int n = tid & 255, tg2 = tid >> 8;
#pragma unroll
            for (int j = 0; j < 32; ++j) { const int t = tg2 * 32 + j; Vt_s[n * 72 + t] = v32[j]; }
        }
        __syncthreads();
        {
            const int mi = wid >> 1;
#pragma unroll
            for (int jj = 0; jj < 2; ++jj) {
                const int nj = (wid & 1) * 2 + jj;
                f32x4 acc = {0.f, 0.f, 0.f, 0.f};
                if (nj <= mi) {
#pragma unroll
                    for (int ks = 0; ks < 4; ++ks) {
                        const bf16x8 a = *(const bf16x8*)(Qb_s + (mi * 16 + c) * 136 + ks * 32 + kq * 8);
                        const bf16x8 bb = *(const bf16x8*)(Kb_s + (nj * 16 + c) * 136 + ks * 32 + kq * 8);
                        acc = mfma16(a, bb, acc);
                    }
                }
#pragma unroll
                for (int r = 0; r < 4; ++r) { const int i = mi * 16 + kq * 4 + r, jx = nj * 16 + c; A_s[i * 72 + jx] = f2bf(jx <= i ? acc[r] : 0.f); }
            }
        }
        __syncthreads();
        {
#pragma unroll
            for (int mt = 0; mt < 2; ++mt) {
                const int nt_ = wid * 2 + mt;
                bf16x8 afr[2];
#pragma unroll
                for (int ks = 0; ks < 2; ++ks) afr[ks] = *(const bf16x8*)(Vt_s + (nt_ * 16 + c) * 72 + ks * 32 + kq * 8);
#pragma unroll
                for (int it = 0; it < 4; ++it) {
                    f32x4 acc = {0.f, 0.f, 0.f, 0.f};
#pragma unroll
                    for (int ks = 0; ks < 2; ++ks) acc = mfma16(afr[ks], *(const bf16x8*)(A_s + (it * 16 + c) * 72 + ks * 32 + kq * 8), acc);
                    *(f32x4*)(oin + (size_t)(tok0 + it * 16 + c) * 1024 + h * 256 + nt_ * 16 + kq * 4) = acc;
                }
            }
            bf16x8 kfr[2];
#pragma unroll
            for (int ks = 0; ks < 2; ++ks) kfr[ks] = *(const bf16x8*)(Klt_s + (wid * 16 + c) * 72 + ks * 32 + kq * 8);
#pragma unroll 4
            for (int nt = 0; nt < 16; ++nt) {
                f32x4 acc = {0.f, 0.f, 0.f, 0.f};
#pragma unroll
                for (int ks = 0; ks < 2; ++ks) acc = mfma16(kfr[ks], *(const bf16x8*)(Vt_s + (nt * 16 + c) * 72 + ks * 32 + kq * 8), acc);
#ifdef DBG_SCAN
                { int* fl = (int*)(P.ws + 240 * MBY); if (!(fabsf(acc[0]) < 1e30f) || !(fabsf(acc[1]) < 1e30f) || !(fabsf(acc[2]) < 1e30f) || !(fabsf(acc[3]) < 1e30f)) fl[45] = 1; }
#endif
                u32x2 w; w.x = pk2(acc[0], acc[1]); w.y = pk2(acc[2], acc[3]);
                *(u32x2*)(UT + ((size_t)item * 256 + nt * 16 + c) * 128 + wid * 16 + kq * 4) = w;
            }
        }
        __syncthreads();
    }
}

__device__ void phase_gla2(const Params& P) {
    const int tid = threadIdx.x, wid = __builtin_amdgcn_readfirstlane(tid >> 6), lane = tid & 63, c = lane & 15, kq = lane >> 4;
    const bf16_t* zq = (const bf16_t*)(P.ws + O_ZQ); const bf16_t* dlastb = (const bf16_t*)(P.ws + O_DLAST); const bf16_t* UT = (const bf16_t*)(P.ws + O_UT);
    float* oin = P.out; float* ssq = (float*)(P.ws + O_SSQ);
    for (int item = blockIdx.x; item < 256; item += gridDim.x) {
        const int pair_ = (item & 7) * 4 + (item >> 6), s = (item >> 3) & 7, b = pair_ >> 2, h = pair_ & 3;
        const int mi = wid & 3, ni = wid >> 2, ncol = s * 32 + ni * 16;
        float S[4][8];
#pragma unroll
        for (int ks = 0; ks < 4; ++ks)
#pragma unroll
            for (int j = 0; j < 8; ++j) S[ks][j] = 0.f;
#define G2_LOAD(Q, U, D, OI, NC) do { const int bn_ = b * 32 + (NC), it_ = bn_ * 4 + h, tok_ = bn_ * 64 + mi * 16 + c; \
            OI = *(const f32x4*)(oin + (size_t)tok_ * 1024 + h * 256 + ncol + kq * 4); \
            _Pragma("unroll") for (int ks = 0; ks < 4; ++ks) { \
                Q[ks] = *(const bf16x8*)(zq + (size_t)tok_ * 512 + h * 128 + ks * 32 + kq * 8); \
                U[ks] = *(const u32x4*)(UT + ((size_t)it_ * 256 + ncol + c) * 128 + ks * 32 + kq * 8); \
                D[ks] = *(const u32x4*)(dlastb + (size_t)it_ * 128 + ks * 32 + kq * 8); } } while (0)
#define G2_COMP(Q, U, D, OI, NC) do { const int bn_ = b * 32 + (NC), tok_ = bn_ * 64 + mi * 16 + c; \
            f32x4 acc = OI; \
            _Pragma("unroll") for (int ks = 0; ks < 4; ++ks) { \
                u32x4 w; w.x = pk2(S[ks][0], S[ks][1]); w.y = pk2(S[ks][2], S[ks][3]); w.z = pk2(S[ks][4], S[ks][5]); w.w = pk2(S[ks][6], S[ks][7]); \
                acc = mfma16(__builtin_bit_cast(bf16x8, w), Q[ks], acc); } \
            *(f32x4*)(oin + (size_t)tok_ * 1024 + h * 256 + ncol + kq * 4) = acc; \
            float ss = acc[0] * acc[0] + acc[1] * acc[1] + acc[2] * acc[2] + acc[3] * acc[3]; \
            ss += __shfl_xor(ss, 16); ss += __shfl_xor(ss, 32); \
            if (kq == 0) ssq[((size_t)tok_ * 4 + h) * 16 + s * 2 + ni] = ss; \
            _Pragma("unroll") for (int ks = 0; ks < 4; ++ks) { const u32x4 uu = U[ks]; const u32x4 dd = D[ks]; \
                S[ks][0] = bflo(dd.x) * S[ks][0] + bflo(uu.x); S[ks][1] = bfhi(dd.x) * S[ks][1] + bfhi(uu.x); \
                S[ks][2] = bflo(dd.y) * S[ks][2] + bflo(uu.y); S[ks][3] = bfhi(dd.y) * S[ks][3] + bfhi(uu.y); \
                S[ks][4] = bflo(dd.z) * S[ks][4] + bflo(uu.z); S[ks][5] = bfhi(dd.z) * S[ks][5] + bfhi(uu.z); \
                S[ks][6] = bflo(dd.w) * S[ks][6] + bflo(uu.w); S[ks][7] = bfhi(dd.w) * S[ks][7] + bfhi(uu.w); } } while (0)
        bf16x8 QA[4], QB[4], QC[4]; u32x4 UA[4], UB[4], UC[4], DA[4], DB[4], DC[4]; f32x4 oA, oB, oC;
        G2_LOAD(QA, UA, DA, oA, 0);
        G2_LOAD(QB, UB, DB, oB, 1);
#pragma unroll 1
        for (int nc = 0; nc < 33; nc += 3) {
            G2_LOAD(QC, UC, DC, oC, (nc + 2 < 32 ? nc + 2 : 31));
            G2_COMP(QA, UA, DA, oA, nc);
            G2_LOAD(QA, UA, DA, oA, (nc + 3 < 32 ? nc + 3 : 31));
            G2_COMP(QB, UB, DB, oB, nc + 1);
            if (nc + 2 >= 32) break;
            G2_LOAD(QB, UB, DB, oB, (nc + 4 < 32 ? nc + 4 : 31));
            G2_COMP(QC, UC, DC, oC, nc + 2);
        }
#undef G2_LOAD
#undef G2_COMP
    }
}

__device__ void phase_combine(const Params& P) {
    const float* oin = P.out; const float* ssq = (const float*)(P.ws + O_SSQ); const bf16_t* gr = (const bf16_t*)(P.ws + O_GR); bf16_t* ym = (bf16_t*)(P.ws + O_XB);
    for (int idx = blockIdx.x * 512 + threadIdx.x; idx < NTOK * 128; idx += gridDim.x * 512) {
        const int row = idx >> 7, col = (idx & 127) * 8, h = col >> 8;
        const f32x4* sp = (const f32x4*)(ssq + ((size_t)row * 4 + h) * 16);
        const f32x4 s0 = sp[0], s1 = sp[1], s2 = sp[2], s3 = sp[3];
        const float tot = (s0[0] + s0[1] + s0[2] + s0[3]) + (s1[0] + s1[1] + s1[2] + s1[3]) + (s2[0] + s2[1] + s2[2] + s2[3]) + (s3[0] + s3[1] + s3[2] + s3[3]);
        const float rs = rsqrtf(tot * (1.0f / 256.0f) + 1e-6f);
        const size_t gi = (size_t)row * 1024 + col;
        const f32x4 o0 = *(const f32x4*)(oin + gi), o1 = *(const f32x4*)(oin + gi + 4);
        const f32x4 n0 = *(const f32x4*)(P.gla_norm_g + col), n1 = *(const f32x4*)(P.gla_norm_g + col + 4);
        const u32x4 g = *(const u32x4*)(gr + gi), y = *(const u32x4*)(ym + gi);
        u32x4 w;
        w.x = pk2(bflo(y.x) + bflo(g.x) * (o0[0] * rs * n0[0]), bfhi(y.x) + bfhi(g.x) * (o0[1] * rs * n0[1]));
        w.y = pk2(bflo(y.y) + bflo(g.y) * (o0[2] * rs * n0[2]), bfhi(y.y) + bfhi(g.y) * (o0[3] * rs * n0[3]));
        w.z = pk2(bflo(y.z) + bflo(g.z) * (o1[0] * rs * n1[0]), bfhi(y.z) + bfhi(g.z) * (o1[1] * rs * n1[1]));
        w.w = pk2(bflo(y.w) + bflo(g.w) * (o1[2] * rs * n1[2]), bfhi(y.w) + bfhi(g.w) * (o1[3] * rs * n1[3]));
        *(u32x4*)(ym + gi) = w;
    }
}

__device__ void phase_ln1(const Params& P) {
    const int tid = threadIdx.x, wid = tid >> 6, lane = tid & 63;
    float* y = P.out; bf16_t* x1b = (bf16_t*)(P.ws + O_X1B);
    const int rstride = gridDim.x * 8;
    for (int row0 = blockIdx.x * 8 + wid; row0 < NTOK; row0 += 2 * rstride) {
        const int row1 = row0 + rstride; const bool has1 = row1 < NTOK; const int r1 = has1 ? row1 : row0;
        f32x4 v[4], w[4]; float s = 0.f, s1 = 0.f;
#pragma unroll
        for (int i = 0; i < 4; ++i) { v[i] = *(const f32x4*)(y + (size_t)row0 * 1024 + i * 256 + lane * 4); w[i] = *(const f32x4*)(y + (size_t)r1 * 1024 + i * 256 + lane * 4); }
#pragma unroll
        for (int i = 0; i < 4; ++i) { s += (v[i][0] + v[i][1]) + (v[i][2] + v[i][3]); s1 += (w[i][0] + w[i][1]) + (w[i][2] + w[i][3]); }
        s += __shfl_xor(s, 32); s1 += __shfl_xor(s1, 32); s += __shfl_xor(s, 16); s1 += __shfl_xor(s1, 16);
        s += dpp_xor8(s); s1 += dpp_xor8(s1); s += dpp_xor4(s); s1 += dpp_xor4(s1); s += dpp_xor2(s); s1 += dpp_xor2(s1); s += dpp_xor1(s); s1 += dpp_xor1(s1);
        const float mu = s * (1.0f / 1024.0f), mu1 = s1 * (1.0f / 1024.0f);
        float q = 0.f, q1 = 0.f;
#pragma unroll
        for (int i = 0; i < 4; ++i) { v[i] = v[i] - mu; w[i] = w[i] - mu1; q += (v[i][0] * v[i][0] + v[i][1] * v[i][1]) + (v[i][2] * v[i][2] + v[i][3] * v[i][3]); q1 += (w[i][0] * w[i][0] + w[i][1] * w[i][1]) + (w[i][2] * w[i][2] + w[i][3] * w[i][3]); }
        q += __shfl_xor(q, 32); q1 += __shfl_xor(q1, 32); q += __shfl_xor(q, 16); q1 += __shfl_xor(q1, 16);
        q += dpp_xor8(q); q1 += dpp_xor8(q1); q += dpp_xor4(q); q1 += dpp_xor4(q1); q += dpp_xor2(q); q1 += dpp_xor2(q1); q += dpp_xor1(q); q1 += dpp_xor1(q1);
        const float rstd = rsqrtf(q * (1.0f / 1024.0f) + 1e-5f), rstd1 = rsqrtf(q1 * (1.0f / 1024.0f) + 1e-5f);
#pragma unroll
        for (int i = 0; i < 4; ++i) {
            const int col = i * 256 + lane * 4;
            const f32x4 gg = *(const f32x4*)(P.ln1_g + col), bb = *(const f32x4*)(P.ln1_b + col);
            const f32x4 o = v[i] * rstd * gg + bb;
            *(f32x4*)(y + (size_t)row0 * 1024 + col) = o;
            u32x2 pw; pw.x = pk2(o[0], o[1]); pw.y = pk2(o[2], o[3]);
            *(u32x2*)(x1b + (size_t)row0 * 1024 + col) = pw;
            if (has1) {
                const f32x4 o1 = w[i] * rstd1 * gg + bb;
                *(f32x4*)(y + (size_t)row1 * 1024 + col) = o1;
                u32x2 pw1; pw1.x = pk2(o1[0], o1[1]); pw1.y = pk2(o1[2], o1[3]);
                *(u32x2*)(x1b + (size_t)row1 * 1024 + col) = pw1;
            }
        }
    }
}

__device__ __forceinline__ int sortable(int bits) { return bits ^ ((bits >> 31) & 0x7fffffff); }
__device__ __forceinline__ void sort16_asc(int (&a)[16]) {
#pragma unroll
    for (int k = 2; k <= 16; k <<= 1)
#pragma unroll
        for (int j = k >> 1; j > 0; j >>= 1)
#pragma unroll
            for (int i = 0; i < 16; ++i) { const int l = i ^ j;
                if (l > i) { const int lo = min(a[i], a[l]), hi = max(a[i], a[l]); const bool up = ((i & k) == 0); a[i] = up ? lo : hi; a[l] = up ? hi : lo; } }
}
__device__ __forceinline__ void merge_top16(int (&top)[16], const int (&asc)[16]) {
#pragma unroll
    for (int i = 0; i < 16; ++i) top[i] = max(top[i], asc[i]);
#pragma unroll
    for (int j = 8; j > 0; j >>= 1)
#pragma unroll
        for (int i = 0; i < 16; ++i) { const int l = i ^ j; if (l > i) { const int lo = min(top[i], top[l]), hi = max(top[i], top[l]); top[i] = hi; top[l] = lo; } }
}
__device__ void phase_peer(const Params& P, unsigned char* lds, cg::grid_group& grid) {
    const bool align_sync = false;
    const int tid = threadIdx.x, wid = __builtin_amdgcn_readfirstlane(tid >> 6), lane = tid & 63;
    int* ridx = (int*)lds;
    float* rgt = (float*)(lds + 33024);
    const float* qp = (const float*)(P.ws + O_QP); const bf16_t* x1b = (const bf16_t*)(P.ws + O_X1B);
    const unsigned char* u8t = P.ws + O_UB; const unsigned char* v8t = P.ws + O_VB; const bf16_t* ple = (const bf16_t*)(P.ws + O_PP);
    float* xo = P.out;
    for (int tile = blockIdx.x; tile < NTOK / 64; tile += gridDim.x) {
        const int tok0 = tile * 64;
#ifndef NO_ROUTE
#ifdef PROBE_T
        unsigned long long pt0 = __builtin_amdgcn_s_memrealtime();
#endif
        {
            const int token = tok0 + lane;
            int* Ls = (int*)(lds + 66048) + wid * 32 * 64 + lane;
            typedef float f32x16 __attribute__((ext_vector_type(16)));
            const int lc = lane & 31, lh = lane >> 5;
#define SPLIT8(HI, LO, A0, A1) do { \
                const float v_[8] = {A0[0], A0[1], A0[2], A0[3], A1[0], A1[1], A1[2], A1[3]}; unsigned h_[4], l_[4]; \
                _Pragma("unroll") for (int e_ = 0; e_ < 4; ++e_) { h_[e_] = pk2(v_[2 * e_], v_[2 * e_ + 1]); l_[e_] = pk2(v_[2 * e_] - bflo(h_[e_]), v_[2 * e_ + 1] - bfhi(h_[e_])); } \
                HI = __builtin_bit_cast(bf16x8, (u32x4){h_[0], h_[1], h_[2], h_[3]}); LO = __builtin_bit_cast(bf16x8, (u32x4){l_[0], l_[1], l_[2], l_[3]}); } while (0)
#pragma unroll 1
            for (int p = 0; p < 2; ++p) {
                bf16x8 Qh[2][4], Ql[2][4];
#pragma unroll
                for (int nt = 0; nt < 2; ++nt)
#pragma unroll
                    for (int ks = 0; ks < 4; ++ks) {
                        const float* qr = qp + (size_t)(tok0 + nt * 32 + lc) * 1024 + wid * 128 + p * 64 + ks * 16 + lh * 8;
                        const f32x4 a0 = *(const f32x4*)qr, a1 = *(const f32x4*)(qr + 4);
                        SPLIT8(Qh[nt][ks], Ql[nt][ks], a0, a1);
                    }
                int topA[16], topB[16];
#pragma unroll
                for (int i = 0; i < 16; ++i) { topA[i] = (int)0x80000000; topB[i] = (int)0x80000000; }
                const float* keys = P.peer_subkeys + (size_t)((wid * 2 + p) * 128) * 64;
#pragma unroll 1
                for (int mt = 0; mt < 4; ++mt) {
                    bf16x8 Kh[4], Kl[4];
#pragma unroll
                    for (int ks = 0; ks < 4; ++ks) {
                        const float* kr = keys + (size_t)(mt * 32 + lc) * 64 + ks * 16 + lh * 8;
                        const f32x4 a0 = *(const f32x4*)kr, a1 = *(const f32x4*)(kr + 4);
                        SPLIT8(Kh[ks], Kl[ks], a0, a1);
                    }
#pragma unroll
                    for (int nt = 0; nt < 2; ++nt) {
                        f32x16 acc;
#pragma unroll
                        for (int i = 0; i < 16; ++i) acc[i] = 0.f;
#pragma unroll
                        for (int ks = 0; ks < 4; ++ks) {
                            acc = __builtin_amdgcn_mfma_f32_32x32x16_bf16(Kh[ks], Qh[nt][ks], acc, 0, 0, 0);
                            acc = __builtin_amdgcn_mfma_f32_32x32x16_bf16(Kh[ks], Ql[nt][ks], acc, 0, 0, 0);
                            acc = __builtin_amdgcn_mfma_f32_32x32x16_bf16(Kl[ks], Qh[nt][ks], acc, 0, 0, 0);
                        }
                        int nk16[16];
#pragma unroll
                        for (int i = 0; i < 16; ++i) { const int kidx = mt * 32 + 8 * (i >> 2) + 4 * lh + (i & 3); nk16[i] = sortable((__float_as_int(acc[i]) & ~127) | kidx); }
                        sort16_asc(nk16);
                        if (nt == 0) merge_top16(topA, nk16); else merge_top16(topB, nk16);
                    }
                }
                int mine[16];
#pragma unroll
                for (int i = 0; i < 16; ++i) mine[i] = lh ? topB[i] : topA[i];
                int recv[16];
#pragma unroll
                for (int i = 0; i < 16; ++i) { const int send = lh ? topA[15 - i] : topB[15 - i]; recv[i] = __shfl_xor(send, 32); }
                merge_top16(mine, recv);
#pragma unroll
                for (int i = 0; i < 16; ++i) Ls[(p * 16 + i) * 64] = mine[i];
            }
#undef SPLIT8
            int top2k[16];
#pragma unroll
            for (int i = 0; i < 16; ++i) top2k[i] = (int)0x80000000;
#pragma unroll 1
            for (int i = 0; i < 16; ++i) {
                const int b0 = sortable(Ls[i * 64]); const float va = __int_as_float(b0 & ~127);
                const int jmax = 16 / (i + 1);
#pragma unroll 1
                for (int j = 0; j < jmax; ++j) {
                    const int b1 = sortable(Ls[(16 + j) * 64]);
                    const float sm = va + __int_as_float(b1 & ~127);
                    int key = sortable((__float_as_int(sm) & ~255) | (i << 4) | j);
#pragma unroll
                    for (int m = 0; m < 16; ++m) { const int hi = max(top2k[m], key); key = min(top2k[m], key); top2k[m] = hi; }
                }
            }
            long long top2[16];
#pragma unroll
            for (int m = 0; m < 16; ++m) {
                const int bits = sortable(top2k[m]); const int ci = (bits >> 4) & 15, cj = bits & 15;
                const int e0 = sortable(Ls[ci * 64]) & 127, e1 = sortable(Ls[(16 + cj) * 64]) & 127;
                top2[m] = (long long)((((unsigned long long)(unsigned)sortable(bits & ~255)) << 32) | (unsigned long long)(unsigned)(e0 * 128 + e1));
            }
            float e[16]; float smax = __int_as_float(sortable((int)(top2[0] >> 32))); float den = 0.f;
#pragma unroll
            for (int m = 0; m < 16; ++m) { const float sv = __int_as_float(sortable((int)(top2[m] >> 32))); e[m] = __expf(sv - smax); den += e[m]; }
            const float inv = 1.0f / den;
#ifdef PEER3
            {
                int* RI = (int*)(P.ws + O_RIDX) + (size_t)token * 128 + wid * 16; float* RWp = (float*)(P.ws + O_RG) + (size_t)token * 128 + wid * 16;
#pragma unroll
                for (int m4 = 0; m4 < 4; ++m4) {
                    *(u32x4*)(RI + m4 * 4) = (u32x4){(unsigned)(top2[m4 * 4] & 0xffffffffll), (unsigned)(top2[m4 * 4 + 1] & 0xffffffffll), (unsigned)(top2[m4 * 4 + 2] & 0xffffffffll), (unsigned)(top2[m4 * 4 + 3] & 0xffffffffll)};
                    *(f32x4*)(RWp + m4 * 4) = (f32x4){e[m4 * 4] * inv, e[m4 * 4 + 1] * inv, e[m4 * 4 + 2] * inv, e[m4 * 4 + 3] * inv};
                }
            }
#else
#pragma unroll
            for (int m = 0; m < 16; ++m) { ridx[lane * 129 + wid * 16 + m] = (int)(unsigned)(top2[m] & 0xffffffffll); rgt[lane * 129 + wid * 16 + m] = e[m] * inv; }
#endif
        }
#endif
        __syncthreads();
#ifdef PEER3
        continue;
#endif
#ifndef NO_GATHER
#ifdef PROBE_T
        unsigned long long pt1 = __builtin_amdgcn_s_memrealtime();
#endif
        {
            const int j = lane & 15, g = lane >> 4;
            unsigned char* xt = lds + 82560;
#pragma unroll 1
            for (int half = 0; half < 2; ++half) {
                for (int i = tid; i < 32 * 128; i += 512) { const int t = i >> 7, c16 = i & 127; *(u32x4*)(xt + t * 2064 + c16 * 16) = *(const u32x4*)(x1b + (size_t)(tok0 + half * 32 + t) * 1024 + c16 * 8); }
                __syncthreads();
                float dkeep = 0.f; int pkeep = -1; int nk = 0;
                int r_ = 0, ch_ = wid - 8; unsigned long long m0 = 0ull, m1 = 0ull;
#define PA_ADV(VALID, TL, BS, ACT) do { VALID = true; \
                    while (!(m0 | m1)) { ch_ += 8; if (ch_ >= 32) { ch_ = wid; if (++r_ >= 1) { VALID = false; break; } } \
                        const int tl_ = half * 32 + ch_; const int id0 = ridx[tl_ * 129 + lane], id1 = ridx[tl_ * 129 + 64 + lane]; \
                        m0 = __ballot((id0 >> 14) == r_); m1 = __ballot((id1 >> 14) == r_); } \
                    if (VALID) { int bb[4]; \
                        _Pragma("unroll") for (int q = 0; q < 4; ++q) { \
                            if (m0) { bb[q] = __ffsll((long long)m0) - 1; m0 &= m0 - 1; } \
                            else if (m1) { bb[q] = 64 + __ffsll((long long)m1) - 1; m1 &= m1 - 1; } \
                            else bb[q] = -1; } \
                        const int bg = g == 0 ? bb[0] : (g == 1 ? bb[1] : (g == 2 ? bb[2] : bb[3])); \
                        ACT = bg >= 0; BS = ACT ? bg : bb[0]; TL = half * 32 + ch_; } else { ACT = false; BS = 0; TL = half * 32; } } while (0)
#define PA_LOAD(U, TL, BS) do { const int pidx = ridx[(TL) * 129 + (BS)]; const unsigned char* ur = u8t + (size_t)pidx * 1024 + j * 16; \
                    _Pragma("unroll") for (int i = 0; i < 4; ++i) U[i] = *(const u32x4*)(ur + i * 256); } while (0)
#define PA_COMP(U, TL, BS, ACT) do { \
                        const unsigned char* xrow = xt + ((TL) - half * 32) * 2064 + j * 32; \
                        float d0 = 0.f, d1 = 0.f; \
                        _Pragma("unroll") for (int i = 0; i < 4; ++i) { \
                            const u32x4 xa = *(const u32x4*)(xrow + i * 512), xb_ = *(const u32x4*)(xrow + i * 512 + 16); \
                            _Pragma("unroll") for (int q = 0; q < 4; ++q) { \
                                const u32x4 xs = q < 2 ? xa : xb_; \
                                const unsigned wd = U[i][q]; \
                                const f32x2 lo_ = __builtin_amdgcn_cvt_pk_f32_fp8((int)wd, false), hi_ = __builtin_amdgcn_cvt_pk_f32_fp8((int)wd, true); \
                                d0 = dot2bf(pk2(lo_.x, lo_.y), xs[(q & 1) * 2], d0); d1 = dot2bf(pk2(hi_.x, hi_.y), xs[(q & 1) * 2 + 1], d1); } } \
                        float dsum = d0 + d1; \
                        dsum += __shfl_xor(dsum, 1); dsum += __shfl_xor(dsum, 2); dsum += __shfl_xor(dsum, 4); dsum += __shfl_xor(dsum, 8); \
                        dsum *= (1.0f / 256.0f); \
                        if (j == nk) { dkeep = dsum; pkeep = (ACT) ? (TL) * 129 + (BS) : -1; } \
                        if (++nk == 16) { \
                            if (pkeep >= 0) { const float hid = 0.5f * dkeep * (1.0f + erff(dkeep * 0.70710678118f)); rgt[pkeep] *= hid * (1.0f / 32.0f); } \
                            nk = 0; pkeep = -1; } } while (0)
                bool vA, vB, actA = false, actB = false; int tlA = 0, tlB = 0, bsA = 0, bsB = 0; u32x4 uA[4], uB[4];
                PA_ADV(vA, tlA, bsA, actA);
                PA_LOAD(uA, tlA, bsA);
                while (vA) {
                    PA_ADV(vB, tlB, bsB, actB);
                    PA_LOAD(uB, tlB, bsB);
                    PA_COMP(uA, tlA, bsA, actA);
                    if (!vB) break;
                    PA_ADV(vA, tlA, bsA, actA);
                    PA_LOAD(uA, tlA, bsA);
                    PA_COMP(uB, tlB, bsB, actB);
                }
#undef PA_COMP
#undef PA_ADV
#undef PA_LOAD
                if (pkeep >= 0) { const float hid = 0.5f * dkeep * (1.0f + erff(dkeep * 0.70710678118f)); rgt[pkeep] *= hid * (1.0f / 32.0f); }
                __syncthreads();
            }
#ifdef PROBE_T
            unsigned long long pt2 = __builtin_amdgcn_s_memrealtime();
            { unsigned long long* tsl = (unsigned long long*)(lds + 163840 - 64); if (tid == 0) { tsl[0] = pt1 - pt0; tsl[1] = pt2 - pt1; } }
#endif
#ifdef PEER2
            {
                int* RI = (int*)(P.ws + O_RIDX) + (size_t)tok0 * 128; float* RWp = (float*)(P.ws + O_RW) + (size_t)tok0 * 128;
                for (int i = tid; i < 64 * 128; i += 512) { RI[i] = ridx[(i >> 7) * 129 + (i & 127)]; RWp[i] = rgt[(i >> 7) * 129 + (i & 127)]; }
            }
            continue;
#endif
#pragma unroll 1
            for (int tt = 0; tt < 8; ++tt) {
                const int tl = wid * 8 + tt, token = tok0 + tl;
                f32x2 acc[32];
#pragma unroll
                for (int i = 0; i < 32; ++i) acc[i] = (f32x2){0.f, 0.f};
#define PEER_LOAD(V, GT, IT) do { const int e_ = (IT) * 4 + g; const int idx_ = ridx[tl * 129 + e_]; GT = rgt[tl * 129 + e_]; \
                    const unsigned char* vr_ = v8t + (size_t)idx_ * 1024 + j * 16; \
                    _Pragma("unroll") for (int i = 0; i < 4; ++i) V[i] = *(const u32x4*)(vr_ + i * 256); } while (0)
#define PEER_COMP(V, GT) do { const f32x2 ww = {GT, GT}; \
                    _Pragma("unroll") for (int i = 0; i < 4; ++i) _Pragma("unroll") for (int q = 0; q < 4; ++q) { const int wd = (int)V[i][q]; \
                        acc[i * 8 + q * 2] = __builtin_elementwise_fma(ww, __builtin_amdgcn_cvt_pk_f32_fp8(wd, false), acc[i * 8 + q * 2]); \
                        acc[i * 8 + q * 2 + 1] = __builtin_elementwise_fma(ww, __builtin_amdgcn_cvt_pk_f32_fp8(wd, true), acc[i * 8 + q * 2 + 1]); } } while (0)
                u32x4 vA[4], vB[4], vC[4], vD[4]; float gA, gB, gC, gD;
                PEER_LOAD(vA, gA, 0); PEER_LOAD(vB, gB, 1); PEER_LOAD(vC, gC, 2);
#pragma unroll 1
                for (int it = 0; it < 32; it += 4) {
                    PEER_LOAD(vD, gD, it + 3);
                    PEER_COMP(vA, gA);
                    PEER_LOAD(vA, gA, (it + 4 < 32 ? it + 4 : 31));
                    PEER_COMP(vB, gB);
                    PEER_LOAD(vB, gB, (it + 5 < 32 ? it + 5 : 31));
                    PEER_COMP(vC, gC);
                    PEER_LOAD(vC, gC, (it + 6 < 32 ? it + 6 : 31));
                    PEER_COMP(vD, gD);
                }
#undef PEER_LOAD
#undef PEER_COMP
#pragma unroll
                for (int i = 0; i < 32; ++i) {
                    acc[i].x += __shfl_xor(acc[i].x, 16); acc[i].y += __shfl_xor(acc[i].y, 16);
                    acc[i].x += __shfl_xor(acc[i].x, 32); acc[i].y += __shfl_xor(acc[i].y, 32);
                }
                const size_t col = (size_t)(j + 16 * g) * 16;
                float yv[16]; float s = 0.f;
                {
                    const u32x4 pw0 = *(const u32x4*)(ple + (size_t)token * 1024 + col), pw1 = *(const u32x4*)(ple + (size_t)token * 1024 + col + 8);
                    const float pv[16] = {bflo(pw0.x), bfhi(pw0.x), bflo(pw0.y), bfhi(pw0.y), bflo(pw0.z), bfhi(pw0.z), bflo(pw0.w), bfhi(pw0.w),
                                          bflo(pw1.x), bfhi(pw1.x), bflo(pw1.y), bfhi(pw1.y), bflo(pw1.z), bfhi(pw1.z), bflo(pw1.w), bfhi(pw1.w)};
#pragma unroll
                    for (int q = 0; q < 8; ++q) {
                        const f32x2 a_ = g == 0 ? acc[q] : (g == 1 ? acc[8 + q] : (g == 2 ? acc[16 + q] : acc[24 + q]));
                        const f32x2 x_ = *(const f32x2*)(xo + (size_t)token * 1024 + col + q * 2);
                        const float y0 = DN_ALPHA * x_.x + a_.x + pv[q * 2], y1 = DN_ALPHA * x_.y + a_.y + pv[q * 2 + 1];
                        yv[q * 2] = y0; yv[q * 2 + 1] = y1; s += y0 + y1;
                    }
                }
                const float mu = wave_sum(s) * (1.0f / 1024.0f);
                float qq = 0.f;
#pragma unroll
                for (int q = 0; q < 16; ++q) { yv[q] -= mu; qq += yv[q] * yv[q]; }
                const float rstd = rsqrtf(wave_sum(qq) * (1.0f / 1024.0f) + 1e-5f);
                {
                    const float* lg = P.ln2_g; const float* lb = P.ln2_b; asm volatile("" : "+s"(lg), "+s"(lb));
#pragma unroll
                    for (int q = 0; q < 4; ++q) {
                        const f32x4 gg = *(const f32x4*)(lg + col + q * 4), bb = *(const f32x4*)(lb + col + q * 4);
                        f32x4 o;
#pragma unroll
                        for (int r = 0; r < 4; ++r) o[r] = yv[q * 4 + r] * rstd * gg[r] + bb[r];
                        *(f32x4*)(xo + (size_t)token * 1024 + col + q * 4) = o;
                    }
                }
            }
        }
#endif
        __syncthreads();
    }
}

#define XB_TMO      128
#define XB_XCNT(j)  (256  + 64 * (j))
#define XB_XSUB(j)  (1280 + 64 * (j))
#define XB_XGEN(j)  (2304 + 64 * (j))
#define XB_TOP      3328
#define XB_TOPGEN   3392
#define XCD_BAR_WORDS 3456
#define XB_SPIN_CAP (1u << 18)
#define LAS __attribute__((address_space(3)))

__device__ __forceinline__ unsigned xb_ld(unsigned* p)              { return __hip_atomic_load(p, __ATOMIC_RELAXED, __HIP_MEMORY_SCOPE_AGENT); }
__device__ __forceinline__ unsigned xb_add(unsigned* p, unsigned v) { return __hip_atomic_fetch_add(p, v, __ATOMIC_RELAXED, __HIP_MEMORY_SCOPE_AGENT); }
__device__ __forceinline__ unsigned xb_xcc_id() { return (unsigned)__builtin_amdgcn_s_getreg((3 << 11) | 20) & 0xFu; }
#define XB_SPIN(cond, bar) do { unsigned _sp = 0; while (cond) { __builtin_amdgcn_s_sleep(1); \
    if ((++_sp & 255u) == 0u) { if (xb_ld(&(bar)[XB_TMO])) break; if (_sp > XB_SPIN_CAP) { atomicAdd(&(bar)[XB_TMO], 1u); break; } } } } while (0)

struct XcdBarrier {
    unsigned* bar; unsigned x;
    volatile LAS unsigned* st;
};

__device__ __forceinline__ XcdBarrier xcd_barrier_post(unsigned* bar, volatile LAS unsigned* st) {
    XcdBarrier b; b.bar = bar; b.x = xb_xcc_id(); b.st = st;
    if (threadIdx.x == 0) (void)xb_add(&bar[XB_XCNT(b.x)], 1u);
    return b;
}
__device__ __forceinline__ void xcd_barrier_complete(unsigned* bar, unsigned x, unsigned& nloc, unsigned& nx) {
    const unsigned G = gridDim.x * gridDim.y * gridDim.z;
    unsigned sum, cnt, mine, sp = 0u;
    for (;;) {
        sum = 0u; cnt = 0u; mine = 0u;
#pragma unroll
        for (unsigned j = 0; j < 16; ++j) { const unsigned c = xb_ld(&bar[XB_XCNT(j)]); sum += c; cnt += (c > 0u) ? 1u : 0u; mine = (j == x) ? c : mine; }
        if (sum == G) break;
        __builtin_amdgcn_s_sleep(1);
        if ((++sp & 255u) == 0u) { if (xb_ld(&bar[XB_TMO])) break; if (sp > XB_SPIN_CAP) { atomicAdd(&bar[XB_TMO], 1u); break; } }
    }
    nloc = mine > 0u ? mine : 1u; nx = cnt > 0u ? cnt : 1u;
}

__device__ __forceinline__ void xcd_barrier(const XcdBarrier& b) {
    asm volatile("s_waitcnt vmcnt(0)" ::: "memory");
    __syncthreads();
    if (threadIdx.x == 0) {
        unsigned* bar = b.bar;
        __builtin_amdgcn_s_waitcnt(0);
        unsigned nloc = b.st[0], nx = b.st[1];
        if (nloc == 0u) { xcd_barrier_complete(bar, b.x, nloc, nx); b.st[0] = nloc; b.st[1] = nx; }
        const unsigned old = xb_add(&bar[XB_XSUB(b.x)], 1u);
        const unsigned gen = old / nloc;
        if (old + 1u == (gen + 1u) * nloc) {
            __builtin_amdgcn_fence(__ATOMIC_RELEASE, "agent");
            asm volatile("s_waitcnt vmcnt(0)" ::: "memory");
            const unsigned og = xb_add(&bar[XB_TOP], 1u);
            const unsigned tg = og / nx;
            if (og + 1u == (tg + 1u) * nx) xb_add(&bar[XB_TOPGEN], 1u);
            else XB_SPIN(xb_ld(&bar[XB_TOPGEN]) == tg, bar);
            __builtin_amdgcn_fence(__ATOMIC_ACQUIRE, "agent");
            xb_add(&bar[XB_XGEN(b.x)], 1u);
            asm volatile("s_waitcnt vmcnt(0)" ::: "memory");
        } else {
            XB_SPIN(xb_ld(&bar[XB_XGEN(b.x)]) == gen, bar);
            __builtin_amdgcn_fence(__ATOMIC_ACQUIRE, "agent");
            asm volatile("s_waitcnt vmcnt(0)" ::: "memory");
        }
    }
    __syncthreads();
}


constexpr size_t O_BAR = 250 * MBY;
__device__ __forceinline__ void counter_barrier(unsigned* cnt, unsigned& epoch) {
    asm volatile("s_waitcnt vmcnt(0)" ::: "memory");
    __syncthreads();
    if (threadIdx.x == 0) {
        __builtin_amdgcn_fence(__ATOMIC_RELEASE, "agent");
        asm volatile("s_waitcnt vmcnt(0)" ::: "memory");
        (void)__hip_atomic_fetch_add(cnt, 1u, __ATOMIC_RELAXED, __HIP_MEMORY_SCOPE_AGENT);
        const unsigned target = (epoch + 1u) * gridDim.x;
        while (__hip_atomic_load(cnt, __ATOMIC_RELAXED, __HIP_MEMORY_SCOPE_AGENT) < target) __builtin_amdgcn_s_sleep(2);
        __builtin_amdgcn_fence(__ATOMIC_ACQUIRE, "agent");
        asm volatile("s_waitcnt vmcnt(0)" ::: "memory");
    }
    ++epoch;
    __syncthreads();
}

#ifdef PEER2
__device__ __forceinline__ int peer_pop(unsigned* q, volatile int* slot) {
    __syncthreads();
    if (threadIdx.x == 0) *slot = (int)__hip_atomic_fetch_add(q, 1u, __ATOMIC_RELAXED, __HIP_MEMORY_SCOPE_AGENT);
    __syncthreads();
    return *slot;
}
__device__ __forceinline__ int peer_next(unsigned* q, int k0, int& kk, unsigned limit, volatile int* slot) {
    __syncthreads();
    if (threadIdx.x == 0) {
        int fk = -1, t = 0;
        for (int i = kk; i < 8; ++i) {
            unsigned* qa = q + ((k0 + i) & 7) * 64;
            if (__hip_atomic_load(qa, __ATOMIC_RELAXED, __HIP_MEMORY_SCOPE_AGENT) >= limit) continue;
            const unsigned tt = __hip_atomic_fetch_add(qa, 1u, __ATOMIC_RELAXED, __HIP_MEMORY_SCOPE_AGENT);
            if (tt < limit) { fk = i; t = (int)tt; break; }
        }
        slot[0] = fk; slot[1] = t;
    }
    __syncthreads();
    kk = slot[0]; return slot[1];
}
struct PeerTickets { int is_static, rank, nloc, t, kk; };
__device__ __forceinline__ void peer_tickets_init(PeerTickets& T, unsigned* bar, volatile int* slot) {
    __syncthreads();
    if (threadIdx.x == 0) {
        const unsigned G = gridDim.x; bool ok = (G % 8u) == 0u && (NTOK / 128) % (int)(G / 8u) == 0;
        for (unsigned jx = 0; jx < 16; ++jx) { const unsigned c = __hip_atomic_load(&bar[XB_XCNT(jx)], __ATOMIC_RELAXED, __HIP_MEMORY_SCOPE_AGENT); if (c != (jx < 8 ? G / 8u : 0u)) ok = false; }
        slot[0] = ok ? 1 : 0;
    }
    __syncthreads();
    T.is_static = slot[0]; T.rank = slot[2]; T.nloc = (int)(gridDim.x / 8u); T.t = 0; T.kk = 0;
    __syncthreads();
}
__device__ __forceinline__ int peer_ticket(PeerTickets& T, unsigned* q, int k0, unsigned limit, volatile int* slot) {
    if (T.is_static) {
        __syncthreads();
        const int g = T.rank + T.t * T.nloc; ++T.t;
        if (g >= (int)limit) { T.kk = -1; return 0; }
        T.kk = 0; return g;
    }
    return peer_next(q, k0, T.kk, limit, slot);
}
__device__ void peer_passA2(const Params& P, unsigned char* lds) {
    const int tid = threadIdx.x, wid = __builtin_amdgcn_readfirstlane(tid >> 6), lane = tid & 63, j = lane & 15, g = lane >> 4;
    const int* RI = (const int*)(P.ws + O_RIDX); float* RWp = (float*)(P.ws + O_RW);
    const bf16_t* x1b = (const bf16_t*)(P.ws + O_X1B); const unsigned char* u8t = P.ws + O_UB;
    unsigned char* xt = lds;
    unsigned short* ids = (unsigned short*)(lds + 132096);
    volatile int* slot = (volatile int*)(lds + 163840 - 48);
    unsigned* qA = (unsigned*)(P.ws + O_BAR) + 3584;
    const int k0 = (int)(xb_xcc_id() & 7u);
#pragma unroll 1
    for (int kk = 0; kk < 8; ++kk) {
        const int k = (k0 + kk) & 7;
#pragma unroll 1
        for (;;) {
            const int grp = peer_pop(qA + k * 64, slot);
            if (grp >= NTOK / 64) break;
            const int tok0 = grp * 64;
            for (int i = tid; i < 64 * 128; i += 512) { const int t = i >> 7, c16 = i & 127; *(u32x4*)(xt + t * 2064 + c16 * 16) = *(const u32x4*)(x1b + (size_t)(tok0 + t) * 1024 + c16 * 8); }
            for (int i = tid; i < 64 * 128 / 4; i += 512) { const u32x4 v = *(const u32x4*)(RI + (size_t)tok0 * 128 + i * 4); *(u32x2*)(ids + i * 4) = (u32x2){(v.x & 0xffffu) | (v.y << 16), (v.z & 0xffffu) | (v.w << 16)}; }
            __syncthreads();
            float dkeep = 0.f; int pkeep = -1; int nk = 0;
            int ch_ = -1; unsigned long long m0 = 0ull, m1 = 0ull;
#define PA_ADV(VALID, TL, BS, ACT) do { VALID = true; \
                while (!(m0 | m1)) { if (++ch_ >= 8) { VALID = false; break; } \
                    const int tl_ = wid * 8 + ch_; const int id0 = ids[tl_ * 128 + lane], id1 = ids[tl_ * 128 + 64 + lane]; \
                    m0 = __ballot((id0 >> 11) == k); m1 = __ballot((id1 >> 11) == k); } \
                if (VALID) { int bb[4]; \
                    _Pragma("unroll") for (int q = 0; q < 4; ++q) { \
                        if (m0) { bb[q] = __ffsll((long long)m0) - 1; m0 &= m0 - 1; } \
                        else if (m1) { bb[q] = 64 + __ffsll((long long)m1) - 1; m1 &= m1 - 1; } \
                        else bb[q] = -1; } \
                    const int bg = g == 0 ? bb[0] : (g == 1 ? bb[1] : (g == 2 ? bb[2] : bb[3])); \
                    ACT = bg >= 0; BS = ACT ? bg : bb[0]; TL = wid * 8 + ch_; } else { ACT = false; BS = 0; TL = wid * 8; } } while (0)
#define PA_LOAD(U, TL, BS) do { const int pidx = ids[(TL) * 128 + (BS)]; const unsigned char* ur = u8t + (size_t)pidx * 1024 + j * 16; \
                _Pragma("unroll") for (int i = 0; i < 4; ++i) U[i] = *(const u32x4*)(ur + i * 256); } while (0)
#define PA_COMP(U, TL, BS, ACT) do { \
                const unsigned char* xrow = xt + (TL) * 2064 + j * 32; \
                float d0 = 0.f, d1 = 0.f; \
                _Pragma("unroll") for (int i = 0; i < 4; ++i) { \
                    const u32x4 xa = *(const u32x4*)(xrow + i * 512), xb_ = *(const u32x4*)(xrow + i * 512 + 16); \
                    _Pragma("unroll") for (int q = 0; q < 4; ++q) { \
                        const u32x4 xs = q < 2 ? xa : xb_; \
                        const unsigned wd = U[i][q]; \
                        const f32x2 lo_ = __builtin_amdgcn_cvt_pk_f32_fp8((int)wd, false), hi_ = __builtin_amdgcn_cvt_pk_f32_fp8((int)wd, true); \
                        d0 = dot2bf(pk2(lo_.x, lo_.y), xs[(q & 1) * 2], d0); d1 = dot2bf(pk2(hi_.x, hi_.y), xs[(q & 1) * 2 + 1], d1); } } \
                float dsum = d0 + d1; \
                dsum += __shfl_xor(dsum, 1); dsum += __shfl_xor(dsum, 2); dsum += __shfl_xor(dsum, 4); dsum += __shfl_xor(dsum, 8); \
                dsum *= (1.0f / 256.0f); \
                if (j == nk) { dkeep = dsum; pkeep = (ACT) ? (tok0 + (TL)) * 128 + (BS) : -1; } \
                if (++nk == 16) { \
                    if (pkeep >= 0) { const float hid = 0.5f * dkeep * (1.0f + erff(dkeep * 0.70710678118f)); RWp[pkeep] *= hid * (1.0f / 32.0f); } \
                    nk = 0; pkeep = -1; } } while (0)
            bool vA, vB, actA = false, actB = false; int tlA = 0, tlB = 0, bsA = 0, bsB = 0; u32x4 uA[4], uB[4];
            PA_ADV(vA, tlA, bsA, actA);
            PA_LOAD(uA, tlA, bsA);
            while (vA) {
                PA_ADV(vB, tlB, bsB, actB);
                PA_LOAD(uB, tlB, bsB);
                PA_COMP(uA, tlA, bsA, actA);
                if (!vB) break;
                PA_ADV(vA, tlA, bsA, actA);
                PA_LOAD(uA, tlA, bsA);
                PA_COMP(uB, tlB, bsB, actB);
            }
#undef PA_ADV
#undef PA_LOAD
#undef PA_COMP
            if (pkeep >= 0) { const float hid = 0.5f * dkeep * (1.0f + erff(dkeep * 0.70710678118f)); RWp[pkeep] *= hid * (1.0f / 32.0f); }
        }
    }
}
#ifdef PEER3
__device__ void peer_passA3(const Params& P, unsigned char* lds) {
    const int tid = threadIdx.x, wid = __builtin_amdgcn_readfirstlane(tid >> 6), lane = tid & 63, j8 = lane & 7, t8 = lane >> 3;
    const int* RI = (const int*)(P.ws + O_RIDX); const float* x1 = P.out; float* PART = (float*)(P.ws + O_PART);
    volatile int* slot = (volatile int*)(lds + 163840 - 48);
    unsigned* qA = (unsigned*)(P.ws + O_BAR) + 3584;
    const int k0 = (int)(xb_xcc_id() & 7u);
    PeerTickets TK; peer_tickets_init(TK, (unsigned*)(P.ws + O_BAR), slot);
#pragma unroll 1
    for (;;) {
        const int grp = peer_ticket(TK, qA, k0, (unsigned)(NTOK / 128), slot); const int kk = TK.kk;
        if (kk < 0) break;
        const int k = (k0 + kk) & 7;
        const unsigned char* ublk = P.ws + O_UB + (size_t)k * 16384 * 128 + j8 * 16;
        {
            u32x4* li0 = (u32x4*)lds; const u32x4* gi = (const u32x4*)(RI + (size_t)grp * 128 * 128);
            for (int i = tid; i < 128 * 32; i += 512) li0[(i >> 5) * 33 + (i & 31)] = gi[i];
        }
        __syncthreads();
#pragma unroll 1
        for (int sub = 0; sub < 2; ++sub) {
            const int tl = sub * 64 + wid * 8 + t8, token = grp * 128 + tl;
            const int* li = (const int*)lds + tl * 132;
            f32x2 xp[8];
#pragma unroll
            for (int q = 0; q < 4; ++q) { const f32x4 v = *(const f32x4*)(x1 + (size_t)token * 1024 + k * 128 + j8 * 16 + q * 4); xp[q * 2] = (f32x2){v[0], v[1]}; xp[q * 2 + 1] = (f32x2){v[2], v[3]}; }
            float* po = PART + (size_t)k * NTOK * 128 + (size_t)token * 128 + j8;
#define PA3_LOAD(V, IT) do { _Pragma("unroll") for (int q = 0; q < 8; ++q) V[q] = *(const u32x4*)(ublk + (size_t)li[(IT) + q] * 128); } while (0)
#define PA3_COMP(V, IT) do { float s_[8]; \
                _Pragma("unroll") for (int q = 0; q < 8; ++q) { f32x2 a0 = {0.f, 0.f}, a1 = {0.f, 0.f}; \
                    _Pragma("unroll") for (int d = 0; d < 4; ++d) { const int wd = (int)V[q][d]; \
                        a0 = __builtin_elementwise_fma(__builtin_amdgcn_cvt_pk_f32_fp8(wd, false), xp[d * 2], a0); \
                        a1 = __builtin_elementwise_fma(__builtin_amdgcn_cvt_pk_f32_fp8(wd, true), xp[d * 2 + 1], a1); } \
                    const f32x2 a = a0 + a1; s_[q] = a.x + a.y; } \
                float r4[4]; \
                _Pragma("unroll") for (int i = 0; i < 4; ++i) { const float mine = (j8 & 4) ? s_[4 + i] : s_[i], oth = (j8 & 4) ? s_[i] : s_[4 + i]; r4[i] = mine + dpp_xor4(oth); } \
                float r2[2]; \
                _Pragma("unroll") for (int i = 0; i < 2; ++i) { const float mine = (j8 & 2) ? r4[2 + i] : r4[i], oth = (j8 & 2) ? r4[i] : r4[2 + i]; r2[i] = mine + dpp_xor2(oth); } \
                const float mine1 = (j8 & 1) ? r2[1] : r2[0], oth1 = (j8 & 1) ? r2[0] : r2[1]; \
                po[(IT)] = mine1 + dpp_xor1(oth1); } while (0)
            u32x4 vA[8], vB[8]; int iA[8], iB[8];
#define PA3_IDX(I, IT) do { _Pragma("unroll") for (int q = 0; q < 8; ++q) I[q] = li[(IT) + q]; } while (0)
#define PA3_LOADI(V, I) do { _Pragma("unroll") for (int q = 0; q < 8; ++q) V[q] = *(const u32x4*)(ublk + (size_t)(unsigned)I[q] * 128); } while (0)
            PA3_IDX(iA, 0); PA3_IDX(iB, 8);
            PA3_LOADI(vA, iA);
#pragma unroll 1
            for (int it = 0; it < 128; it += 16) {
                PA3_LOADI(vB, iB);
                PA3_IDX(iA, (it + 16 < 128 ? it + 16 : 112));
                PA3_COMP(vA, it);
                PA3_LOADI(vA, iA);
                PA3_IDX(iB, (it + 24 < 128 ? it + 24 : 120));
                PA3_COMP(vB, it + 8);
            }
#undef PA3_IDX
#undef PA3_LOADI
#undef PA3_LOAD
#undef PA3_COMP
        }
    }
}
__device__ void peer_reduce3(const Params& P) {
    const float* PART = (const float*)(P.ws + O_PART); const float* RG = (const float*)(P.ws + O_RG); float* RWp = (float*)(P.ws + O_RW);
    for (int i = blockIdx.x * 512 + threadIdx.x; i < NTOK * 128 / 4; i += gridDim.x * 512) {
        f32x4 d = *(const f32x4*)(PART + (size_t)i * 4);
#pragma unroll
        for (int k = 1; k < 8; ++k) d += *(const f32x4*)(PART + (size_t)k * NTOK * 128 + (size_t)i * 4);
        const f32x4 gt = *(const f32x4*)(RG + (size_t)i * 4);
        f32x4 w;
#pragma unroll
        for (int q = 0; q < 4; ++q) { const float ds = d[q] * (1.0f / 256.0f); w[q] = gt[q] * (0.5f * ds * (1.0f + erff(ds * 0.70710678118f))) * (1.0f / 32.0f); }
        *(f32x4*)(RWp + (size_t)i * 4) = w;
    }
}
#endif
__device__ void peer_passB2(const Params& P, unsigned char* lds) {
    const int tid = threadIdx.x, wid = __builtin_amdgcn_readfirstlane(tid >> 6), lane = tid & 63, j8 = lane & 7, g8 = lane >> 3;
    const int* RI = (const int*)(P.ws + O_RIDX); const float* RWp = (const float*)(P.ws + O_RW);
    float* FF = (float*)(P.ws + O_FF);
    volatile int* slot = (volatile int*)(lds + 163840 - 48);
    unsigned* qB = (unsigned*)(P.ws + O_BAR) + 4096;
    const int k0 = (int)(xb_xcc_id() & 7u);
    PeerTickets TK; peer_tickets_init(TK, (unsigned*)(P.ws + O_BAR), slot);
#pragma unroll 1
    for (;;) {
        {
            const int grp = peer_ticket(TK, qB, k0, (unsigned)(NTOK / 128), slot); const int kk = TK.kk;
            if (kk < 0) break;
            const int k = (k0 + kk) & 7;
            const unsigned char* vblk = P.ws + O_VB + (size_t)k * 16384 * 128 + j8 * 16;
            {
                u32x4* li0 = (u32x4*)lds; u32x4* lw0 = (u32x4*)(lds + 67584);
                const u32x4* gi = (const u32x4*)(RI + (size_t)grp * 128 * 128); const u32x4* gw = (const u32x4*)(RWp + (size_t)grp * 128 * 128);
                for (int i = tid; i < 128 * 32; i += 512) { li0[(i >> 5) * 33 + (i & 31)] = gi[i]; lw0[(i >> 5) * 33 + (i & 31)] = gw[i]; }
            }
            __syncthreads();
            {
                const int t8 = lane >> 3;
                const int* lib = (const int*)lds + (wid * 8 + t8) * 132; const float* lwb = (const float*)(lds + 67584) + (wid * 8 + t8) * 132;
#define POS(P_) ((((P_) >> 7) * (64 * 132)) + ((P_) & 127))
                f32x2 acc[8];
#pragma unroll
                for (int i = 0; i < 8; ++i) acc[i] = (f32x2){0.f, 0.f};
#define PB_COMP(V, IT) do { const float* lw_ = lwb + POS(IT); _Pragma("unroll") for (int q = 0; q < 8; ++q) { const float w_ = lw_[q]; const f32x2 ww = {w_, w_}; \
                    _Pragma("unroll") for (int d = 0; d < 4; ++d) { const int wd = (int)V[q][d]; \
                        acc[d * 2] = __builtin_elementwise_fma(ww, __builtin_amdgcn_cvt_pk_f32_fp8(wd, false), acc[d * 2]); \
                        acc[d * 2 + 1] = __builtin_elementwise_fma(ww, __builtin_amdgcn_cvt_pk_f32_fp8(wd, true), acc[d * 2 + 1]); } } } while (0)
                u32x4 vA[8], vB[8]; int iA[8], iB[8];
#define PB_IDX(I, IT) do { const int* li_ = lib + POS(IT); _Pragma("unroll") for (int q = 0; q < 8; ++q) I[q] = li_[q]; } while (0)
#define PB_LOADI(V, I) do { _Pragma("unroll") for (int q = 0; q < 8; ++q) V[q] = *(const u32x4*)(vblk + (size_t)(unsigned)I[q] * 128); } while (0)
                PB_IDX(iA, 0); PB_IDX(iB, 8);
                PB_LOADI(vA, iA);
#pragma unroll 1
                for (int it = 0; it < 256; it += 16) {
                    PB_LOADI(vB, iB);
                    PB_IDX(iA, (it + 16 < 256 ? it + 16 : 240));
                    PB_COMP(vA, it);
                    PB_LOADI(vA, iA);
                    PB_IDX(iB, (it + 24 < 256 ? it + 24 : 248));
                    PB_COMP(vB, it + 8);
                    if ((it & 127) == 112) {
                        const int token = grp * 128 + (it >> 7) * 64 + wid * 8 + t8;
                        float* o = FF + (size_t)token * 1024 + k * 128 + j8 * 16;
#pragma unroll
                        for (int q = 0; q < 4; ++q) *(f32x4*)(o + q * 4) = (f32x4){acc[q * 2].x, acc[q * 2].y, acc[q * 2 + 1].x, acc[q * 2 + 1].y};
#pragma unroll
                        for (int i = 0; i < 8; ++i) acc[i] = (f32x2){0.f, 0.f};
                    }
                }
#undef PB_IDX
#undef PB_LOADI
#undef PB_COMP
#undef POS
            }
        }
    }
}
__device__ void peer_ln2(const Params& P) {
    const int tid = threadIdx.x, wid = tid >> 6, lane = tid & 63;
    float* y = P.out; const float* FF = (const float*)(P.ws + O_FF); const bf16_t* ple = (const bf16_t*)(P.ws + O_PP);
    const int rstride = gridDim.x * 8;
    for (int row0 = blockIdx.x * 8 + wid; row0 < NTOK; row0 += 2 * rstride) {
        const int row1 = row0 + rstride; const bool has1 = row1 < NTOK; const int r1 = has1 ? row1 : row0;
        f32x4 v[4], w[4]; float s = 0.f, s1 = 0.f;
#pragma unroll
        for (int i = 0; i < 4; ++i) {
            const size_t c0 = (size_t)row0 * 1024 + i * 256 + lane * 4, c1 = (size_t)r1 * 1024 + i * 256 + lane * 4;
            const u32x2 p0 = *(const u32x2*)(ple + c0), p1 = *(const u32x2*)(ple + c1);
            v[i] = *(const f32x4*)(y + c0) * DN_ALPHA + *(const f32x4*)(FF + c0) + (f32x4){bflo(p0.x), bfhi(p0.x), bflo(p0.y), bfhi(p0.y)};
            w[i] = *(const f32x4*)(y + c1) * DN_ALPHA + *(const f32x4*)(FF + c1) + (f32x4){bflo(p1.x), bfhi(p1.x), bflo(p1.y), bfhi(p1.y)};
        }
#pragma unroll
        for (int i = 0; i < 4; ++i) { s += (v[i][0] + v[i][1]) + (v[i][2] + v[i][3]); s1 += (w[i][0] + w[i][1]) + (w[i][2] + w[i][3]); }
        s += __shfl_xor(s, 32); s1 += __shfl_xor(s1, 32); s += __shfl_xor(s, 16); s1 += __shfl_xor(s1, 16);
        s += dpp_xor8(s); s1 += dpp_xor8(s1); s += dpp_xor4(s); s1 += dpp_xor4(s1); s += dpp_xor2(s); s1 += dpp_xor2(s1); s += dpp_xor1(s); s1 += dpp_xor1(s1);
        const float mu = s * (1.0f / 1024.0f), mu1 = s1 * (1.0f / 1024.0f);
        float q = 0.f, q1 = 0.f;
#pragma unroll
        for (int i = 0; i < 4; ++i) { v[i] = v[i] - mu; w[i] = w[i] - mu1; q += (v[i][0] * v[i][0] + v[i][1] * v[i][1]) + (v[i][2] * v[i][2] + v[i][3] * v[i][3]); q1 += (w[i][0] * w[i][0] + w[i][1] * w[i][1]) + (w[i][2] * w[i][2] + w[i][3] * w[i][3]); }
        q += __shfl_xor(q, 32); q1 += __shfl_xor(q1, 32); q += __shfl_xor(q, 16); q1 += __shfl_xor(q1, 16);
        q += dpp_xor8(q); q1 += dpp_xor8(q1); q += dpp_xor4(q); q1 += dpp_xor4(q1); q += dpp_xor2(q); q1 += dpp_xor2(q1); q += dpp_xor1(q); q1 += dpp_xor1(q1);
        const float rstd = rsqrtf(q * (1.0f / 1024.0f) + 1e-5f), rstd1 = rsqrtf(q1 * (1.0f / 1024.0f) + 1e-5f);
#pragma unroll
        for (int i = 0; i < 4; ++i) {
            const int col = i * 256 + lane * 4;
            const f32x4 gg = *(const f32x4*)(P.ln2_g + col), bb = *(const f32x4*)(P.ln2_b + col);
            *(f32x4*)(y + (size_t)row0 * 1024 + col) = v[i] * rstd * gg + bb;
            if (has1) *(f32x4*)(y + (size_t)row1 * 1024 + col) = w[i] * rstd1 * gg + bb;
        }
    }
}
#endif

__global__ void __launch_bounds__(512, 2) mega(Params P) {
    extern __shared__ __attribute__((aligned(16))) unsigned char shm[];
    cg::grid_group grid = cg::this_grid();
    PG8_LAS unsigned char* ldsg = (PG8_LAS unsigned char*)shm;
#ifdef ONLY
#define PH(i) ((i) == ONLY)
#else
#define PH(i) (P.ph_lo <= (i) && (i) < P.ph_hi)
#endif
#ifdef USE_XCD_BARRIER
#define SYNC() do { if (P.coop == 1) xcd_barrier(xbar); else if (P.coop == 2) grid.sync(); } while (0)
#else
    unsigned bar_epoch = 0u;
#define SYNC() do { if (P.coop == 1) counter_barrier((unsigned*)(P.ws + O_BAR) + 64, bar_epoch); else if (P.coop == 2) grid.sync(); } while (0)
#endif
    volatile LAS unsigned* xst = (volatile LAS unsigned*)(ldsg + (163840 - 32));
    if (threadIdx.x == 0) { xst[0] = 0u; xst[1] = 0u; }
    __syncthreads();
#ifndef HOST_MEMSET
    if (P.coop) {
        if (blockIdx.x == 0) for (int i = threadIdx.x; i < XCD_BAR_WORDS; i += 512) ((unsigned*)(P.ws + O_BAR))[i] = 0u;
        grid.sync();
    }
#else
    if (P.coop == 2) grid.sync();
#endif
    XcdBarrier xbar = xcd_barrier_post((unsigned*)(P.ws + O_BAR), xst);
    if (threadIdx.x == 0) ((volatile LAS int*)(ldsg + (163840 - 48)))[2] = (int)__hip_atomic_fetch_add((unsigned*)(P.ws + O_BAR) + 7168 + 64 * (xbar.x & 15u), 1u, __ATOMIC_RELAXED, __HIP_MEMORY_SCOPE_AGENT);
#ifdef PROBE_T
    unsigned long long TS[14];
#define STAMP(k) TS[k] = __builtin_amdgcn_s_memrealtime()
#else
#define STAMP(k)
#endif
    STAMP(0);
    if (PH(0)) { phase_prep(P, shm); SYNC(); }
    STAMP(1);
    if (PH(1)) {
        pg8::Gemm g{(const bf16_t*)(P.ws + O_XB), (const bf16_t*)(P.ws + O_WINT), NTOK, 7168, 1024};
        pg8::StaticOrder S; S.init(NTOK, 7168, (int)gridDim.x, (int)blockIdx.x);
        EpiZ E{P.ws};
        pg8::gemm_phase<EpiZ, pg8::StaticOrder, false>(ldsg, g, S, E, nullptr);
        SYNC();
    }
    STAMP(2);
    if (PH(2)) { phase_lru(P, shm); SYNC(); }
    STAMP(3);
    if (PH(3)) { phase_gla1(P, shm); SYNC(); }
    STAMP(4);
    if (PH(4)) { phase_gla2(P); SYNC(); }
    STAMP(5);
    if (PH(5)) { phase_combine(P); SYNC(); }
    STAMP(6);
    if (PH(6)) {
        {
            pg8::Gemm g{(const bf16_t*)(P.ws + O_XB), (const bf16_t*)(P.ws + O_WOUTT), NTOK, 1024, 1024};
            pg8::StaticOrder S; S.init(NTOK, 1024, (int)gridDim.x, (int)blockIdx.x);
            EpiY1 E{P.x, P.out};
            pg8::gemm_phase<EpiY1, pg8::StaticOrder, false>(ldsg, g, S, E, nullptr);
        }
        {
            pg8::Gemm g{(const bf16_t*)(P.ws + O_PB), (const bf16_t*)(P.ws + O_WPPT), NTOK, 1024, 256};
            pg8::StaticOrder S; S.init(NTOK, 1024, (int)gridDim.x, (int)blockIdx.x);
            EpiPP E{(bf16_t*)(P.ws + O_PP)};
            pg8::gemm_phase<EpiPP, pg8::StaticOrder, false>(ldsg, g, S, E, nullptr);
        }
        SYNC();
    }
    STAMP(7);
    if (PH(7)) { phase_ln1(P); SYNC(); }
    STAMP(8);
    if (PH(8)) {
        pg8::Gemm g{(const bf16_t*)(P.ws + O_X1B), (const bf16_t*)(P.ws + O_WQGT), NTOK, 2048, 1024};
        pg8::StaticOrder S; S.init(NTOK, 2048, (int)gridDim.x, (int)blockIdx.x);
        EpiQG E{(float*)(P.ws + O_QP), (bf16_t*)(P.ws + O_PP)};
        pg8::gemm_phase<EpiQG, pg8::StaticOrder, false>(ldsg, g, S, E, nullptr);
        SYNC();
    }
    STAMP(9);
#ifdef EXTRA_SYNCS
    for (int i = 0; i < EXTRA_SYNCS; ++i) SYNC();
#endif
    if (PH(9)) { phase_peer(P, shm, grid); }
#ifdef PEER2
#ifdef PEER3
    if (PH(9)) { SYNC(); STAMP(10); peer_passA3(P, shm); SYNC(); peer_reduce3(P); SYNC(); STAMP(11); peer_passB2(P, shm); SYNC(); STAMP(13); peer_ln2(P); }
#else
    if (PH(9)) { SYNC(); STAMP(11); peer_passB2(P, shm); SYNC(); STAMP(13); peer_ln2(P); }
#endif
#endif
#ifdef PROBE_T
    {
        __syncthreads();
        const unsigned long long* tsl = (const unsigned long long*)(shm + 163840 - 64);
#ifndef PEER2
        TS[10] = TS[9] + tsl[0]; TS[11] = TS[10] + tsl[1];
#endif
        STAMP(12);
        const unsigned long long dtS = TS[PROBE_SB] - TS[PROBE_SA], dtF = TS[PROBE_FB] - TS[PROBE_FA];
        while (__builtin_amdgcn_s_memrealtime() - TS[12] < dtS) __builtin_amdgcn_s_sleep(8);
        if (blockIdx.x == 0 && threadIdx.x < 64) {
            const float frac = (float)(double)dtF / (float)(double)(TS[12] - TS[0]);
            P.out[threadIdx.x] += 0.2f + 0.2f * frac;
        }
    }
#endif
#undef PH
#undef SYNC
#undef STAMP
}

#ifdef DBG_SCAN

__global__ void dbg_check(const void* p, size_t n, int is_bf16, int* flags, int code) {
    int bad = 0;
    if (is_bf16) { const unsigned short* q = (const unsigned short*)p; for (size_t i = (size_t)blockIdx.x * blockDim.x + threadIdx.x; i < n; i += (size_t)gridDim.x * blockDim.x) if ((q[i] & 0x7f80) == 0x7f80) bad = 1; }
    else { const unsigned* q = (const unsigned*)p; for (size_t i = (size_t)blockIdx.x * blockDim.x + threadIdx.x; i < n; i += (size_t)gridDim.x * blockDim.x) if ((q[i] & 0x7f800000u) == 0x7f800000u) bad = 1; }
    if (bad) flags[code] = 1;
}
__global__ void dbg_report(float* out, size_t n, const int* flags) {
    int code = 0; for (int c = 40; c < 64; ++c) if (flags[c]) { code = c; break; }
    if (!code) for (int c = 1; c < 40; ++c) if (flags[c]) { code = c; break; }
    for (size_t i = (size_t)blockIdx.x * blockDim.x + threadIdx.x; i < n; i += (size_t)gridDim.x * blockDim.x) out[i] = (i == 0) ? 1000.f * code : 0.f;
}
static void dbg_after_phase(int ph, const Params& P, hipStream_t stream) {
    int* flags = (int*)(P.ws + 240 * MBY);
    auto chk = [&](size_t off, size_t nelem, int bf, int code) { hipLaunchKernelGGL(dbg_check, dim3(1024), dim3(256), 0, stream, (const void*)(P.ws + off), nelem, bf, flags, code); };
    auto chko = [&](int code) { hipLaunchKernelGGL(dbg_check, dim3(1024), dim3(256), 0, stream, (const void*)P.out, (size_t)NTOK * 1024, 0, flags, code); };
    const size_t M1 = (size_t)NTOK * 1024, MH = (size_t)NTOK * 512;
    switch (ph) {
    case 0: chk(O_XB, M1, 1, 1); chk(O_FLOW, (size_t)NTOK * 16, 0, 2); chk(O_PB, (size_t)NTOK * 256, 1, 3); chk(O_WINT, (size_t)7168 * 1024, 1, 4); chk(O_WOUTT, (size_t)1024 * 1024, 1, 5); chk(O_WQGT, (size_t)2048 * 1024, 1, 6); chk(O_WPPT, (size_t)1024 * 256, 1, 7); break;
    case 1: chk(O_ZX, M1, 1, 8); chk(O_GY, M1, 1, 9); chk(O_ZQ, MH, 1, 10); chk(O_ZK, MH, 1, 11); chk(O_ZV, M1, 1, 12); chk(O_GR, M1, 1, 13); break;
    case 2: chk(O_XB, M1, 1, 14); break;
    case 3: chk(O_ZQ, MH, 1, 15); chk(O_UT, (size_t)1024 * 256 * 128, 1, 16); chko(17); chk(O_DLAST, (size_t)1024 * 128, 0, 18); break;
    case 4: chko(19); chk(O_SSQ, (size_t)NTOK * 64, 0, 20); break;
    case 5: chk(O_XB, M1, 1, 21); break;
    case 6: chko(22); chk(O_PP, M1, 1, 23); break;
    case 7: chko(24); chk(O_X1B, M1, 1, 25); chk(O_UB, 2 * M1, 1, 26); break;
    case 8: chk(O_QP, M1, 0, 27); chk(O_PP, M1, 1, 28); break;
    case 9: chko(29); break;
    }
}
#endif
#ifndef MULTI_LAUNCH
#define MULTI_LAUNCH 0
#endif
extern "C" void kernel_launch(void* const* d_in, const int* in_sizes, int n_in, void* d_out, int out_size, void* d_ws, size_t ws_size, hipStream_t stream) {
    static int grid = 0;
    if (grid == 0) {
        int dev = 0, cus = 0, per_cu = 0;
        hipGetDevice(&dev); hipDeviceGetAttribute(&cus, hipDeviceAttributeMultiprocessorCount, dev);
        if (hipFuncSetAttribute((const void*)mega, hipFuncAttributeMaxDynamicSharedMemorySize, LDS_BYTES) != hipSuccess) { fprintf(stderr, "hipFuncSetAttribute failed\n"); }
        hipOccupancyMaxActiveBlocksPerMultiprocessor(&per_cu, (const void*)mega, 512, LDS_BYTES);
        if (per_cu < 1) { fprintf(stderr, "occupancy query says %d\n", per_cu); per_cu = 1; }
        (void)hipGetLastError();
        grid = cus * 1;
        if (ws_size < 236 * MBY) fprintf(stderr, "workspace too small: %zu\n", ws_size);
    }
    Params P{};
    P.x = (const float*)d_in[0]; P.p = (const float*)d_in[1]; P.w_in = (const float*)d_in[2]; P.conv_w = (const float*)d_in[3]; P.conv_b = (const float*)d_in[4];
    P.lru_wr = (const float*)d_in[5]; P.lru_br = (const float*)d_in[6]; P.lru_wi = (const float*)d_in[7]; P.lru_bi = (const float*)d_in[8]; P.lru_lambda = (const float*)d_in[9];
    P.gla_wf2 = (const float*)d_in[10]; P.gla_bf = (const float*)d_in[11]; P.gla_norm_g = (const float*)d_in[12]; P.w_out = (const float*)d_in[13]; P.ln1_g = (const float*)d_in[14];
    P.ln1_b = (const float*)d_in[15]; P.peer_wq = (const float*)d_in[16]; P.peer_subkeys = (const float*)d_in[17]; P.peer_u = (const float*)d_in[18]; P.peer_v = (const float*)d_in[19];
    P.ple_gate_w = (const float*)d_in[20]; P.ple_proj_w = (const float*)d_in[21]; P.ln2_g = (const float*)d_in[22]; P.ln2_b = (const float*)d_in[23];
    P.out = (float*)d_out; P.ws = (unsigned char*)d_ws; P.pad_ = 0;
#if MULTI_LAUNCH
    for (int ph = 0; ph < 10; ++ph) {
        P.ph_lo = ph; P.ph_hi = ph + 1; P.coop = 0;
        hipLaunchKernelGGL(mega, dim3(grid), dim3(512), LDS_BYTES, stream, P);
#ifdef DBG_SCAN
        if (ph == 0) (void)hipMemsetAsync(P.ws + 240 * MBY, 0, 256, stream);
        dbg_after_phase(ph, P, stream);
#endif
    }
#ifdef DBG_SCAN
    hipLaunchKernelGGL(dbg_report, dim3(1024), dim3(256), 0, stream, P.out, (size_t)NTOK * 1024, (const int*)(P.ws + 240 * MBY));
#endif
#else
    P.ph_lo = 0; P.ph_hi = 10; P.coop = 1;
#ifdef HOST_MEMSET
    (void)hipMemsetD32Async((hipDeviceptr_t)((unsigned char*)d_ws + O_BAR), 0, 8192, stream);
#endif
    void* args[] = {&P};
    hipError_t e = hipLaunchCooperativeKernel((const void*)mega, dim3(grid), dim3(512), args, LDS_BYTES, stream);
    if (e != hipSuccess) fprintf(stderr, "cooperative launch failed: %s (grid %d)\n", hipGetErrorString(e), grid);
#endif
}
```

```cpp
#define USE_XCD_BARRIER 1
#define HOST_MEMSET 1
#define PEER2 1
#define PEER3 1
#include <hip/hip_runtime.h>
#include <hip/hip_cooperative_groups.h>
#include <cstdio>
namespace cg = cooperative_groups;
namespace pg8 {
#define PG8_LAS __attribute__((address_space(3)))
typedef unsigned short bf16_t;
typedef short bf16x8 __attribute__((ext_vector_type(8)));
typedef float f32x4 __attribute__((ext_vector_type(4)));
typedef unsigned u32x4 __attribute__((ext_vector_type(4)));
constexpr int BM = 256, BK = 64, HALF = 128, HTB = HALF * BK * 2  , STAGE_BYTES = 8 * HTB, NXCD = 8, WGM = 8;

__host__ __device__ __forceinline__ int lds_byte(int r, int c) { const int st = (r >> 4) * 2 + (c >> 5), rr = r & 15, cc = c & 31, ob = rr * 64 + cc * 2; return st * 1024 + (ob ^ (((ob >> 9) & 1) << 5)); }
__host__ __device__ __forceinline__ void stage_rc(int b, int& R, int& C) { const int st = b / 1024, sb = b % 1024, swz = sb ^ (((sb >> 9) & 1) << 5); R = (st >> 1) * 16 + swz / 64; C = (st & 1) * 32 + (swz % 64) / 2; }
__host__ __device__ __forceinline__ int perm32(int rho) { const int n = rho >> 4, i = rho & 15; return 8 * (i >> 2) + 4 * n + (i & 3); }

struct Unit { int pm, pn; };
struct Gemm { const bf16_t* A; const bf16_t* Bt; int M, N, K; };

struct StaticOrder {
    int nM, nN, nwg, G, c;
    __host__ __device__ void init(int M, int N, int G_, int c_) { nM = M / BM; nN = N / BM; nwg = nM * nN; G = G_; c = c_; }
    __host__ __device__ bool next(int i, Unit& u) const {
        const long L = (long)i * G + c; if (L >= nwg) return false;
        int wgid = (int)L; { const int q = nwg / NXCD, r = nwg % NXCD, xcd = wgid % NXCD, off = wgid / NXCD; wgid = (xcd < r ? xcd * (q + 1) : r * (q + 1) + (xcd - r) * q) + off; }
        const int nig = WGM * nN, gid = wgid / nig, fm = gid * WGM, gsz = (nM - fm) < WGM ? (nM - fm) : WGM;
        u.pm = fm + ((wgid % nig) % gsz); u.pn = (wgid % nig) / gsz; return true;
    }
    __device__ __forceinline__ void a_ready(const Unit&) const {}
    __device__ __forceinline__ void done(const Unit&) const {}
};
struct CountedOrder : StaticOrder {
    const unsigned* ready; unsigned need; unsigned* tmo;
    __device__ __forceinline__ void a_ready(const Unit& u) const {
        if (threadIdx.x < 64) {
            const unsigned long long t0 = __builtin_amdgcn_s_memrealtime(); unsigned polls = 0;
            while ((unsigned)__builtin_amdgcn_readfirstlane(__hip_atomic_load(ready + 64 * u.pm, __ATOMIC_RELAXED, __HIP_MEMORY_SCOPE_AGENT)) < need) {
                if ((++polls & 255u) == 0u && __builtin_amdgcn_readfirstlane(__hip_atomic_load(tmo, __ATOMIC_RELAXED, __HIP_MEMORY_SCOPE_AGENT)) != 0u) break;
                if (__builtin_amdgcn_s_memrealtime() - t0 > 2000000ull) {
                    if (threadIdx.x == 0) { unsigned expect = 0u; __hip_atomic_compare_exchange_strong(tmo + 1, &expect, 0x600u | (unsigned)(u.pm & 0xff), __ATOMIC_RELAXED, __ATOMIC_RELAXED, __HIP_MEMORY_SCOPE_AGENT); __hip_atomic_store(tmo, 1u, __ATOMIC_RELAXED, __HIP_MEMORY_SCOPE_AGENT); }
                    break; }
                __builtin_amdgcn_s_sleep(2); }
            __builtin_amdgcn_fence(__ATOMIC_ACQUIRE, "agent");
            asm volatile("s_waitcnt vmcnt(0)" ::: "memory");
        }
#if !defined(BROKEN_HOOK_NO_BARRIER)
        asm volatile("" ::: "memory"); __builtin_amdgcn_s_barrier(); asm volatile("" ::: "memory");
#endif
    }
};

__device__ __forceinline__ unsigned cvt_pk_bf16(float lo, float hi) { unsigned r; asm volatile("v_cvt_pk_bf16_f32 %0, %1, %2" : "=v"(r) : "v"(lo), "v"(hi)); return r; }
typedef float f32x2 __attribute__((ext_vector_type(2)));
__device__ __forceinline__ f32x2 gelu_pk(f32x2 v) {
    const f32x2 av = __builtin_elementwise_abs(v), d = av * 0.2316418882f + 1.0f;
    f32x2 t; t.x = __builtin_amdgcn_rcpf(d.x); t.y = __builtin_amdgcn_rcpf(d.y);
    f32x2 q = t * 0.5307027145f + (-0.7265760135f); q = q * t + 0.7107068705f; q = q * t + (-0.142248368f); q = q * t + 0.127414796f; q = q * t;
    const f32x2 s = (v * v) * (-0.72134752044f);
    f32x2 e; e.x = __builtin_amdgcn_exp2f(s.x); e.y = __builtin_amdgcn_exp2f(s.y);
    const f32x2 m = v * (q * e), r = v - m;
    f32x2 o; o.x = v.x < 0.f ? m.x : r.x; o.y = v.y < 0.f ? m.y : r.y; return o;
}
template <class Epi, class Sched, bool STAMP = false>
__device__ __forceinline__ void gemm_phase(PG8_LAS unsigned char* lds, const Gemm g, const Sched& S, const Epi& E, unsigned long long* stamps) {
    const int tid = threadIdx.x, wid = __builtin_amdgcn_readfirstlane(tid >> 6), lane = tid & 63, wr = wid >> 2, wc = wid & 3, fr = lane & 15, fq = lane >> 4;
    const int K = g.K, nt = K / BK;
    int ts_lo = 0, ts_hi = 0, nts = 0; const unsigned long long rt_entry = STAMP ? (unsigned long long)wall_clock64() : 0ull;
#define PG8_STAMP() do { if (STAMP && wid == 0 && nts < 64) { const unsigned long long _c = (unsigned long long)clock64(); \
        ts_lo = (lane == nts) ? (int)(unsigned)_c : ts_lo; ts_hi = (lane == nts) ? (int)(unsigned)(_c >> 32) : ts_hi; ++nts; } } while (0)
    PG8_STAMP();
    unsigned voffA[2], voffB[2];
#pragma unroll
    for (int i = 0; i < 2; ++i) { int R, C; stage_rc(tid * 16 + i * 8192, R, C); const int Rb = Epi::PERM ? ((R & ~31) + perm32(R & 31)) : R;
        voffA[i] = (unsigned)(R * K + C) * 2u; voffB[i] = (unsigned)(Rb * K + C) * 2u; }
    const size_t kstep = (size_t)(BK * 2);
    const size_t hstep = (size_t)HALF * K * 2;
    const size_t tstep = 2 * hstep;
    const unsigned ldsw = (unsigned)wid * 1024u;
    const int aoff = lds_byte(wr * 64 + fr, fq * 8), boff = lds_byte(wc * 32 + fr, fq * 8);
#define PG8_SA(b, h) (((b) * 2 + (h)) * HTB)
#define PG8_SB(b, h) ((4 + (b) * 2 + (h)) * HTB)
#define PG8_STAGE(bufoff, gbase, voff) do { _Pragma("unroll") for (int _i = 0; _i < 2; ++_i) \
        __builtin_amdgcn_global_load_lds((const unsigned*)((const char*)(gbase) + (voff)[_i]), (PG8_LAS unsigned*)(lds + (bufoff) + ldsw + _i * 8192), 16, 0, 0); } while (0)
#define PG8_LDA(dst, b, h) do { _Pragma("unroll") for (int m = 0; m < 4; ++m) _Pragma("unroll") for (int k = 0; k < 2; ++k) dst[m][k] = *(const PG8_LAS bf16x8*)(lds + PG8_SA(b, h) + aoff + m * 2048 + k * 1024); } while (0)
#define PG8_LDB(dst, b, h) do { _Pragma("unroll") for (int n = 0; n < 2; ++n) _Pragma("unroll") for (int k = 0; k < 2; ++k) dst[n][k] = *(const PG8_LAS bf16x8*)(lds + PG8_SB(b, h) + boff + n * 2048 + k * 1024); } while (0)
#define PG8_MMA(ai, bj, At, Bt) do { __builtin_amdgcn_s_setprio(1); _Pragma("unroll") for (int m = 0; m < 4; ++m) _Pragma("unroll") for (int n = 0; n < 2; ++n) _Pragma("unroll") for (int k = 0; k < 2; ++k) \
        acc[ai][bj][m][n] = __builtin_amdgcn_mfma_f32_16x16x32_bf16(Bt[n][k], At[m][k], acc[ai][bj][m][n], 0, 0, 0); __builtin_amdgcn_s_setprio(0); } while (0)
#define PG8_WAIT_V(n) asm volatile("s_waitcnt vmcnt(" #n ")" ::: "memory")
#define PG8_WAIT_L(n) asm volatile("s_waitcnt lgkmcnt(" #n ")" ::: "memory")
#define PG8_BAR __builtin_amdgcn_s_barrier()
#define PG8_SCHED __builtin_amdgcn_sched_barrier(0)
    Unit cur, nxt; int ui = 0;
    if (!S.next(0, cur)) return;
    f32x4 acc[2][2][4][2];
#pragma unroll
    for (int a = 0; a < 2; ++a)
#pragma unroll
        for (int b = 0; b < 2; ++b)
#pragma unroll
            for (int m = 0; m < 4; ++m)
#pragma unroll
                for (int n = 0; n < 2; ++n) acc[a][b][m][n] = (f32x4){0.f, 0.f, 0.f, 0.f};
    bf16x8 At[4][2], B0[2][2], B1[2][2];
    const char* cA = (const char*)g.A + (size_t)cur.pm * tstep; const char* cB = (const char*)g.Bt + (size_t)cur.pn * tstep;
    S.a_ready(cur);
    PG8_STAGE(PG8_SB(0, 0), cB, voffB); PG8_STAGE(PG8_SA(0, 0), cA, voffA); PG8_STAGE(PG8_SB(0, 1), cB + hstep, voffB); PG8_STAGE(PG8_SA(0, 1), cA + hstep, voffA);
    if (wr == 1) PG8_BAR;
    PG8_WAIT_V(4); PG8_BAR;
    PG8_STAGE(PG8_SB(1, 0), cB + kstep, voffB); PG8_STAGE(PG8_SA(1, 0), cA + kstep, voffA); PG8_STAGE(PG8_SB(1, 1), cB + hstep + kstep, voffB);
    PG8_WAIT_V(6); PG8_BAR;
    PG8_STAMP();
    for (;;) {
        const bool has_next = S.next(ui + 1, nxt);
        const char* nA = has_next ? (const char*)g.A + (size_t)nxt.pm * tstep : cA; const char* nB = has_next ? (const char*)g.Bt + (size_t)nxt.pn * tstep : cB;
        for (int t = 0; t < nt; t += 2) {
            const bool last = (t == nt - 2);
            const char* a1 = cA + (size_t)(t + 1) * kstep;
            const char* a2 = last ? nA : cA + (size_t)(t + 2) * kstep; const char* b2 = last ? nB : cB + (size_t)(t + 2) * kstep;
            const char* a3 = a2 + kstep; const char* b3 = b2 + kstep;
            if (last && has_next) S.a_ready(nxt);
            PG8_LDB(B0, 0, 0); PG8_SCHED; PG8_LDA(At, 0, 0); PG8_STAGE(PG8_SA(1, 1), a1 + hstep, voffA);
            PG8_WAIT_L(8); PG8_BAR; PG8_WAIT_L(0); PG8_MMA(0, 0, At, B0); PG8_BAR; PG8_SCHED;
            PG8_LDB(B1, 0, 1); PG8_STAGE(PG8_SB(0, 0), b2, voffB);
            PG8_BAR; PG8_WAIT_L(0); PG8_MMA(0, 1, At, B1); PG8_BAR;
            PG8_LDA(At, 0, 1); PG8_STAGE(PG8_SA(0, 0), a2, voffA);
            PG8_BAR; PG8_WAIT_L(0); PG8_MMA(1, 0, At, B0); PG8_BAR; PG8_SCHED;
            PG8_STAGE(PG8_SB(0, 1), b2 + hstep, voffB);
            PG8_WAIT_V(6); PG8_BAR; PG8_MMA(1, 1, At, B1); PG8_BAR;
            PG8_LDB(B0, 1, 0); PG8_SCHED; PG8_LDA(At, 1, 0); PG8_STAGE(PG8_SA(0, 1), a2 + hstep, voffA);
            PG8_WAIT_L(8); PG8_BAR; PG8_WAIT_L(0); PG8_MMA(0, 0, At, B0); PG8_BAR; PG8_SCHED;
            PG8_LDB(B1, 1, 1); PG8_STAGE(PG8_SB(1, 0), b3, voffB);
            PG8_BAR; PG8_WAIT_L(0); PG8_MMA(0, 1, At, B1); PG8_BAR;
            PG8_LDA(At, 1, 1); PG8_STAGE(PG8_SA(1, 0), a3, voffA);
            PG8_BAR; PG8_WAIT_L(0); PG8_MMA(1, 0, At, B0); PG8_BAR; PG8_SCHED;
            PG8_STAGE(PG8_SB(1, 1), b3 + hstep, voffB);
            PG8_WAIT_V(6); PG8_BAR; PG8_MMA(1, 1, At, B1); PG8_BAR;
        }
        PG8_STAMP();
        if constexpr (!Epi::AFTER_DRAIN) { E(acc, cur, wr, wc, fr, fq); S.done(cur); }
        PG8_STAMP();
        if (!has_next) break;
#pragma unroll
        for (int a = 0; a < 2; ++a)
#pragma unroll
            for (int b = 0; b < 2; ++b)
#pragma unroll
                for (int m = 0; m < 4; ++m)
#pragma unroll
                    for (int n = 0; n < 2; ++n) acc[a][b][m][n] = (f32x4){0.f, 0.f, 0.f, 0.f};
        cur = nxt; cA = nA; cB = nB; ++ui;
    }
    PG8_WAIT_V(0);
    if (wr == 0) PG8_BAR;
    PG8_BAR;
    if constexpr (Epi::AFTER_DRAIN) { E.fused(acc, cur, wr, wc, fr, fq, lds, wid, lane); S.done(cur); }
    PG8_STAMP();
    if (STAMP && wid == 0) { stamps[lane] = lane < nts ? (((unsigned long long)(unsigned)ts_hi << 32) | (unsigned)ts_lo) : 0ull;
        if (lane == 62) stamps[62] = rt_entry; if (lane == 63) stamps[63] = (unsigned long long)wall_clock64(); }
#undef PG8_STAMP
#undef PG8_SA
#undef PG8_SB
#undef PG8_STAGE
#undef PG8_LDA
#undef PG8_LDB
#undef PG8_MMA
#undef PG8_WAIT_V
#undef PG8_WAIT_L
#undef PG8_BAR
#undef PG8_SCHED
}
}

using pg8::bf16_t; using pg8::bf16x8; using pg8::f32x4; using pg8::u32x4; using pg8::f32x2; using pg8::Unit;
typedef __bf16 bf16x2_t __attribute__((ext_vector_type(2)));
__device__ __forceinline__ float dpp_xor1(float v) { return __int_as_float(__builtin_amdgcn_update_dpp(0, __float_as_int(v), 0xB1, 0xF, 0xF, true)); }
__device__ __forceinline__ float dpp_xor2(float v) { return __int_as_float(__builtin_amdgcn_update_dpp(0, __float_as_int(v), 0x4E, 0xF, 0xF, true)); }
__device__ __forceinline__ float dpp_xor4(float v) { const int m = __builtin_amdgcn_update_dpp(0, __float_as_int(v), 0x141, 0xF, 0xF, true); return __int_as_float(__builtin_amdgcn_update_dpp(0, m, 0x1B, 0xF, 0xF, true)); }
__device__ __forceinline__ float dpp_xor8(float v) { return __int_as_float(__builtin_amdgcn_update_dpp(0, __float_as_int(v), 0x128, 0xF, 0xF, true)); }
typedef unsigned u32x2 __attribute__((ext_vector_type(2)));

constexpr int NTOK = 16384, DM = 1024, SEQL = 2048;
constexpr int INW = 7184;
constexpr size_t MBY = (size_t)1 << 20;
constexpr size_t O_ZX = 0, O_GY = 32 * MBY, O_ZQ = 64 * MBY, O_ZK = 80 * MBY, O_ZV = 96 * MBY, O_GR = 128 * MBY, O_XB = 160 * MBY,
                 O_WINT = 192 * MBY, O_WOUTT = 228 * MBY, O_WQGT = 230 * MBY, O_WPPT = 234 * MBY, O_PB = 235 * MBY, O_FLOW = 243 * MBY,
                 O_DLAST = 244 * MBY, O_SSQ = 245 * MBY;
constexpr size_t O_UT = 0, O_UB = 192 * MBY  , O_VB = 208 * MBY, O_X1B = 64 * MBY, O_PP = 96 * MBY, O_QP = 128 * MBY;
constexpr int LDS_BYTES = 160 * 1024;
constexpr size_t O_RIDX = 0, O_RW = 8 * MBY, O_RG = 16 * MBY  , O_FF = 128 * MBY, O_PART = 128 * MBY  ;
constexpr float DN_ALPHA = 1.189207115002721f;

struct Params {
    const float* x; const float* p; const float* w_in; const float* conv_w; const float* conv_b; const float* lru_wr; const float* lru_br;
    const float* lru_wi; const float* lru_bi; const float* lru_lambda; const float* gla_wf2; const float* gla_bf; const float* gla_norm_g;
    const float* w_out; const float* ln1_g; const float* ln1_b; const float* peer_wq; const float* peer_subkeys; const float* peer_u;
    const float* peer_v; const float* ple_gate_w; const float* ple_proj_w; const float* ln2_g; const float* ln2_b;
    float* out; unsigned char* ws; int ph_lo, ph_hi, coop, pad_;
};

__device__ __forceinline__ bf16_t f2bf(float f) { unsigned u = __float_as_uint(f); u += 0x7FFFu + ((u >> 16) & 1u); return (bf16_t)(u >> 16); }
__device__ __forceinline__ float bf2f(bf16_t b) { return __uint_as_float(((unsigned)b) << 16); }
__device__ __forceinline__ float bflo(unsigned w) { return __uint_as_float(w << 16); }
__device__ __forceinline__ float bfhi(unsigned w) { return __uint_as_float(w & 0xffff0000u); }
__device__ __forceinline__ unsigned pk2(float lo, float hi) { typedef float f2_t __attribute__((ext_vector_type(2))); f2_t v = {lo, hi}; return __builtin_bit_cast(unsigned, __builtin_convertvector(v, bf16x2_t)); }
__device__ __forceinline__ float sigmoidf_(float x) { return __builtin_amdgcn_rcpf(1.0f + __expf(-x)); }
__device__ __forceinline__ f32x4 mfma16(bf16x8 a, bf16x8 b, f32x4 c) { return __builtin_amdgcn_mfma_f32_16x16x32_bf16(a, b, c, 0, 0, 0); }
__device__ __forceinline__ float dot2bf(unsigned a, unsigned b, float c) { return __builtin_amdgcn_fdot2_f32_bf16(__builtin_bit_cast(bf16x2_t, a), __builtin_bit_cast(bf16x2_t, b), c, false); }
__device__ __forceinline__ float wave_sum(float v) {
#pragma unroll
    for (int o = 32; o >= 1; o >>= 1) v += __shfl_xor(v, o);
    return v;
}

struct EpiZ {
    static constexpr bool PERM = true, AFTER_DRAIN = false;
    unsigned char* ws;
    __device__ __forceinline__ void operator()(const f32x4 (&acc)[2][2][4][2], const Unit& u, int wr, int wc, int fr, int fq) const {
        const int pn = u.pn; const int row0 = u.pm * 256 + wr * 64 + fr;
        const bool pairA = (pn >= 4 && pn < 12), pairB = (pn >= 20);
        if (pairA || pairB) {
            const int j = pairA ? pn - 4 : pn - 20;
            bf16_t* base = (bf16_t*)(ws + (pairA ? O_GY : O_GR));
            const int col = j * 128 + wc * 32 + 8 * fq;
#pragma unroll
            for (int ai = 0; ai < 2; ++ai)
#pragma unroll
                for (int m = 0; m < 4; ++m) {
                    const f32x4 a0 = acc[ai][0][m][0], a1 = acc[ai][0][m][1], g0 = acc[ai][1][m][0], g1 = acc[ai][1][m][1];
                    float o[8];
                    if (pairA) {
                        f32x2 e0 = pg8::gelu_pk((f32x2){a0[0], a0[1]}), e1 = pg8::gelu_pk((f32x2){a0[2], a0[3]}), e2 = pg8::gelu_pk((f32x2){a1[0], a1[1]}), e3 = pg8::gelu_pk((f32x2){a1[2], a1[3]});
                        o[0] = e0.x; o[1] = e0.y; o[2] = e1.x; o[3] = e1.y; o[4] = e2.x; o[5] = e2.y; o[6] = e3.x; o[7] = e3.y;
                    } else {
#pragma unroll
                        for (int q = 0; q < 4; ++q) { o[q] = a0[q] * sigmoidf_(a0[q]); o[4 + q] = a1[q] * sigmoidf_(a1[q]); }
                    }
#pragma unroll
                    for (int q = 0; q < 4; ++q) { o[q] *= sigmoidf_(g0[q]); o[4 + q] *= sigmoidf_(g1[q]); }
                    u32x4 w; w.x = pk2(o[0], o[1]); w.y = pk2(o[2], o[3]); w.z = pk2(o[4], o[5]); w.w = pk2(o[6], o[7]);
                    *(u32x4*)(base + (size_t)(row0 + ai * 128 + m * 16) * 1024 + col) = w;
                }
        } else {
            bf16_t* base; int ldc, colt;
            if (pn < 4) { base = (bf16_t*)(ws + O_ZX); ldc = 1024; colt = pn * 256; }
            else if (pn < 14) { base = (bf16_t*)(ws + O_ZQ); ldc = 512; colt = (pn - 12) * 256; }
            else if (pn < 16) { base = (bf16_t*)(ws + O_ZK); ldc = 512; colt = (pn - 14) * 256; }
            else { base = (bf16_t*)(ws + O_ZV); ldc = 1024; colt = (pn - 16) * 256; }
            const int col0 = colt + wc * 32 + 8 * fq;
#pragma unroll
            for (int ai = 0; ai < 2; ++ai)
#pragma unroll
                for (int m = 0; m < 4; ++m) {
                    bf16_t* rowp = base + (size_t)(row0 + ai * 128 + m * 16) * ldc + col0;
#pragma unroll
                    for (int bj = 0; bj < 2; ++bj) {
                        const f32x4 v0 = acc[ai][bj][m][0], v1 = acc[ai][bj][m][1];
                        u32x4 w; w.x = pk2(v0[0], v0[1]); w.y = pk2(v0[2], v0[3]); w.z = pk2(v1[0], v1[1]); w.w = pk2(v1[2], v1[3]);
                        *(u32x4*)(rowp + bj * 128) = w;
                    }
                }
        }
    }
};
struct EpiPP {
    static constexpr bool PERM = true, AFTER_DRAIN = false;
    bf16_t* O;
    __device__ __forceinline__ void operator()(const f32x4 (&acc)[2][2][4][2], const Unit& u, int wr, int wc, int fr, int fq) const {
        const int row0 = u.pm * 256 + wr * 64 + fr, col0 = u.pn * 256 + wc * 32 + 8 * fq;
#pragma unroll
        for (int ai = 0; ai < 2; ++ai)
#pragma unroll
            for (int m = 0; m < 4; ++m) {
                bf16_t* rowp = O + (size_t)(row0 + ai * 128 + m * 16) * 1024 + col0;
#pragma unroll
                for (int bj = 0; bj < 2; ++bj) {
                    const f32x4 v0 = acc[ai][bj][m][0], v1 = acc[ai][bj][m][1];
                    u32x4 w; w.x = pk2(v0[0], v0[1]); w.y = pk2(v0[2], v0[3]); w.z = pk2(v1[0], v1[1]); w.w = pk2(v1[2], v1[3]);
                    *(u32x4*)(rowp + bj * 128) = w;
                }
            }
    }
};
struct EpiY1 {
    static constexpr bool PERM = false, AFTER_DRAIN = false;
    const float* X; float* Y;
    __device__ __forceinline__ void operator()(const f32x4 (&acc)[2][2][4][2], const Unit& u, int wr, int wc, int fr, int fq) const {
        const int row0 = u.pm * 256 + wr * 64 + fr, col0 = u.pn * 256 + wc * 32 + 4 * fq;
#pragma unroll
        for (int ai = 0; ai < 2; ++ai)
#pragma unroll
            for (int m = 0; m < 4; ++m) {
                const size_t ro = (size_t)(row0 + ai * 128 + m * 16) * 1024 + col0;
#pragma unroll
                for (int bj = 0; bj < 2; ++bj)
#pragma unroll
                    for (int n = 0; n < 2; ++n) {
                        const f32x4 xv = *(const f32x4*)(X + ro + bj * 128 + n * 16);
                        *(f32x4*)(Y + ro + bj * 128 + n * 16) = xv * DN_ALPHA + acc[ai][bj][m][n];
                    }
            }
    }
};
struct EpiQG {
    static constexpr bool PERM = false, AFTER_DRAIN = false;
    float* QP; bf16_t* PP;
    __device__ __forceinline__ void operator()(const f32x4 (&acc)[2][2][4][2], const Unit& u, int wr, int wc, int fr, int fq) const {
        const int row0 = u.pm * 256 + wr * 64 + fr; const int pn = u.pn;
        const int col0 = (pn & 3) * 256 + wc * 32 + 4 * fq;
#pragma unroll
        for (int ai = 0; ai < 2; ++ai)
#pragma unroll
            for (int m = 0; m < 4; ++m) {
                const size_t ro = (size_t)(row0 + ai * 128 + m * 16) * 1024 + col0;
#pragma unroll
                for (int bj = 0; bj < 2; ++bj)
#pragma unroll
                    for (int n = 0; n < 2; ++n) {
                        const f32x4 a = acc[ai][bj][m][n];
                        if (pn < 4) { *(f32x4*)(QP + ro + bj * 128 + n * 16) = a; }
                        else {
                            u32x2* pp = (u32x2*)(PP + ro + bj * 128 + n * 16);
                            const u32x2 w = *pp;
                            u32x2 o; o.x = pk2(sigmoidf_(a[0]) * bflo(w.x), sigmoidf_(a[1]) * bfhi(w.x)); o.y = pk2(sigmoidf_(a[2]) * bflo(w.y), sigmoidf_(a[3]) * bfhi(w.y));
                            *pp = o;
                        }
                    }
            }
    }
};

__device__ __forceinline__ int win_src_col(int n) {
    if (n < 1024) return n;
    if (n < 3072) { const int j = (n - 1024) >> 8, r = (n - 1024) & 255; return r < 128 ? 1024 + j * 128 + r : 5136 + j * 128 + (r - 128); }
    if (n < 3584) return 2048 + (n - 3072);
    if (n < 4096) return 2560 + (n - 3584);
    if (n < 5120) return 3072 + (n - 4096);
    { const int j = (n - 5120) >> 8, r = (n - 5120) & 255; return r < 128 ? 4096 + j * 128 + r : 6160 + j * 128 + (r - 128); }
}
__device__ void phase_prep(const Params& P, unsigned char* lds) {
    const int tid = threadIdx.x, wid = tid >> 6, lane = tid & 63;
    bf16_t* wf = (bf16_t*)lds;
    float* ts = (float*)(lds + 34816);
    for (int i = tid; i < 16 * 1024; i += 512) { const int r = i & 15, k = i >> 4; wf[r * 1032 + k] = f2bf(P.w_in[(size_t)k * INW + 5120 + r]); }
    __syncthreads();
    bf16_t* xb = (bf16_t*)(P.ws + O_XB); float* flow = (float*)(P.ws + O_FLOW);
    if (wid < 4) {
        for (int tile = wid * gridDim.x + blockIdx.x; tile < 1024; tile += 4 * gridDim.x) {
            const int c = lane & 15, kq = lane >> 4; const int row = tile * 16 + c;
            f32x4 acc = {0.f, 0.f, 0.f, 0.f};
            const float* xr = P.x + (size_t)row * 1024 + kq * 8;
#pragma unroll 4
            for (int ks = 0; ks < 32; ++ks) {
                const f32x4 a0 = *(const f32x4*)(xr + ks * 32), a1 = *(const f32x4*)(xr + ks * 32 + 4);
                u32x4 w; w.x = pk2(a0[0], a0[1]); w.y = pk2(a0[2], a0[3]); w.z = pk2(a1[0], a1[1]); w.w = pk2(a1[2], a1[3]);
                *(u32x4*)(xb + (size_t)row * 1024 + ks * 32 + kq * 8) = w;
                const bf16x8 bfr = *(const bf16x8*)(wf + c * 1032 + ks * 32 + kq * 8);
                acc = mfma16(__builtin_bit_cast(bf16x8, w), bfr, acc);
            }
#pragma unroll
            for (int i = 0; i < 4; ++i) flow[(size_t)(tile * 16 + kq * 4 + i) * 16 + c] = acc[i];
        }
    } else {
        bf16_t* pb = (bf16_t*)(P.ws + O_PB);
        const int nthr = 4 * 64 * gridDim.x;
        for (int i = ((wid - 4) * gridDim.x + blockIdx.x) * 64 + lane; i < NTOK * 256 / 4; i += nthr) {
            const f32x4 a = *(const f32x4*)(P.p + (size_t)i * 4);
            u32x2 w; w.x = pk2(a[0], a[1]); w.y = pk2(a[2], a[3]);
            *(u32x2*)(pb + (size_t)i * 4) = w;
        }
    }
    for (int job = blockIdx.x; job < 2624; job += gridDim.x) {
        const float* W; bf16_t* O; int ldw, Kd, tn, tk, mode;
        if (job < 1792) { W = P.w_in; O = (bf16_t*)(P.ws + O_WINT); ldw = INW; Kd = 1024; tn = job >> 4; tk = job & 15; mode = 0; }
        else if (job < 2048) { const int j = job - 1792; W = P.w_out; O = (bf16_t*)(P.ws + O_WOUTT); ldw = 1024; Kd = 1024; tn = j >> 4; tk = j & 15; mode = 1; }
        else if (job < 2560) { const int j = job - 2048; tn = j >> 4; tk = j & 15; mode = 2; ldw = 1024; Kd = 1024; O = (bf16_t*)(P.ws + O_WQGT); W = tn < 16 ? P.peer_wq : P.ple_gate_w; }
        else { const int j = job - 2560; W = P.ple_proj_w; O = (bf16_t*)(P.ws + O_WPPT); ldw = 1024; Kd = 256; tn = j >> 2; tk = j & 3; mode = 1; }
        const int n0 = tn * 64, k0 = tk * 64;
        int sc0 = n0; if (mode == 0) sc0 = win_src_col(n0); if (mode == 2) sc0 = n0 & 1023;
        {
            const int kk = tid >> 4, c4 = (tid & 15) * 4;
#pragma unroll
            for (int i = 0; i < 2; ++i) {
                const f32x4 v = *(const f32x4*)(W + (size_t)(k0 + kk + 32 * i) * ldw + sc0 + c4);
                float* d = ts + (kk + 32 * i) * 65 + c4; d[0] = v[0]; d[1] = v[1]; d[2] = v[2]; d[3] = v[3];
            }
        }
        __syncthreads();
        {
            const int n = tid >> 3, kc = (tid & 7) * 8;
            float v[8];
#pragma unroll
            for (int j = 0; j < 8; ++j) v[j] = ts[(kc + j) * 65 + n];
            u32x4 w; w.x = pk2(v[0], v[1]); w.y = pk2(v[2], v[3]); w.z = pk2(v[4], v[5]); w.w = pk2(v[6], v[7]);
            *(u32x4*)(O + (size_t)(n0 + n) * Kd + k0 + kc) = w;
        }
        __syncthreads();
    }
}

__device__ void phase_lru(const Params& P, unsigned char* lds) {
    const int tid = threadIdx.x, wid = __builtin_amdgcn_readfirstlane(tid >> 6), lane = tid & 63, c = lane & 15, kq = lane >> 4;
    bf16_t* u_s = (bf16_t*)lds;
    float* u32_s = (float*)(lds + 34816);
    float* a_s = (float*)(lds + 51712);
    float* i_s = (float*)(lds + 68608);
    float* segA = (float*)(lds + 85504);
    float* segH = (float*)(lds + 87552);
    float* carry = (float*)(lds + 89600);
    const bf16_t* zx = (const bf16_t*)(P.ws + O_ZX); const bf16_t* gy = (const bf16_t*)(P.ws + O_GY); bf16_t* yag = (bf16_t*)(P.ws + O_XB);
    for (int item = blockIdx.x; item < 256; item += gridDim.x) {
        const int grp_ = (item & 7) * 8 + (item >> 5), qd = (item >> 3) & 3, b = grp_ >> 3, blk = grp_ & 7;
        const int ch0 = blk * 128, d0 = ch0 + qd * 32;
        bf16_t* wB = (bf16_t*)(lds + 90112);
        for (int i = tid; i < 2 * 128 * 32; i += 512) {
            const int mat = i >> 12, cc = (i >> 5) & 127, dd = i & 31;
            wB[(mat * 32 + dd) * 136 + cc] = f2bf(((mat ? P.lru_wi : P.lru_wr) + (size_t)blk * 128 * 128)[cc * 128 + qd * 32 + dd]);
        }
        float br[2], bi[2], sp[2];
#pragma unroll
        for (int nt = 0; nt < 2; ++nt) {
            const int dch = d0 + nt * 16 + c;
            br[nt] = P.lru_br[dch]; bi[nt] = P.lru_bi[dch];
            const float lam = P.lru_lambda[dch];
            const float spl = (lam > 0.f ? 0.f : -lam) + log1pf(__expf(-fabsf(lam)));
            sp[nt] = -8.0f * spl;
        }
        const int cg8 = tid & 15, tgrp = tid >> 4;
        float cw[4][8], cb[8];
#pragma unroll
        for (int j = 0; j < 4; ++j)
#pragma unroll
            for (int q = 0; q < 8; ++q) cw[j][q] = P.conv_w[j * 1024 + ch0 + cg8 * 8 + q];
#pragma unroll
        for (int q = 0; q < 8; ++q) cb[q] = P.conv_b[ch0 + cg8 * 8 + q];
        if (tid < 32) carry[tid] = 0.f;
        u32x4 rows[7], rowsN[7];
#pragma unroll
        for (int r = 0; r < 7; ++r) {
            const int tt = tgrp * 4 - 3 + r;
            if (tt >= 0) rows[r] = *(const u32x4*)(zx + ((size_t)b * SEQL + tt) * 1024 + ch0 + cg8 * 8);
            else rows[r] = (u32x4){0u, 0u, 0u, 0u};
        }
#pragma unroll 1
        for (int tile = 0; tile < 16; ++tile) {
            const int t0 = tile * 128;
            {
#pragma unroll
                for (int i = 0; i < 4; ++i) {
                    float o[8];
#pragma unroll
                    for (int q = 0; q < 8; ++q) o[q] = cb[q];
#pragma unroll
                    for (int j = 0; j < 4; ++j) {
                        const u32x4 rw = rows[i + j];
                        o[0] += cw[j][0] * bflo(rw.x); o[1] += cw[j][1] * bfhi(rw.x); o[2] += cw[j][2] * bflo(rw.y); o[3] += cw[j][3] * bfhi(rw.y);
                        o[4] += cw[j][4] * bflo(rw.z); o[5] += cw[j][5] * bfhi(rw.z); o[6] += cw[j][6] * bflo(rw.w); o[7] += cw[j][7] * bfhi(rw.w);
                    }
                    const int t = tgrp * 4 + i;
                    u32x4 w; w.x = pk2(o[0], o[1]); w.y = pk2(o[2], o[3]); w.z = pk2(o[4], o[5]); w.w = pk2(o[6], o[7]);
                    *(u32x4*)(u_s + t * 136 + cg8 * 8) = w;
                    if ((cg8 >> 2) == qd) {
#pragma unroll
                        for (int q = 0; q < 8; ++q) u32_s[t * 33 + (cg8 & 3) * 8 + q] = o[q];
                    }
                }
            }
            __syncthreads();
            f32x4 cvs[4];
            {
                const size_t cbase = ((size_t)item * 16 + tile) * 2048;
#pragma unroll
                for (int k = 0; k < 4; ++k) { const size_t ci = cbase + k * 512 + tid; cvs[k] = __builtin_nontemporal_load((const f32x4*)(ci < (size_t)NTOK * 256 ? P.peer_u + ci * 4 : P.peer_v + (ci - (size_t)NTOK * 256) * 4)); }
            }
            bf16_t gyv[8];
            {
                const int tn = (tile + 1 < 16 ? tile + 1 : 15) * 128;
#pragma unroll
                for (int r = 0; r < 7; ++r) rowsN[r] = *(const u32x4*)(zx + ((size_t)b * SEQL + tn + tgrp * 4 - 3 + r) * 1024 + ch0 + cg8 * 8);
                const int cs_ = tid & 31, seg_ = tid >> 5;
#pragma unroll
                for (int jq = 0; jq < 8; ++jq) gyv[jq] = gy[((size_t)b * SEQL + t0 + seg_ * 8 + jq) * 1024 + d0 + cs_];
            }
            {
                f32x4 accR[2], accI[2];
#pragma unroll
                for (int nt = 0; nt < 2; ++nt) { accR[nt] = (f32x4){0.f, 0.f, 0.f, 0.f}; accI[nt] = (f32x4){0.f, 0.f, 0.f, 0.f}; }
#pragma unroll
                for (int ks = 0; ks < 4; ++ks) {
                    const bf16x8 af = *(const bf16x8*)(u_s + (wid * 16 + c) * 136 + ks * 32 + kq * 8);
#pragma unroll
                    for (int nt = 0; nt < 2; ++nt) {
                        accR[nt] = mfma16(af, *(const bf16x8*)(wB + (nt * 16 + c) * 136 + ks * 32 + kq * 8), accR[nt]);
                        accI[nt] = mfma16(af, *(const bf16x8*)(wB + (32 + nt * 16 + c) * 136 + ks * 32 + kq * 8), accI[nt]);
                    }
                }
#pragma unroll
                for (int nt = 0; nt < 2; ++nt)
#pragma unroll
                    for (int i = 0; i < 4; ++i) {
                        const int t = wid * 16 + kq * 4 + i, dl = nt * 16 + c;
                        const float r = sigmoidf_(accR[nt][i] + br[nt]), ig = sigmoidf_(accI[nt][i] + bi[nt]);
                        const float log_a = sp[nt] * r;
                        const float a = __expf(log_a);
                        const float mult = __builtin_amdgcn_sqrtf(fmaf(-a, a, 1.0f));
                        a_s[t * 33 + dl] = a; i_s[t * 33 + dl] = mult * ig * u32_s[t * 33 + dl];
                    }
            }
            __syncthreads();
            {
                const int cs = tid & 31, seg = tid >> 5;
                float av[8], iv[8];
#pragma unroll
                for (int j = 0; j < 8; ++j) { av[j] = a_s[(seg * 8 + j) * 33 + cs]; iv[j] = i_s[(seg * 8 + j) * 33 + cs]; }
                float A = 1.f, H = 0.f;
#pragma unroll
                for (int j = 0; j < 8; ++j) { H = av[j] * H + iv[j]; A *= av[j]; }
                segA[seg * 32 + cs] = A; segH[seg * 32 + cs] = H;
                __syncthreads();
                float h = carry[cs];
                for (int s = 0; s < seg; ++s) h = segA[s * 32 + cs] * h + segH[s * 32 + cs];
#pragma unroll
                for (int j = 0; j < 8; ++j) {
                    h = av[j] * h + iv[j];
                    const size_t gi = ((size_t)b * SEQL + t0 + seg * 8 + j) * 1024 + d0 + cs;
                    yag[gi] = f2bf(h * bf2f(gyv[j]));
                }
                __syncthreads();
                if (seg == 15) carry[cs] = h;
            }
            {
                unsigned* u8 = (unsigned*)(P.ws + O_UB);
                const size_t cbase = ((size_t)item * 16 + tile) * 2048;
#pragma unroll
                for (int k = 0; k < 4; ++k) {
                    const size_t ci = cbase + k * 512 + tid; const float sc = ci < (size_t)NTOK * 256 ? 256.0f : 32.0f;
                    int wv = 0;
                    wv = __builtin_amdgcn_cvt_pk_fp8_f32(cvs[k][0] * sc, cvs[k][1] * sc, wv, false);
                    wv = __builtin_amdgcn_cvt_pk_fp8_f32(cvs[k][2] * sc, cvs[k][3] * sc, wv, true);
#ifdef PEER2
#ifdef PEER3
                    if (ci < (size_t)NTOK * 256) { const size_t e_ = ci >> 8; const unsigned c4 = (unsigned)ci & 255u; ((unsigned*)(P.ws + O_UB))[((size_t)(c4 >> 5) * 16384 + e_) * 32 + (c4 & 31u)] = (unsigned)wv; }
#else
                    if (ci < (size_t)NTOK * 256) u8[ci] = (unsigned)wv;
#endif
                    else { const size_t cv = ci - (size_t)NTOK * 256; const size_t e_ = cv >> 8; const unsigned c4 = (unsigned)cv & 255u;
                           ((unsigned*)(P.ws + O_VB))[((size_t)(c4 >> 5) * 16384 + e_) * 32 + (c4 & 31u)] = (unsigned)wv; }
#else
                    u8[ci] = (unsigned)wv;
#endif
                }
            }
#pragma unroll
            for (int r = 0; r < 7; ++r) rows[r] = rowsN[r];
        }
        __syncthreads();
    }
}

__device__ void phase_gla1(const Params& P, unsigned char* lds) {
    const int tid = threadIdx.x, wid = __builtin_amdgcn_readfirstlane(tid >> 6), lane = tid & 63, c = lane & 15, kq = lane >> 4;
    bf16_t* Qb_s = (bf16_t*)(lds + 33024);
    bf16_t* Kb_s = (bf16_t*)(lds + 50432);
    bf16_t* Klt_s = (bf16_t*)(lds + 67840);
    bf16_t* Vt_s = (bf16_t*)(lds + 86272);
    bf16_t* A_s = (bf16_t*)(lds + 123136);
    float* fl_s = (float*)(lds + 132352);
    float* segs = (float*)(lds + 136448);
    bf16_t* zq = (bf16_t*)(P.ws + O_ZQ); const bf16_t* zk = (const bf16_t*)(P.ws + O_ZK); const bf16_t* zv = (const bf16_t*)(P.ws + O_ZV);
    const float* flow = (const float*)(P.ws + O_FLOW); bf16_t* dlastb = (bf16_t*)(P.ws + O_DLAST); bf16_t* UT = (bf16_t*)(P.ws + O_UT); float* oin = P.out;
    for (int item0 = blockIdx.x; item0 < 1024; item0 += gridDim.x) {
        const int h = (item0 >> 3) & 3, bn = (item0 & 7) * 32 + (item0 >> 5), tok0 = bn * 64, item = bn * 4 + h;
        const int d = tid & 127, tg = tid >> 7;
        for (int i = tid; i < 1024; i += 512) fl_s[i] = flow[(size_t)tok0 * 16 + i];
        float w2[16];
#pragma unroll
        for (int r = 0; r < 16; ++r) w2[r] = P.gla_wf2[r * 512 + h * 128 + d];
        const float bfd = P.gla_bf[h * 128 + d];
        bf16_t q16[16], k16[16], v32[32];
#pragma unroll
        for (int j = 0; j < 16; ++j) { const size_t gi = (size_t)(tok0 + tg * 16 + j) * 512 + h * 128 + d; q16[j] = zq[gi]; k16[j] = zk[gi]; }
        {
            const int n = tid & 255, tg2 = tid >> 8;
#pragma unroll
            for (int j = 0; j < 32; ++j) v32[j] = zv[(size_t)(tok0 + tg2 * 32 + j) * 1024 + h * 256 + n];
        }
        __syncthreads();
        float g[16]; float run = 0.f;
#pragma unroll
        for (int j = 0; j < 16; ++j) {
            const int t = tg * 16 + j; float xv = bfd;
#pragma unroll
            for (int r = 0; r < 16; ++r) xv += fl_s[t * 16 + r] * w2[r];
            const float ls = fminf(xv, 0.f) - __logf(1.0f + __expf(-fabsf(xv)));
            run += ls * 0.0625f; g[j] = run;
#ifdef DBG_SCAN
            { int* fl = (int*)(P.ws + 240 * MBY); if (!(fabsf(fl_s[t * 16 + (j & 15)]) < 1e3f)) fl[40] = 1; if (!(fabsf(xv) < 1e30f)) fl[41] = 1; if (!(fabsf(ls) < 1e30f)) fl[42] = 1; }
#endif
        }
        segs[tg * 128 + d] = run;
        __syncthreads();
        float pre = 0.f, blast = 0.f;
#pragma unroll
        for (int s = 0; s < 4; ++s) { const float v = segs[s * 128 + d]; if (s < tg) pre += v; blast += v; }
#pragma unroll
        for (int j = 0; j < 16; ++j) {
            const int t = tg * 16 + j; const float bv = pre + g[j];
            const size_t gi = (size_t)(tok0 + t) * 512 + h * 128 + d;
            const float qv = bf2f(q16[j]), kv = bf2f(k16[j]);
            const float qb = qv * __expf(bv) * 0.08838834764831845f, kb = kv * __expf(-bv), kl = kv * __expf(blast - bv);
            const bf16_t qbb = f2bf(qb);
#ifdef DBG_SCAN
            { int* fl = (int*)(P.ws + 240 * MBY); if (!(fabsf(bv) < 1e30f)) fl[43] = 1; if (!(fabsf(kl) < 1e30f)) fl[44] = 1; if (!(fabsf(kb) < 1e30f)) fl[46] = 1; }
#endif
            Qb_s[t * 136 + d] = qbb; zq[gi] = qbb; Kb_s[t * 136 + d] = f2bf(kb); Klt_s[d * 72 + t] = f2bf(kl);
        }
        if (tg == 0) dlastb[(size_t)item * 128 + d] = f2bf(__expf(blast));
        {
            const int n = tid & 255, tg2 = tid >> 8;
#pragma unroll
            for (int j = 0; j < 32; ++j) { const int t = tg2 * 32 + j; Vt_s[n * 72 + t] = v32[j]; }
        }
        __syncthreads();
        {
            const int mi = wid >> 1;
#pragma unroll
            for (int jj = 0; jj < 2; ++jj) {
                const int nj = (wid & 1) * 2 + jj;
                f32x4 acc = {0.f, 0.f, 0.f, 0.f};
                if (nj <= mi) {
#pragma unroll
                    for (int ks = 0; ks < 4; ++ks) {
                        const bf16x8 a = *(const bf16x8*)(Qb_s + (mi * 16 + c) * 136 + ks * 32 + kq * 8);
                        const bf16x8 bb = *(const bf16x8*)(Kb_s + (nj * 16 + c) * 136 + ks * 32 + kq * 8);
                        acc = mfma16(a, bb, acc);
                    }
                }
#pragma unroll
                for (int r = 0; r < 4; ++r) { const int i = mi * 16 + kq * 4 + r, jx = nj * 16 + c; A_s[i * 72 + jx] = f2bf(jx <= i ? acc[r] : 0.f); }
            }
        }
        __syncthreads();
        {
#pragma unroll
            for (int mt = 0; mt < 2; ++mt) {
                const int nt_ = wid * 2 + mt;
                bf16x8 afr[2];
#pragma unroll
                for (int ks = 0; ks < 2; ++ks) afr[ks] = *(const bf16x8*)(Vt_s + (nt_ * 16 + c) * 72 + ks * 32 + kq * 8);
#pragma unroll
                for (int it = 0; it < 4; ++it) {
                    f32x4 acc = {0.f, 0.f, 0.f, 0.f};
#pragma unroll
                    for (int ks = 0; ks < 2; ++ks) acc = mfma16(afr[ks], *(const bf16x8*)(A_s + (it * 16 + c) * 72 + ks * 32 + kq * 8), acc);
                    *(f32x4*)(oin + (size_t)(tok0 + it * 16 + c) * 1024 + h * 256 + nt_ * 16 + kq * 4) = acc;
                }
            }
            bf16x8 kfr[2];
#pragma unroll
            for (int ks = 0; ks < 2; ++ks) kfr[ks] = *(const bf16x8*)(Klt_s + (wid * 16 + c) * 72 + ks * 32 + kq * 8);
#pragma unroll 4
            for (int nt = 0; nt < 16; ++nt) {
                f32x4 acc = {0.f, 0.f, 0.f, 0.f};
#pragma unroll
                for (int ks = 0; ks < 2; ++ks) acc = mfma16(kfr[ks], *(const bf16x8*)(Vt_s + (nt * 16 + c) * 72 + ks * 32 + kq * 8), acc);
#ifdef DBG_SCAN
                { int* fl = (int*)(P.ws + 240 * MBY); if (!(fabsf(acc[0]) < 1e30f) || !(fabsf(acc[1]) < 1e30f) || !(fabsf(acc[2]) < 1e30f) || !(fabsf(acc[3]) < 1e30f)) fl[45] = 1; }
#endif
                u32x2 w; w.x = pk2(acc[0], acc[1]); w.y = pk2(acc[2], acc[3]);
                *(u32x2*)(UT + ((size_t)item * 256 + nt * 16 + c) * 128 + wid * 16 + kq * 4) = w;
            }
        }
        __syncthreads();
    }
}

__device__ void phase_gla2(const Params& P) {
    const int tid = threadIdx.x, wid = __builtin_amdgcn_readfirstlane(tid >> 6), lane = tid & 63, c = lane & 15, kq = lane >> 4;
    const bf16_t* zq = (const bf16_t*)(P.ws + O_ZQ); const bf16_t* dlastb = (const bf16_t*)(P.ws + O_DLAST); const bf16_t* UT = (const bf16_t*)(P.ws + O_UT);
    float* oin = P.out; float* ssq = (float*)(P.ws + O_SSQ);
    for (int item = blockIdx.x; item < 256; item += gridDim.x) {
        const int pair_ = (item & 7) * 4 + (item >> 6), s = (item >> 3) & 7, b = pair_ >> 2, h = pair_ & 3;
        const int mi = wid & 3, ni = wid >> 2, ncol = s * 32 + ni * 16;
        float S[4][8];
#pragma unroll
        for (int ks = 0; ks < 4; ++ks)
#pragma unroll
            for (int j = 0; j < 8; ++j) S[ks][j] = 0.f;
#define G2_LOAD(Q, U, D, OI, NC) do { const int bn_ = b * 32 + (NC), it_ = bn_ * 4 + h, tok_ = bn_ * 64 + mi * 16 + c; \
            OI = *(const f32x4*)(oin + (size_t)tok_ * 1024 + h * 256 + ncol + kq * 4); \
            _Pragma("unroll") for (int ks = 0; ks < 4; ++ks) { \
                Q[ks] = *(const bf16x8*)(zq + (size_t)tok_ * 512 + h * 128 + ks * 32 + kq * 8); \
                U[ks] = *(const u32x4*)(UT + ((size_t)it_ * 256 + ncol + c) * 128 + ks * 32 + kq * 8); \
                D[ks] = *(const u32x4*)(dlastb + (size_t)it_ * 128 + ks * 32 + kq * 8); } } while (0)
#define G2_COMP(Q, U, D, OI, NC) do { const int bn_ = b * 32 + (NC), tok_ = bn_ * 64 + mi * 16 + c; \
            f32x4 acc = OI; \
            _Pragma("unroll") for (int ks = 0; ks < 4; ++ks) { \
                u32x4 w; w.x = pk2(S[ks][0], S[ks][1]); w.y = pk2(S[ks][2], S[ks][3]); w.z = pk2(S[ks][4], S[ks][5]); w.w = pk2(S[ks][6], S[ks][7]); \
                acc = mfma16(__builtin_bit_cast(bf16x8, w), Q[ks], acc); } \
            *(f32x4*)(oin + (size_t)tok_ * 1024 + h * 256 + ncol + kq * 4) = acc; \
            float ss = acc[0] * acc[0] + acc[1] * acc[1] + acc[2] * acc[2] + acc[3] * acc[3]; \
            ss += __shfl_xor(ss, 16); ss += __shfl_xor(ss, 32); \
            if (kq == 0) ssq[((size_t)tok_ * 4 + h) * 16 + s * 2 + ni] = ss; \
            _Pragma("unroll") for (int ks = 0; ks < 4; ++ks) { const u32x4 uu = U[ks]; const u32x4 dd = D[ks]; \
                S[ks][0] = bflo(dd.x) * S[ks][0] + bflo(uu.x); S[ks][1] = bfhi(dd.x) * S[ks][1] + bfhi(uu.x); \
                S[ks][2] = bflo(dd.y) * S[ks][2] + bflo(uu.y); S[ks][3] = bfhi(dd.y) * S[ks][3] + bfhi(uu.y); \
                S[ks][4] = bflo(dd.z) * S[ks][4] + bflo(uu.z); S[ks][5] = bfhi(dd.z) * S[ks][5] + bfhi(uu.z); \
                S[ks][6] = bflo(dd.w) * S[ks][6] + bflo(uu.w); S[ks][7] = bfhi(dd.w) * S[ks][7] + bfhi(uu.w); } } while (0)
        bf16x8 QA[4], QB[4], QC[4]; u32x4 UA[4], UB[4], UC[4], DA[4], DB[4], DC[4]; f32x4 oA, oB, oC;
        G2_LOAD(QA, UA, DA, oA, 0);
        G2_LOAD(QB, UB, DB, oB, 1);
#pragma unroll 1
        for (int nc = 0; nc < 33; nc += 3) {
            G2_LOAD(QC, UC, DC, oC, (nc + 2 < 32 ? nc + 2 : 31));
            G2_COMP(QA, UA, DA, oA, nc);
            G2_LOAD(QA, UA, DA, oA, (nc + 3 < 32 ? nc + 3 : 31));
            G2_COMP(QB, UB, DB, oB, nc + 1);
            if (nc + 2 >= 32) break;
            G2_LOAD(QB, UB, DB, oB, (nc + 4 < 32 ? nc + 4 : 31));
            G2_COMP(QC, UC, DC, oC, nc + 2);
        }
#undef G2_LOAD
#undef G2_COMP
    }
}

__device__ void phase_combine(const Params& P) {
    const float* oin = P.out; const float* ssq = (const float*)(P.ws + O_SSQ); const bf16_t* gr = (const bf16_t*)(P.ws + O_GR); bf16_t* ym = (bf16_t*)(P.ws + O_XB);
    for (int idx = blockIdx.x * 512 + threadIdx.x; idx < NTOK * 128; idx += gridDim.x * 512) {
        const int row = idx >> 7, col = (idx & 127) * 8, h = col >> 8;
        const f32x4* sp = (const f32x4*)(ssq + ((size_t)row * 4 + h) * 16);
        const f32x4 s0 = sp[0], s1 = sp[1], s2 = sp[2], s3 = sp[3];
        const float tot = (s0[0] + s0[1] + s0[2] + s0[3]) + (s1[0] + s1[1] + s1[2] + s1[3]) + (s2[0] + s2[1] + s2[2] + s2[3]) + (s3[0] + s3[1] + s3[2] + s3[3]);
        const float rs = rsqrtf(tot * (1.0f / 256.0f) + 1e-6f);
        const size_t gi = (size_t)row * 1024 + col;
        const f32x4 o0 = *(const f32x4*)(oin + gi), o1 = *(const f32x4*)(oin + gi + 4);
        const f32x4 n0 = *(const f32x4*)(P.gla_norm_g + col), n1 = *(const f32x4*)(P.gla_norm_g + col + 4);
        const u32x4 g = *(const u32x4*)(gr + gi), y = *(const u32x4*)(ym + gi);
        u32x4 w;
        w.x = pk2(bflo(y.x) + bflo(g.x) * (o0[0] * rs * n0[0]), bfhi(y.x) + bfhi(g.x) * (o0[1] * rs * n0[1]));
        w.y = pk2(bflo(y.y) + bflo(g.y) * (o0[2] * rs * n0[2]), bfhi(y.y) + bfhi(g.y) * (o0[3] * rs * n0[3]));
        w.z = pk2(bflo(y.z) + bflo(g.z) * (o1[0] * rs * n1[0]), bfhi(y.z) + bfhi(g.z) * (o1[1] * rs * n1[1]));
        w.w = pk2(bflo(y.w) + bflo(g.w) * (o1[2] * rs * n1[2]), bfhi(y.w) + bfhi(g.w) * (o1[3] * rs * n1[3]));
        *(u32x4*)(ym + gi) = w;
    }
}

__device__ void phase_ln1(const Params& P) {
    const int tid = threadIdx.x, wid = tid >> 6, lane = tid & 63;
    float* y = P.out; bf16_t* x1b = (bf16_t*)(P.ws + O_X1B);
    const int rstride = gridDim.x * 8;
    for (int row0 = blockIdx.x * 8 + wid; row0 < NTOK; row0 += 2 * rstride) {
        const int row1 = row0 + rstride; const bool has1 = row1 < NTOK; const int r1 = has1 ? row1 : row0;
        f32x4 v[4], w[4]; float s = 0.f, s1 = 0.f;
#pragma unroll
        for (int i = 0; i < 4; ++i) { v[i] = *(const f32x4*)(y + (size_t)row0 * 1024 + i * 256 + lane * 4); w[i] = *(const f32x4*)(y + (size_t)r1 * 1024 + i * 256 + lane * 4); }
#pragma unroll
        for (int i = 0; i < 4; ++i) { s += (v[i][0] + v[i][1]) + (v[i][2] + v[i][3]); s1 += (w[i][0] + w[i][1]) + (w[i][2] + w[i][3]); }
        s += __shfl_xor(s, 32); s1 += __shfl_xor(s1, 32); s += __shfl_xor(s, 16); s1 += __shfl_xor(s1, 16);
        s += dpp_xor8(s); s1 += dpp_xor8(s1); s += dpp_xor4(s); s1 += dpp_xor4(s1); s += dpp_xor2(s); s1 += dpp_xor2(s1); s += dpp_xor1(s); s1 += dpp_xor1(s1);
        const float mu = s * (1.0f / 1024.0f), mu1 = s1 * (1.0f / 1024.0f);
        float q = 0.f, q1 = 0.f;
#pragma unroll
        for (int i = 0; i < 4; ++i) { v[i] = v[i] - mu; w[i] = w[i] - mu1; q += (v[i][0] * v[i][0] + v[i][1] * v[i][1]) + (v[i][2] * v[i][2] + v[i][3] * v[i][3]); q1 += (w[i][0] * w[i][0] + w[i][1] * w[i][1]) + (w[i][2] * w[i][2] + w[i][3] * w[i][3]); }
        q += __shfl_xor(q, 32); q1 += __shfl_xor(q1, 32); q += __shfl_xor(q, 16); q1 += __shfl_xor(q1, 16);
        q += dpp_xor8(q); q1 += dpp_xor8(q1); q += dpp_xor4(q); q1 += dpp_xor4(q1); q += dpp_xor2(q); q1 += dpp_xor2(q1); q += dpp_xor1(q); q1 += dpp_xor1(q1);
        const float rstd = rsqrtf(q * (1.0f / 1024.0f) + 1e-5f), rstd1 = rsqrtf(q1 * (1.0f / 1024.0f) + 1e-5f);
#pragma unroll
        for (int i = 0; i < 4; ++i) {
            const int col = i * 256 + lane * 4;
            const f32x4 gg = *(const f32x4*)(P.ln1_g + col), bb = *(const f32x4*)(P.ln1_b + col);
            const f32x4 o = v[i] * rstd * gg + bb;
            *(f32x4*)(y + (size_t)row0 * 1024 + col) = o;
            u32x2 pw; pw.x = pk2(o[0], o[1]); pw.y = pk2(o[2], o[3]);
            *(u32x2*)(x1b + (size_t)row0 * 1024 + col) = pw;
            if (has1) {
                const f32x4 o1 = w[i] * rstd1 * gg + bb;
                *(f32x4*)(y + (size_t)row1 * 1024 + col) = o1;
                u32x2 pw1; pw1.x = pk2(o1[0], o1[1]); pw1.y = pk2(o1[2], o1[3]);
                *(u32x2*)(x1b + (size_t)row1 * 1024 + col) = pw1;
            }
        }
    }
}

__device__ __forceinline__ int sortable(int bits) { return bits ^ ((bits >> 31) & 0x7fffffff); }
__device__ __forceinline__ void sort16_asc(int (&a)[16]) {
#pragma unroll
    for (int k = 2; k <= 16; k <<= 1)
#pragma unroll
        for (int j = k >> 1; j > 0; j >>= 1)
#pragma unroll
            for (int i = 0; i < 16; ++i) { const int l = i ^ j;
                if (l > i) { const int lo = min(a[i], a[l]), hi = max(a[i], a[l]); const bool up = ((i & k) == 0); a[i] = up ? lo : hi; a[l] = up ? hi : lo; } }
}
__device__ __forceinline__ void merge_top16(int (&top)[16], const int (&asc)[16]) {
#pragma unroll
    for (int i = 0; i < 16; ++i) top[i] = max(top[i], asc[i]);
#pragma unroll
    for (int j = 8; j > 0; j >>= 1)
#pragma unroll
        for (int i = 0; i < 16; ++i) { const int l = i ^ j; if (l > i) { const int lo = min(top[i], top[l]), hi = max(top[i], top[l]); top[i] = hi; top[l] = lo; } }
}
__device__ void phase_peer(const Params& P, unsigned char* lds, cg::grid_group& grid) {
    const bool align_sync = false;
    const int tid = threadIdx.x, wid = __builtin_amdgcn_readfirstlane(tid >> 6), lane = tid & 63;
    int* ridx = (int*)lds;
    float* rgt = (float*)(lds + 33024);
    const float* qp = (const float*)(P.ws + O_QP); const bf16_t* x1b = (const bf16_t*)(P.ws + O_X1B);
    const unsigned char* u8t = P.ws + O_UB; const unsigned char* v8t = P.ws + O_VB; const bf16_t* ple = (const bf16_t*)(P.ws + O_PP);
    float* xo = P.out;
    for (int tile = blockIdx.x; tile < NTOK / 64; tile += gridDim.x) {
        const int tok0 = tile * 64;
#ifndef NO_ROUTE
#ifdef PROBE_T
        unsigned long long pt0 = __builtin_amdgcn_s_memrealtime();
#endif
        {
            const int token = tok0 + lane;
            int* Ls = (int*)(lds + 66048) + wid * 32 * 64 + lane;
            typedef float f32x16 __attribute__((ext_vector_type(16)));
            const int lc = lane & 31, lh = lane >> 5;
#define SPLIT8(HI, LO, A0, A1) do { \
                const float v_[8] = {A0[0], A0[1], A0[2], A0[3], A1[0], A1[1], A1[2], A1[3]}; unsigned h_[4], l_[4]; \
                _Pragma("unroll") for (int e_ = 0; e_ < 4; ++e_) { h_[e_] = pk2(v_[2 * e_], v_[2 * e_ + 1]); l_[e_] = pk2(v_[2 * e_] - bflo(h_[e_]), v_[2 * e_ + 1] - bfhi(h_[e_])); } \
                HI = __builtin_bit_cast(bf16x8, (u32x4){h_[0], h_[1], h_[2], h_[3]}); LO = __builtin_bit_cast(bf16x8, (u32x4){l_[0], l_[1], l_[2], l_[3]}); } while (0)
#pragma unroll 1
            for (int p = 0; p < 2; ++p) {
                bf16x8 Qh[2][4], Ql[2][4];
#pragma unroll
                for (int nt = 0; nt < 2; ++nt)
#pragma unroll
                    for (int ks = 0; ks < 4; ++ks) {
                        const float* qr = qp + (size_t)(tok0 + nt * 32 + lc) * 1024 + wid * 128 + p * 64 + ks * 16 + lh * 8;
                        const f32x4 a0 = *(const f32x4*)qr, a1 = *(const f32x4*)(qr + 4);
                        SPLIT8(Qh[nt][ks], Ql[nt][ks], a0, a1);
                    }
                int topA[16], topB[16];
#pragma unroll
                for (int i = 0; i < 16; ++i) { topA[i] = (int)0x80000000; topB[i] = (int)0x80000000; }
                const float* keys = P.peer_subkeys + (size_t)((wid * 2 + p) * 128) * 64;
#pragma unroll 1
                for (int mt = 0; mt < 4; ++mt) {
                    bf16x8 Kh[4], Kl[4];
#pragma unroll
                    for (int ks = 0; ks < 4; ++ks) {
                        const float* kr = keys + (size_t)(mt * 32 + lc) * 64 + ks * 16 + lh * 8;
                        const f32x4 a0 = *(const f32x4*)kr, a1 = *(const f32x4*)(kr + 4);
                        SPLIT8(Kh[ks], Kl[ks], a0, a1);
                    }
#pragma unroll
                    for (int nt = 0; nt < 2; ++nt) {
                        f32x16 acc;
#pragma unroll
                        for (int i = 0; i < 16; ++i) acc[i] = 0.f;
#pragma unroll
                        for (int ks = 0; ks < 4; ++ks) {
                            acc = __builtin_amdgcn_mfma_f32_32x32x16_bf16(Kh[ks], Qh[nt][ks], acc, 0, 0, 0);
                            acc = __builtin_amdgcn_mfma_f32_32x32x16_bf16(Kh[ks], Ql[nt][ks], acc, 0, 0, 0);
                            acc = __builtin_amdgcn_mfma_f32_32x32x16_bf16(Kl[ks], Qh[nt][ks], acc, 0, 0, 0);
                        }
                        int nk16[16];
#pragma unroll
                        for (int i = 0; i < 16; ++i) { const int kidx = mt * 32 + 8 * (i >> 2) + 4 * lh + (i & 3); nk16[i] = sortable((__float_as_int(acc[i]) & ~127) | kidx); }
                        sort16_asc(nk16);
                        if (nt == 0) merge_top16(topA, nk16); else merge_top16(topB, nk16);
                    }
                }
                int mine[16];
#pragma unroll
                for (int i = 0; i < 16; ++i) mine[i] = lh ? topB[i] : topA[i];
                int recv[16];
#pragma unroll
                for (int i = 0; i < 16; ++i) { const int send = lh ? topA[15 - i] : topB[15 - i]; recv[i] = __shfl_xor(send, 32); }
                merge_top16(mine, recv);
#pragma unroll
                for (int i = 0; i < 16; ++i) Ls[(p * 16 + i) * 64] = mine[i];
            }
#undef SPLIT8
            int top2k[16];
#pragma unroll
            for (int i = 0; i < 16; ++i) top2k[i] = (int)0x80000000;
#pragma unroll 1
            for (int i = 0; i < 16; ++i) {
                const int b0 = sortable(Ls[i * 64]); const float va = __int_as_float(b0 & ~127);
                const int jmax = 16 / (i + 1);
#pragma unroll 1
                for (int j = 0; j < jmax; ++j) {
                    const int b1 = sortable(Ls[(16 + j) * 64]);
                    const float sm = va + __int_as_float(b1 & ~127);
                    int key = sortable((__float_as_int(sm) & ~255) | (i << 4) | j);
#pragma unroll
                    for (int m = 0; m < 16; ++m) { const int hi = max(top2k[m], key); key = min(top2k[m], key); top2k[m] = hi; }
                }
            }
            long long top2[16];
#pragma unroll
            for (int m = 0; m < 16; ++m) {
                const int bits = sortable(top2k[m]); const int ci = (bits >> 4) & 15, cj = bits & 15;
                const int e0 = sortable(Ls[ci * 64]) & 127, e1 = sortable(Ls[(16 + cj) * 64]) & 127;
                top2[m] = (long long)((((unsigned long long)(unsigned)sortable(bits & ~255)) << 32) | (unsigned long long)(unsigned)(e0 * 128 + e1));
            }
            float e[16]; float smax = __int_as_float(sortable((int)(top2[0] >> 32))); float den = 0.f;
#pragma unroll
            for (int m = 0; m < 16; ++m) { const float sv = __int_as_float(sortable((int)(top2[m] >> 32))); e[m] = __expf(sv - smax); den += e[m]; }
            const float inv = 1.0f / den;
#ifdef PEER3
            {
                int* RI = (int*)(P.ws + O_RIDX) + (size_t)token * 128 + wid * 16; float* RWp = (float*)(P.ws + O_RG) + (size_t)token * 128 + wid * 16;
#pragma unroll
                for (int m4 = 0; m4 < 4; ++m4) {
                    *(u32x4*)(RI + m4 * 4) = (u32x4){(unsigned)(top2[m4 * 4] & 0xffffffffll), (unsigned)(top2[m4 * 4 + 1] & 0xffffffffll), (unsigned)(top2[m4 * 4 + 2] & 0xffffffffll), (unsigned)(top2[m4 * 4 + 3] & 0xffffffffll)};
                    *(f32x4*)(RWp + m4 * 4) = (f32x4){e[m4 * 4] * inv, e[m4 * 4 + 1] * inv, e[m4 * 4 + 2] * inv, e[m4 * 4 + 3] * inv};
                }
            }
#else
#pragma unroll
            for (int m = 0; m < 16; ++m) { ridx[lane * 129 + wid * 16 + m] = (int)(unsigned)(top2[m] & 0xffffffffll); rgt[lane * 129 + wid * 16 + m] = e[m] * inv; }
#endif
        }
#endif
        __syncthreads();
#ifdef PEER3
        continue;
#endif
#ifndef NO_GATHER
#ifdef PROBE_T
        unsigned long long pt1 = __builtin_amdgcn_s_memrealtime();
#endif
        {
            const int j = lane & 15, g = lane >> 4;
            unsigned char* xt = lds + 82560;
#pragma unroll 1
            for (int half = 0; half < 2; ++half) {
                for (int i = tid; i < 32 * 128; i += 512) { const int t = i >> 7, c16 = i & 127; *(u32x4*)(xt + t * 2064 + c16 * 16) = *(const u32x4*)(x1b + (size_t)(tok0 + half * 32 + t) * 1024 + c16 * 8); }
                __syncthreads();
                float dkeep = 0.f; int pkeep = -1; int nk = 0;
                int r_ = 0, ch_ = wid - 8; unsigned long long m0 = 0ull, m1 = 0ull;
#define PA_ADV(VALID, TL, BS, ACT) do { VALID = true; \
                    while (!(m0 | m1)) { ch_ += 8; if (ch_ >= 32) { ch_ = wid; if (++r_ >= 1) { VALID = false; break; } } \
                        const int tl_ = half * 32 + ch_; const int id0 = ridx[tl_ * 129 + lane], id1 = ridx[tl_ * 129 + 64 + lane]; \
                        m0 = __ballot((id0 >> 14) == r_); m1 = __ballot((id1 >> 14) == r_); } \
                    if (VALID) { int bb[4]; \
                        _Pragma("unroll") for (int q = 0; q < 4; ++q) { \
                            if (m0) { bb[q] = __ffsll((long long)m0) - 1; m0 &= m0 - 1; } \
                            else if (m1) { bb[q] = 64 + __ffsll((long long)m1) - 1; m1 &= m1 - 1; } \
                            else bb[q] = -1; } \
                        const int bg = g == 0 ? bb[0] : (g == 1 ? bb[1] : (g == 2 ? bb[2] : bb[3])); \
                        ACT = bg >= 0; BS = ACT ? bg : bb[0]; TL = half * 32 + ch_; } else { ACT = false; BS = 0; TL = half * 32; } } while (0)
#define PA_LOAD(U, TL, BS) do { const int pidx = ridx[(TL) * 129 + (BS)]; const unsigned char* ur = u8t + (size_t)pidx * 1024 + j * 16; \
                    _Pragma("unroll") for (int i = 0; i < 4; ++i) U[i] = *(const u32x4*)(ur + i * 256); } while (0)
#define PA_COMP(U, TL, BS, ACT) do { \
                        const unsigned char* xrow = xt + ((TL) - half * 32) * 2064 + j * 32; \
                        float d0 = 0.f, d1 = 0.f; \
                        _Pragma("unroll") for (int i = 0; i < 4; ++i) { \
                            const u32x4 xa = *(const u32x4*)(xrow + i * 512), xb_ = *(const u32x4*)(xrow + i * 512 + 16); \
                            _Pragma("unroll") for (int q = 0; q < 4; ++q) { \
                                const u32x4 xs = q < 2 ? xa : xb_; \
                                const unsigned wd = U[i][q]; \
                                const f32x2 lo_ = __builtin_amdgcn_cvt_pk_f32_fp8((int)wd, false), hi_ = __builtin_amdgcn_cvt_pk_f32_fp8((int)wd, true); \
                                d0 = dot2bf(pk2(lo_.x, lo_.y), xs[(q & 1) * 2], d0); d1 = dot2bf(pk2(hi_.x, hi_.y), xs[(q & 1) * 2 + 1], d1); } } \
                        float dsum = d0 + d1; \
                        dsum += __shfl_xor(dsum, 1); dsum += __shfl_xor(dsum, 2); dsum += __shfl_xor(dsum, 4); dsum += __shfl_xor(dsum, 8); \
                        dsum *= (1.0f / 256.0f); \
                        if (j == nk) { dkeep = dsum; pkeep = (ACT) ? (TL) * 129 + (BS) : -1; } \
                        if (++nk == 16) { \
                            if (pkeep >= 0) { const float hid = 0.5f * dkeep * (1.0f + erff(dkeep * 0.70710678118f)); rgt[pkeep] *= hid * (1.0f / 32.0f); } \
                            nk = 0; pkeep = -1; } } while (0)
                bool vA, vB, actA = false, actB = false; int tlA = 0, tlB = 0, bsA = 0, bsB = 0; u32x4 uA[4], uB[4];
                PA_ADV(vA, tlA, bsA, actA);
                PA_LOAD(uA, tlA, bsA);
                while (vA) {
                    PA_ADV(vB, tlB, bsB, actB);
                    PA_LOAD(uB, tlB, bsB);
                    PA_COMP(uA, tlA, bsA, actA);
                    if (!vB) break;
                    PA_ADV(vA, tlA, bsA, actA);
                    PA_LOAD(uA, tlA, bsA);
                    PA_COMP(uB, tlB, bsB, actB);
                }
#undef PA_COMP
#undef PA_ADV
#undef PA_LOAD
                if (pkeep >= 0) { const float hid = 0.5f * dkeep * (1.0f + erff(dkeep * 0.70710678118f)); rgt[pkeep] *= hid * (1.0f / 32.0f); }
                __syncthreads();
            }
#ifdef PROBE_T
            unsigned long long pt2 = __builtin_amdgcn_s_memrealtime();
            { unsigned long long* tsl = (unsigned long long*)(lds + 163840 - 64); if (tid == 0) { tsl[0] = pt1 - pt0; tsl[1] = pt2 - pt1; } }
#endif
#ifdef PEER2
            {
                int* RI = (int*)(P.ws + O_RIDX) + (size_t)tok0 * 128; float* RWp = (float*)(P.ws + O_RW) + (size_t)tok0 * 128;
                for (int i = tid; i < 64 * 128; i += 512) { RI[i] = ridx[(i >> 7) * 129 + (i & 127)]; RWp[i] = rgt[(i >> 7) * 129 + (i & 127)]; }
            }
            continue;
#endif
#pragma unroll 1
            for (int tt = 0; tt < 8; ++tt) {
                const int tl = wid * 8 + tt, token = tok0 + tl;
                f32x2 acc[32];
#pragma unroll
                for (int i = 0; i < 32; ++i) acc[i] = (f32x2){0.f, 0.f};
#define PEER_LOAD(V, GT, IT) do { const int e_ = (IT) * 4 + g; const int idx_ = ridx[tl * 129 + e_]; GT = rgt[tl * 129 + e_]; \
                    const unsigned char* vr_ = v8t + (size_t)idx_ * 1024 + j * 16; \
                    _Pragma("unroll") for (int i = 0; i < 4; ++i) V[i] = *(const u32x4*)(vr_ + i * 256); } while (0)
#define PEER_COMP(V, GT) do { const f32x2 ww = {GT, GT}; \
                    _Pragma("unroll") for (int i = 0; i < 4; ++i) _Pragma("unroll") for (int q = 0; q < 4; ++q) { const int wd = (int)V[i][q]; \
                        acc[i * 8 + q * 2] = __builtin_elementwise_fma(ww, __builtin_amdgcn_cvt_pk_f32_fp8(wd, false), acc[i * 8 + q * 2]); \
                        acc[i * 8 + q * 2 + 1] = __builtin_elementwise_fma(ww, __builtin_amdgcn_cvt_pk_f32_fp8(wd, true), acc[i * 8 + q * 2 + 1]); } } while (0)
                u32x4 vA[4], vB[4], vC[4], vD[4]; float gA, gB, gC, gD;
                PEER_LOAD(vA, gA, 0); PEER_LOAD(vB, gB, 1); PEER_LOAD(vC, gC, 2);
#pragma unroll 1
                for (int it = 0; it < 32; it += 4) {
                    PEER_LOAD(vD, gD, it + 3);
                    PEER_COMP(vA, gA);
                    PEER_LOAD(vA, gA, (it + 4 < 32 ? it + 4 : 31));
                    PEER_COMP(vB, gB);
                    PEER_LOAD(vB, gB, (it + 5 < 32 ? it + 5 : 31));
                    PEER_COMP(vC, gC);
                    PEER_LOAD(vC, gC, (it + 6 < 32 ? it + 6 : 31));
                    PEER_COMP(vD, gD);
                }
#undef PEER_LOAD
#undef PEER_COMP
#pragma unroll
                for (int i = 0; i < 32; ++i) {
                    acc[i].x += __shfl_xor(acc[i].x, 16); acc[i].y += __shfl_xor(acc[i].y, 16);
                    acc[i].x += __shfl_xor(acc[i].x, 32); acc[i].y += __shfl_xor(acc[i].y, 32);
                }
                const size_t col = (size_t)(j + 16 * g) * 16;
                float yv[16]; float s = 0.f;
                {
                    const u32x4 pw0 = *(const u32x4*)(ple + (size_t)token * 1024 + col), pw1 = *(const u32x4*)(ple + (size_t)token * 1024 + col + 8);
                    const float pv[16] = {bflo(pw0.x), bfhi(pw0.x), bflo(pw0.y), bfhi(pw0.y), bflo(pw0.z), bfhi(pw0.z), bflo(pw0.w), bfhi(pw0.w),
                                          bflo(pw1.x), bfhi(pw1.x), bflo(pw1.y), bfhi(pw1.y), bflo(pw1.z), bfhi(pw1.z), bflo(pw1.w), bfhi(pw1.w)};
#pragma unroll
                    for (int q = 0; q < 8; ++q) {
                        const f32x2 a_ = g == 0 ? acc[q] : (g == 1 ? acc[8 + q] : (g == 2 ? acc[16 + q] : acc[24 + q]));
                        const f32x2 x_ = *(const f32x2*)(xo + (size_t)token * 1024 + col + q * 2);
                        const float y0 = DN_ALPHA * x_.x + a_.x + pv[q * 2], y1 = DN_ALPHA * x_.y + a_.y + pv[q * 2 + 1];
                        yv[q * 2] = y0; yv[q * 2 + 1] = y1; s += y0 + y1;
                    }
                }
                const float mu = wave_sum(s) * (1.0f / 1024.0f);
                float qq = 0.f;
#pragma unroll
                for (int q = 0; q < 16; ++q) { yv[q] -= mu; qq += yv[q] * yv[q]; }
                const float rstd = rsqrtf(wave_sum(qq) * (1.0f / 1024.0f) + 1e-5f);
                {
                    const float* lg = P.ln2_g; const float* lb = P.ln2_b; asm volatile("" : "+s"(lg), "+s"(lb));
#pragma unroll
                    for (int q = 0; q < 4; ++q) {
                        const f32x4 gg = *(const f32x4*)(lg + col + q * 4), bb = *(const f32x4*)(lb + col + q * 4);
                        f32x4 o;
#pragma unroll
                        for (int r = 0; r < 4; ++r) o[r] = yv[q * 4 + r] * rstd * gg[r] + bb[r];
                        *(f32x4*)(xo + (size_t)token * 1024 + col + q * 4) = o;
                    }
                }
            }
        }
#endif
        __syncthreads();
    }
}

#define XB_TMO      128
#define XB_XCNT(j)  (256  + 64 * (j))
#define XB_XSUB(j)  (1280 + 64 * (j))
#define XB_XGEN(j)  (2304 + 64 * (j))
#define XB_TOP      3328
#define XB_TOPGEN   3392
#define XCD_BAR_WORDS 3456
#define XB_SPIN_CAP (1u << 18)
#define LAS __attribute__((address_space(3)))

__device__ __forceinline__ unsigned xb_ld(unsigned* p)              { return __hip_atomic_load(p, __ATOMIC_RELAXED, __HIP_MEMORY_SCOPE_AGENT); }
__device__ __forceinline__ unsigned xb_add(unsigned* p, unsigned v) { return __hip_atomic_fetch_add(p, v, __ATOMIC_RELAXED, __HIP_MEMORY_SCOPE_AGENT); }
__device__ __forceinline__ unsigned xb_xcc_id() { return (unsigned)__builtin_amdgcn_s_getreg((3 << 11) | 20) & 0xFu; }
#define XB_SPIN(cond, bar) do { unsigned _sp = 0; while (cond) { __builtin_amdgcn_s_sleep(1); \
    if ((++_sp & 255u) == 0u) { if (xb_ld(&(bar)[XB_TMO])) break; if (_sp > XB_SPIN_CAP) { atomicAdd(&(bar)[XB_TMO], 1u); break; } } } } while (0)

struct XcdBarrier {
    unsigned* bar; unsigned x;
    volatile LAS unsigned* st;
};

__device__ __forceinline__ XcdBarrier xcd_barrier_post(unsigned* bar, volatile LAS unsigned* st) {
    XcdBarrier b; b.bar = bar; b.x = xb_xcc_id(); b.st = st;
    if (threadIdx.x == 0) (void)xb_add(&bar[XB_XCNT(b.x)], 1u);
    return b;
}
__device__ __forceinline__ void xcd_barrier_complete(unsigned* bar, unsigned x, unsigned& nloc, unsigned& nx) {
    const unsigned G = gridDim.x * gridDim.y * gridDim.z;
    unsigned sum, cnt, mine, sp = 0u;
    for (;;) {
        sum = 0u; cnt = 0u; mine = 0u;
#pragma unroll
        for (unsigned j = 0; j < 16; ++j) { const unsigned c = xb_ld(&bar[XB_XCNT(j)]); sum += c; cnt += (c > 0u) ? 1u : 0u; mine = (j == x) ? c : mine; }
        if (sum == G) break;
        __builtin_amdgcn_s_sleep(1);
        if ((++sp & 255u) == 0u) { if (xb_ld(&bar[XB_TMO])) break; if (sp > XB_SPIN_CAP) { atomicAdd(&bar[XB_TMO], 1u); break; } }
    }
    nloc = mine > 0u ? mine : 1u; nx = cnt > 0u ? cnt : 1u;
}

__device__ __forceinline__ void xcd_barrier(const XcdBarrier& b) {
    asm volatile("s_waitcnt vmcnt(0)" ::: "memory");
    __syncthreads();
    if (threadIdx.x == 0) {
        unsigned* bar = b.bar;
        __builtin_amdgcn_s_waitcnt(0);
        unsigned nloc = b.st[0], nx = b.st[1];
        if (nloc == 0u) { xcd_barrier_complete(bar, b.x, nloc, nx); b.st[0] = nloc; b.st[1] = nx; }
        const unsigned old = xb_add(&bar[XB_XSUB(b.x)], 1u);
        const unsigned gen = old / nloc;
        if (old + 1u == (gen + 1u) * nloc) {
            __builtin_amdgcn_fence(__ATOMIC_RELEASE, "agent");
            asm volatile("s_waitcnt vmcnt(0)" ::: "memory");
            const unsigned og = xb_add(&bar[XB_TOP], 1u);
            const unsigned tg = og / nx;
            if (og + 1u == (tg + 1u) * nx) xb_add(&bar[XB_TOPGEN], 1u);
            else XB_SPIN(xb_ld(&bar[XB_TOPGEN]) == tg, bar);
            __builtin_amdgcn_fence(__ATOMIC_ACQUIRE, "agent");
            xb_add(&bar[XB_XGEN(b.x)], 1u);
            asm volatile("s_waitcnt vmcnt(0)" ::: "memory");
        } else {
            XB_SPIN(xb_ld(&bar[XB_XGEN(b.x)]) == gen, bar);
            __builtin_amdgcn_fence(__ATOMIC_ACQUIRE, "agent");
            asm volatile("s_waitcnt vmcnt(0)" ::: "memory");
        }
    }
    __syncthreads();
}


constexpr size_t O_BAR = 250 * MBY;
__device__ __forceinline__ void counter_barrier(unsigned* cnt, unsigned& epoch) {
    asm volatile("s_waitcnt vmcnt(0)" ::: "memory");
    __syncthreads();
    if (threadIdx.x == 0) {
        __builtin_amdgcn_fence(__ATOMIC_RELEASE, "agent");
        asm volatile("s_waitcnt vmcnt(0)" ::: "memory");
        (void)__hip_atomic_fetch_add(cnt, 1u, __ATOMIC_RELAXED, __HIP_MEMORY_SCOPE_AGENT);
        const unsigned target = (epoch + 1u) * gridDim.x;
        while (__hip_atomic_load(cnt, __ATOMIC_RELAXED, __HIP_MEMORY_SCOPE_AGENT) < target) __builtin_amdgcn_s_sleep(2);
        __builtin_amdgcn_fence(__ATOMIC_ACQUIRE, "agent");
        asm volatile("s_waitcnt vmcnt(0)" ::: "memory");
    }
    ++epoch;
    __syncthreads();
}

#ifdef PEER2
__device__ __forceinline__ int peer_pop(unsigned* q, volatile int* slot) {
    __syncthreads();
    if (threadIdx.x == 0) *slot = (int)__hip_atomic_fetch_add(q, 1u, __ATOMIC_RELAXED, __HIP_MEMORY_SCOPE_AGENT);
    __syncthreads();
    return *slot;
}
__device__ __forceinline__ int peer_next(unsigned* q, int k0, int& kk, unsigned limit, volatile int* slot) {
    __syncthreads();
    if (threadIdx.x == 0) {
        int fk = -1, t = 0;
        for (int i = kk; i < 8; ++i) {
            unsigned* qa = q + ((k0 + i) & 7) * 64;
            if (__hip_atomic_load(qa, __ATOMIC_RELAXED, __HIP_MEMORY_SCOPE_AGENT) >= limit) continue;
            const unsigned tt = __hip_atomic_fetch_add(qa, 1u, __ATOMIC_RELAXED, __HIP_MEMORY_SCOPE_AGENT);
            if (tt < limit) { fk = i; t = (int)tt; break; }
        }
        slot[0] = fk; slot[1] = t;
    }
    __syncthreads();
    kk = slot[0]; return slot[1];
}
struct PeerTickets { int is_static, rank, nloc, t, kk; };
__device__ __forceinline__ void peer_tickets_init(PeerTickets& T, unsigned* bar, volatile int* slot) {
    __syncthreads();
    if (threadIdx.x == 0) {
        const unsigned G = gridDim.x; bool ok = (G % 8u) == 0u && (NTOK / 128) % (int)(G / 8u) == 0;
        for (unsigned jx = 0; jx < 16; ++jx) { const unsigned c = __hip_atomic_load(&bar[XB_XCNT(jx)], __ATOMIC_RELAXED, __HIP_MEMORY_SCOPE_AGENT); if (c != (jx < 8 ? G / 8u : 0u)) ok = false; }
        slot[0] = ok ? 1 : 0;
    }
    __syncthreads();
    T.is_static = slot[0]; T.rank = slot[2]; T.nloc = (int)(gridDim.x / 8u); T.t = 0; T.kk = 0;
    __syncthreads();
}
__device__ __forceinline__ int peer_ticket(PeerTickets& T, unsigned* q, int k0, unsigned limit, volatile int* slot) {
    if (T.is_static) {
        __syncthreads();
        const int g = T.rank + T.t * T.nloc; ++T.t;
        if (g >= (int)limit) { T.kk = -1; return 0; }
        T.kk = 0; return g;
    }
    return peer_next(q, k0, T.kk, limit, slot);
}
__device__ void peer_passA2(const Params& P, unsigned char* lds) {
    const int tid = threadIdx.x, wid = __builtin_amdgcn_readfirstlane(tid >> 6), lane = tid & 63, j = lane & 15, g = lane >> 4;
    const int* RI = (const int*)(P.ws + O_RIDX); float* RWp = (float*)(P.ws + O_RW);
    const bf16_t* x1b = (const bf16_t*)(P.ws + O_X1B); const unsigned char* u8t = P.ws + O_UB;
    unsigned char* xt = lds;
    unsigned short* ids = (unsigned short*)(lds + 132096);
    volatile int* slot = (volatile int*)(lds + 163840 - 48);
    unsigned* qA = (unsigned*)(P.ws + O_BAR) + 3584;
    const int k0 = (int)(xb_xcc_id() & 7u);
#pragma unroll 1
    for (int kk = 0; kk < 8; ++kk) {
        const int k = (k0 + kk) & 7;
#pragma unroll 1
        for (;;) {
            const int grp = peer_pop(qA + k * 64, slot);
            if (grp >= NTOK / 64) break;
            const int tok0 = grp * 64;
            for (int i = tid; i < 64 * 128; i += 512) { const int t = i >> 7, c16 = i & 127; *(u32x4*)(xt + t * 2064 + c16 * 16) = *(const u32x4*)(x1b + (size_t)(tok0 + t) * 1024 + c16 * 8); }
            for (int i = tid; i < 64 * 128 / 4; i += 512) { const u32x4 v = *(const u32x4*)(RI + (size_t)tok0 * 128 + i * 4); *(u32x2*)(ids + i * 4) = (u32x2){(v.x & 0xffffu) | (v.y << 16), (v.z & 0xffffu) | (v.w << 16)}; }
            __syncthreads();
            float dkeep = 0.f; int pkeep = -1; int nk = 0;
            int ch_ = -1; unsigned long long m0 = 0ull, m1 = 0ull;
#define PA_ADV(VALID, TL, BS, ACT) do { VALID = true; \
                while (!(m0 | m1)) { if (++ch_ >= 8) { VALID = false; break; } \
                    const int tl_ = wid * 8 + ch_; const int id0 = ids[tl_ * 128 + lane], id1 = ids[tl_ * 128 + 64 + lane]; \
                    m0 = __ballot((id0 >> 11) == k); m1 = __ballot((id1 >> 11) == k); } \
                if (VALID) { int bb[4]; \
                    _Pragma("unroll") for (int q = 0; q < 4; ++q) { \
                        if (m0) { bb[q] = __ffsll((long long)m0) - 1; m0 &= m0 - 1; } \
                        else if (m1) { bb[q] = 64 + __ffsll((long long)m1) - 1; m1 &= m1 - 1; } \
                        else bb[q] = -1; } \
                    const int bg = g == 0 ? bb[0] : (g == 1 ? bb[1] : (g == 2 ? bb[2] : bb[3])); \
                    ACT = bg >= 0; BS = ACT ? bg : bb[0]; TL = wid * 8 + ch_; } else { ACT = false; BS = 0; TL = wid * 8; } } while (0)
#define PA_LOAD(U, TL, BS) do { const int pidx = ids[(TL) * 128 + (BS)]; const unsigned char* ur = u8t + (size_t)pidx * 1024 + j * 16; \
                _Pragma("unroll") for (int i = 0; i < 4; ++i) U[i] = *(const u32x4*)(ur + i * 256); } while (0)
#define PA_COMP(U, TL, BS, ACT) do { \
                const unsigned char* xrow = xt + (TL) * 2064 + j * 32; \
                float d0 = 0.f, d1 = 0.f; \
                _Pragma("unroll") for (int i = 0; i < 4; ++i) { \
                    const u32x4 xa = *(const u32x4*)(xrow + i * 512), xb_ = *(const u32x4*)(xrow + i * 512 + 16); \
                    _Pragma("unroll") for (int q = 0; q < 4; ++q) { \
                        const u32x4 xs = q < 2 ? xa : xb_; \
                        const unsigned wd = U[i][q]; \
                        const f32x2 lo_ = __builtin_amdgcn_cvt_pk_f32_fp8((int)wd, false), hi_ = __builtin_amdgcn_cvt_pk_f32_fp8((int)wd, true); \
                        d0 = dot2bf(pk2(lo_.x, lo_.y), xs[(q & 1) * 2], d0); d1 = dot2bf(pk2(hi_.x, hi_.y), xs[(q & 1) * 2 + 1], d1); } } \
                float dsum = d0 + d1; \
                dsum += __shfl_xor(dsum, 1); dsum += __shfl_xor(dsum, 2); dsum += __shfl_xor(dsum, 4); dsum += __shfl_xor(dsum, 8); \
                dsum *= (1.0f / 256.0f); \
                if (j == nk) { dkeep = dsum; pkeep = (ACT) ? (tok0 + (TL)) * 128 + (BS) : -1; } \
                if (++nk == 16) { \
                    if (pkeep >= 0) { const float hid = 0.5f * dkeep * (1.0f + erff(dkeep * 0.70710678118f)); RWp[pkeep] *= hid * (1.0f / 32.0f); } \
                    nk = 0; pkeep = -1; } } while (0)
            bool vA, vB, actA = false, actB = false; int tlA = 0, tlB = 0, bsA = 0, bsB = 0; u32x4 uA[4], uB[4];
            PA_ADV(vA, tlA, bsA, actA);
            PA_LOAD(uA, tlA, bsA);
            while (vA) {
                PA_ADV(vB, tlB, bsB, actB);
                PA_LOAD(uB, tlB, bsB);
                PA_COMP(uA, tlA, bsA, actA);
                if (!vB) break;
                PA_ADV(vA, tlA, bsA, actA);
                PA_LOAD(uA, tlA, bsA);
                PA_COMP(uB, tlB, bsB, actB);
            }
#undef PA_ADV
#undef PA_LOAD
#undef PA_COMP
            if (pkeep >= 0) { const float hid = 0.5f * dkeep * (1.0f + erff(dkeep * 0.70710678118f)); RWp[pkeep] *= hid * (1.0f / 32.0f); }
        }
    }
}
#ifdef PEER3
__device__ void peer_passA3(const Params& P, unsigned char* lds) {
    const int tid = threadIdx.x, wid = __builtin_amdgcn_readfirstlane(tid >> 6), lane = tid & 63, j8 = lane & 7, t8 = lane >> 3;
    const int* RI = (const int*)(P.ws + O_RIDX); const float* x1 = P.out; float* PART = (float*)(P.ws + O_PART);
    volatile int* slot = (volatile int*)(lds + 163840 - 48);
    unsigned* qA = (unsigned*)(P.ws + O_BAR) + 3584;
    const int k0 = (int)(xb_xcc_id() & 7u);
    PeerTickets TK; peer_tickets_init(TK, (unsigned*)(P.ws + O_BAR), slot);
#pragma unroll 1
    for (;;) {
        const int grp = peer_ticket(TK, qA, k0, (unsigned)(NTOK / 128), slot); const int kk = TK.kk;
        if (kk < 0) break;
        const int k = (k0 + kk) & 7;
        const unsigned char* ublk = P.ws + O_UB + (size_t)k * 16384 * 128 + j8 * 16;
        {
            u32x4* li0 = (u32x4*)lds; const u32x4* gi = (const u32x4*)(RI + (size_t)grp * 128 * 128);
            for (int i = tid; i < 128 * 32; i += 512) li0[(i >> 5) * 33 + (i & 31)] = gi[i];
        }
        __syncthreads();
#pragma unroll 1
        for (int sub = 0; sub < 2; ++sub) {
            const int tl = sub * 64 + wid * 8 + t8, token = grp * 128 + tl;
            const int* li = (const int*)lds + tl * 132;
            f32x2 xp[8];
#pragma unroll
            for (int q = 0; q < 4; ++q) { const f32x4 v = *(const f32x4*)(x1 + (size_t)token * 1024 + k * 128 + j8 * 16 + q * 4); xp[q * 2] = (f32x2){v[0], v[1]}; xp[q * 2 + 1] = (f32x2){v[2], v[3]}; }
            float* po = PART + (size_t)k * NTOK * 128 + (size_t)token * 128 + j8;
#define PA3_LOAD(V, IT) do { _Pragma("unroll") for (int q = 0; q < 8; ++q) V[q] = *(const u32x4*)(ublk + (size_t)li[(IT) + q] * 128); } while (0)
#define PA3_COMP(V, IT) do { float s_[8]; \
                _Pragma("unroll") for (int q = 0; q < 8; ++q) { f32x2 a0 = {0.f, 0.f}, a1 = {0.f, 0.f}; \
                    _Pragma("unroll") for (int d = 0; d < 4; ++d) { const int wd = (int)V[q][d]; \
                        a0 = __builtin_elementwise_fma(__builtin_amdgcn_cvt_pk_f32_fp8(wd, false), xp[d * 2], a0); \
                        a1 = __builtin_elementwise_fma(__builtin_amdgcn_cvt_pk_f32_fp8(wd, true), xp[d * 2 + 1], a1); } \
                    const f32x2 a = a0 + a1; s_[q] = a.x + a.y; } \
                float r4[4]; \
                _Pragma("unroll") for (int i = 0; i < 4; ++i) { const float mine = (j8 & 4) ? s_[4 + i] : s_[i], oth = (j8 & 4) ? s_[i] : s_[4 + i]; r4[i] = mine + dpp_xor4(oth); } \
                float r2[2]; \
                _Pragma("unroll") for (int i = 0; i < 2; ++i) { const float mine = (j8 & 2) ? r4[2 + i] : r4[i], oth = (j8 & 2) ? r4[i] : r4[2 + i]; r2[i] = mine + dpp_xor2(oth); } \
                const float mine1 = (j8 & 1) ? r2[1] : r2[0], oth1 = (j8 & 1) ? r2[0] : r2[1]; \
                po[(IT)] = mine1 + dpp_xor1(oth1); } while (0)
            u32x4 vA[8], vB[8]; int iA[8], iB[8];
#define PA3_IDX(I, IT) do { _Pragma("unroll") for (int q = 0; q < 8; ++q) I[q] = li[(IT) + q]; } while (0)
#define PA3_LOADI(V, I) do { _Pragma("unroll") for (int q = 0; q < 8; ++q) V[q] = *(const u32x4*)(ublk + (size_t)(unsigned)I[q] * 128); } while (0)
            PA3_IDX(iA, 0); PA3_IDX(iB, 8);
            PA3_LOADI(vA, iA);
#pragma unroll 1
            for (int it = 0; it < 128; it += 16) {
                PA3_LOADI(vB, iB);
                PA3_IDX(iA, (it + 16 < 128 ? it + 16 : 112));
                PA3_COMP(vA, it);
                PA3_LOADI(vA, iA);
                PA3_IDX(iB, (it + 24 < 128 ? it + 24 : 120));
                PA3_COMP(vB, it + 8);
            }
#undef PA3_IDX
#undef PA3_LOADI
#undef PA3_LOAD
#undef PA3_COMP
        }
    }
}
__device__ void peer_reduce3(const Params& P) {
    const float* PART = (const float*)(P.ws + O_PART); const float* RG = (const float*)(P.ws + O_RG); float* RWp = (float*)(P.ws + O_RW);
    for (int i = blockIdx.x * 512 + threadIdx.x; i < NTOK * 128 / 4; i += gridDim.x * 512) {
        f32x4 d = *(const f32x4*)(PART + (size_t)i * 4);
#pragma unroll
        for (int k = 1; k < 8; ++k) d += *(const f32x4*)(PART + (size_t)k * NTOK * 128 + (size_t)i * 4);
        const f32x4 gt = *(const f32x4*)(RG + (size_t)i * 4);
        f32x4 w;
#pragma unroll
        for (int q = 0; q < 4; ++q) { const float ds = d[q] * (1.0f / 256.0f); w[q] = gt[q] * (0.5f * ds * (1.0f + erff(ds * 0.70710678118f))) * (1.0f / 32.0f); }
        *(f32x4*)(RWp + (size_t)i * 4) = w;
    }
}
#endif
__device__ void peer_passB2(const Params& P, unsigned char* lds) {
    const int tid = threadIdx.x, wid = __builtin_amdgcn_readfirstlane(tid >> 6), lane = tid & 63, j8 = lane & 7, g8 = lane >> 3;
    const int* RI = (const int*)(P.ws + O_RIDX); const float* RWp = (const float*)(P.ws + O_RW);
    float* FF = (float*)(P.ws + O_FF);
    volatile int* slot = (volatile int*)(lds + 163840 - 48);
    unsigned* qB = (unsigned*)(P.ws + O_BAR) + 4096;
    const int k0 = (int)(xb_xcc_id() & 7u);
    PeerTickets TK; peer_tickets_init(TK, (unsigned*)(P.ws + O_BAR), slot);
#pragma unroll 1
    for (;;) {
        {
            const int grp = peer_ticket(TK, qB, k0, (unsigned)(NTOK / 128), slot); const int kk = TK.kk;
            if (kk < 0) break;
            const int k = (k0 + kk) & 7;
            const unsigned char* vblk = P.ws + O_VB + (size_t)k * 16384 * 128 + j8 * 16;
            {
                u32x4* li0 = (u32x4*)lds; u32x4* lw0 = (u32x4*)(lds + 67584);
                const u32x4* gi = (const u32x4*)(RI + (size_t)grp * 128 * 128); const u32x4* gw = (const u32x4*)(RWp + (size_t)grp * 128 * 128);
                for (int i = tid; i < 128 * 32; i += 512) { li0[(i >> 5) * 33 + (i & 31)] = gi[i]; lw0[(i >> 5) * 33 + (i & 31)] = gw[i]; }
            }
            __syncthreads();
            {
                const int t8 = lane >> 3;
                const int* lib = (const int*)lds + (wid * 8 + t8) * 132; const float* lwb = (const float*)(lds + 67584) + (wid * 8 + t8) * 132;
#define POS(P_) ((((P_) >> 7) * (64 * 132)) + ((P_) & 127))
                f32x2 acc[8];
#pragma unroll
                for (int i = 0; i < 8; ++i) acc[i] = (f32x2){0.f, 0.f};
#define PB_COMP(V, IT) do { const float* lw_ = lwb + POS(IT); _Pragma("unroll") for (int q = 0; q < 8; ++q) { const float w_ = lw_[q]; const f32x2 ww = {w_, w_}; \
                    _Pragma("unroll") for (int d = 0; d < 4; ++d) { const int wd = (int)V[q][d]; \
                        acc[d * 2] = __builtin_elementwise_fma(ww, __builtin_amdgcn_cvt_pk_f32_fp8(wd, false), acc[d * 2]); \
                        acc[d * 2 + 1] = __builtin_elementwise_fma(ww, __builtin_amdgcn_cvt_pk_f32_fp8(wd, true), acc[d * 2 + 1]); } } } while (0)
                u32x4 vA[8], vB[8]; int iA[8], iB[8];
#define PB_IDX(I, IT) do { const int* li_ = lib + POS(IT); _Pragma("unroll") for (int q = 0; q < 8; ++q) I[q] = li_[q]; } while (0)
#define PB_LOADI(V, I) do { _Pragma("unroll") for (int q = 0; q < 8; ++q) V[q] = *(const u32x4*)(vblk + (size_t)(unsigned)I[q] * 128); } while (0)
                PB_IDX(iA, 0); PB_IDX(iB, 8);
                PB_LOADI(vA, iA);
#pragma unroll 1
                for (int it = 0; it < 256; it += 16) {
                    PB_LOADI(vB, iB);
                    PB_IDX(iA, (it + 16 < 256 ? it + 16 : 240));
                    PB_COMP(vA, it);
                    PB_LOADI(vA, iA);
                    PB_IDX(iB, (it + 24 < 256 ? it + 24 : 248));
                    PB_COMP(vB, it + 8);
                    if ((it & 127) == 112) {
                        const int token = grp * 128 + (it >> 7) * 64 + wid * 8 + t8;
                        float* o = FF + (size_t)token * 1024 + k * 128 + j8 * 16;
#pragma unroll
                        for (int q = 0; q < 4; ++q) *(f32x4*)(o + q * 4) = (f32x4){acc[q * 2].x, acc[q * 2].y, acc[q * 2 + 1].x, acc[q * 2 + 1].y};
#pragma unroll
                        for (int i = 0; i < 8; ++i) acc[i] = (f32x2){0.f, 0.f};
                    }
                }
#undef PB_IDX
#undef PB_LOADI
#undef PB_COMP
#undef POS
            }
        }
    }
}
__device__ void peer_ln2(const Params& P) {
    const int tid = threadIdx.x, wid = tid >> 6, lane = tid & 63;
    float* y = P.out; const float* FF = (const float*)(P.ws + O_FF); const bf16_t* ple = (const bf16_t*)(P.ws + O_PP);
    const int rstride = gridDim.x * 8;
    for (int row0 = blockIdx.x * 8 + wid; row0 < NTOK; row0 += 2 * rstride) {
        const int row1 = row0 + rstride; const bool has1 = row1 < NTOK; const int r1 = has1 ? row1 : row0;
        f32x4 v[4], w[4]; float s = 0.f, s1 = 0.f;
#pragma unroll
        for (int i = 0; i < 4; ++i) {
            const size_t c0 = (size_t)row0 * 1024 + i * 256 + lane * 4, c1 = (size_t)r1 * 1024 + i * 256 + lane * 4;
            const u32x2 p0 = *(const u32x2*)(ple + c0), p1 = *(const u32x2*)(ple + c1);
            v[i] = *(const f32x4*)(y + c0) * DN_ALPHA + *(const f32x4*)(FF + c0) + (f32x4){bflo(p0.x), bfhi(p0.x), bflo(p0.y), bfhi(p0.y)};
            w[i] = *(const f32x4*)(y + c1) * DN_ALPHA + *(const f32x4*)(FF + c1) + (f32x4){bflo(p1.x), bfhi(p1.x), bflo(p1.y), bfhi(p1.y)};
        }
#pragma unroll
        for (int i = 0; i < 4; ++i) { s += (v[i][0] + v[i][1]) + (v[i][2] + v[i][3]); s1 += (w[i][0] + w[i][1]) + (w[i][2] + w[i][3]); }
        s += __shfl_xor(s, 32); s1 += __shfl_xor(s1, 32); s += __shfl_xor(s, 16); s1 += __shfl_xor(s1, 16);
        s += dpp_xor8(s); s1 += dpp_xor8(s1); s += dpp_xor4(s); s1 += dpp_xor4(s1); s += dpp_xor2(s); s1 += dpp_xor2(s1); s += dpp_xor1(s); s1 += dpp_xor1(s1);
        const float mu = s * (1.0f / 1024.0f), mu1 = s1 * (1.0f / 1024.0f);
        float q = 0.f, q1 = 0.f;
#pragma unroll
        for (int i = 0; i < 4; ++i) { v[i] = v[i] - mu; w[i] = w[i] - mu1; q += (v[i][0] * v[i][0] + v[i][1] * v[i][1]) + (v[i][2] * v[i][2] + v[i][3] * v[i][3]); q1 += (w[i][0] * w[i][0] + w[i][1] * w[i][1]) + (w[i][2] * w[i][2] + w[i][3] * w[i][3]); }
        q += __shfl_xor(q, 32); q1 += __shfl_xor(q1, 32); q += __shfl_xor(q, 16); q1 += __shfl_xor(q1, 16);
        q += dpp_xor8(q); q1 += dpp_xor8(q1); q += dpp_xor4(q); q1 += dpp_xor4(q1); q += dpp_xor2(q); q1 += dpp_xor2(q1); q += dpp_xor1(q); q1 += dpp_xor1(q1);
        const float rstd = rsqrtf(q * (1.0f / 1024.0f) + 1e-5f), rstd1 = rsqrtf(q1 * (1.0f / 1024.0f) + 1e-5f);
#pragma unroll
        for (int i = 0; i < 4; ++i) {
            const int col = i * 256 + lane * 4;
            const f32x4 gg = *(const f32x4*)(P.ln2_g + col), bb = *(const f32x4*)(P.ln2_b + col);
            *(f32x4*)(y + (size_t)row0 * 1024 + col) = v[i] * rstd * gg + bb;
            if (has1) *(f32x4*)(y + (size_t)row1 * 1024 + col) = w[i] * rstd1 * gg + bb;
        }
    }
}
#endif

__global__ void __launch_bounds__(512, 2) mega(Params P) {
    extern __shared__ __attribute__((aligned(16))) unsigned char shm[];
    cg::grid_group grid = cg::this_grid();
    PG8_LAS unsigned char* ldsg = (PG8_LAS unsigned char*)shm;
#ifdef ONLY
#define PH(i) ((i) == ONLY)
#else
#define PH(i) (P.ph_lo <= (i) && (i) < P.ph_hi)
#endif
#ifdef USE_XCD_BARRIER
#define SYNC() do { if (P.coop == 1) xcd_barrier(xbar); else if (P.coop == 2) grid.sync(); } while (0)
#else
    unsigned bar_epoch = 0u;
#define SYNC() do { if (P.coop == 1) counter_barrier((unsigned*)(P.ws + O_BAR) + 64, bar_epoch); else if (P.coop == 2) grid.sync(); } while (0)
#endif
    volatile LAS unsigned* xst = (volatile LAS unsigned*)(ldsg + (163840 - 32));
    if (threadIdx.x == 0) { xst[0] = 0u; xst[1] = 0u; }
    __syncthreads();
#ifndef HOST_MEMSET
    if (P.coop) {
        if (blockIdx.x == 0) for (int i = threadIdx.x; i < XCD_BAR_WORDS; i += 512) ((unsigned*)(P.ws + O_BAR))[i] = 0u;
        grid.sync();
    }
#else
    if (P.coop == 2) grid.sync();
#endif
    XcdBarrier xbar = xcd_barrier_post((unsigned*)(P.ws + O_BAR), xst);
    if (threadIdx.x == 0) ((volatile LAS int*)(ldsg + (163840 - 48)))[2] = (int)__hip_atomic_fetch_add((unsigned*)(P.ws + O_BAR) + 7168 + 64 * (xbar.x & 15u), 1u, __ATOMIC_RELAXED, __HIP_MEMORY_SCOPE_AGENT);
#ifdef PROBE_T
    unsigned long long TS[14];
#define STAMP(k) TS[k] = __builtin_amdgcn_s_memrealtime()
#else
#define STAMP(k)
#endif
    STAMP(0);
    if (PH(0)) { phase_prep(P, shm); SYNC(); }
    STAMP(1);
    if (PH(1)) {
        pg8::Gemm g{(const bf16_t*)(P.ws + O_XB), (const bf16_t*)(P.ws + O_WINT), NTOK, 7168, 1024};
        pg8::StaticOrder S; S.init(NTOK, 7168, (int)gridDim.x, (int)blockIdx.x);
        EpiZ E{P.ws};
        pg8::gemm_phase<EpiZ, pg8::StaticOrder, false>(ldsg, g, S, E, nullptr);
        SYNC();
    }
    STAMP(2);
    if (PH(2)) { phase_lru(P, shm); SYNC(); }
    STAMP(3);
    if (PH(3)) { phase_gla1(P, shm); SYNC(); }
    STAMP(4);
    if (PH(4)) { phase_gla2(P); SYNC(); }
    STAMP(5);
    if (PH(5)) { phase_combine(P); SYNC(); }
    STAMP(6);
    if (PH(6)) {
        {
            pg8::Gemm g{(const bf16_t*)(P.ws + O_XB), (const bf16_t*)(P.ws + O_WOUTT), NTOK, 1024, 1024};
            pg8::StaticOrder S; S.init(NTOK, 1024, (int)gridDim.x, (int)blockIdx.x);
            EpiY1 E{P.x, P.out};
            pg8::gemm_phase<EpiY1, pg8::StaticOrder, false>(ldsg, g, S, E, nullptr);
        }
        {
            pg8::Gemm g{(const bf16_t*)(P.ws + O_PB), (const bf16_t*)(P.ws + O_WPPT), NTOK, 1024, 256};
            pg8::StaticOrder S; S.init(NTOK, 1024, (int)gridDim.x, (int)blockIdx.x);
            EpiPP E{(bf16_t*)(P.ws + O_PP)};
            pg8::gemm_phase<EpiPP, pg8::StaticOrder, false>(ldsg, g, S, E, nullptr);
        }
        SYNC();
    }
    STAMP(7);
    if (PH(7)) { phase_ln1(P); SYNC(); }
    STAMP(8);
    if (PH(8)) {
        pg8::Gemm g{(const bf16_t*)(P.ws + O_X1B), (const bf16_t*)(P.ws + O_WQGT), NTOK, 2048, 1024};
        pg8::StaticOrder S; S.init(NTOK, 2048, (int)gridDim.x, (int)blockIdx.x);
        EpiQG E{(float*)(P.ws + O_QP), (bf16_t*)(P.ws + O_PP)};
        pg8::gemm_phase<EpiQG, pg8::StaticOrder, false>(ldsg, g, S, E, nullptr);
        SYNC();
    }
    STAMP(9);
#ifdef EXTRA_SYNCS
    for (int i = 0; i < EXTRA_SYNCS; ++i) SYNC();
#endif
    if (PH(9)) { phase_peer(P, shm, grid); }
#ifdef PEER2
#ifdef PEER3
    if (PH(9)) { SYNC(); STAMP(10); peer_passA3(P, shm); SYNC(); peer_reduce3(P); SYNC(); STAMP(11); peer_passB2(P, shm); SYNC(); STAMP(13); peer_ln2(P); }
#else
    if (PH(9)) { SYNC(); STAMP(11); peer_passB2(P, shm); SYNC(); STAMP(13); peer_ln2(P); }
#endif
#endif
#ifdef PROBE_T
    {
        __syncthreads();
        const unsigned long long* tsl = (const unsigned long long*)(shm + 163840 - 64);
#ifndef PEER2
        TS[10] = TS[9] + tsl[0]; TS[11] = TS[10] + tsl[1];
#endif
        STAMP(12);
        const unsigned long long dtS = TS[PROBE_SB] - TS[PROBE_SA], dtF = TS[PROBE_FB] - TS[PROBE_FA];
        while (__builtin_amdgcn_s_memrealtime() - TS[12] < dtS) __builtin_amdgcn_s_sleep(8);
        if (blockIdx.x == 0 && threadIdx.x < 64) {
            const float frac = (float)(double)dtF / (float)(double)(TS[12] - TS[0]);
            P.out[threadIdx.x] += 0.2f + 0.2f * frac;
        }
    }
#endif
#undef PH
#undef SYNC
#undef STAMP
}

#ifdef DBG_SCAN

__global__ void dbg_check(const void* p, size_t n, int is_bf16, int* flags, int code) {
    int bad = 0;
    if (is_bf16) { const unsigned short* q = (const unsigned short*)p; for (size_t i = (size_t)blockIdx.x * blockDim.x + threadIdx.x; i < n; i += (size_t)gridDim.x * blockDim.x) if ((q[i] & 0x7f80) == 0x7f80) bad = 1; }
    else { const unsigned* q = (const unsigned*)p; for (size_t i = (size_t)blockIdx.x * blockDim.x + threadIdx.x; i < n; i += (size_t)gridDim.x * blockDim.x) if ((q[i] & 0x7f800000u) == 0x7f800000u) bad = 1; }
    if (bad) flags[code] = 1;
}
__global__ void dbg_report(float* out, size_t n, const int* flags) {
    int code = 0; for (int c = 40; c < 64; ++c) if (flags[c]) { code = c; break; }
    if (!code) for (int c = 1; c < 40; ++c) if (flags[c]) { code = c; break; }
    for (size_t i = (size_t)blockIdx.x * blockDim.x + threadIdx.x; i < n; i += (size_t)gridDim.x * blockDim.x) out[i] = (i == 0) ? 1000.f * code : 0.f;
}
static void dbg_after_phase(int ph, const Params& P, hipStream_t stream) {
    int* flags = (int*)(P.ws + 240 * MBY);
    auto chk = [&](size_t off, size_t nelem, int bf, int code) { hipLaunchKernelGGL(dbg_check, dim3(1024), dim3(256), 0, stream, (const void*)(P.ws + off), nelem, bf, flags, code); };
    auto chko = [&](int code) { hipLaunchKernelGGL(dbg_check, dim3(1024), dim3(256), 0, stream, (const void*)P.out, (size_t)NTOK * 1024, 0, flags, code); };
    const size_t M1 = (size_t)NTOK * 1024, MH = (size_t)NTOK * 512;
    switch (ph) {
    case 0: chk(O_XB, M1, 1, 1); chk(O_FLOW, (size_t)NTOK * 16, 0, 2); chk(O_PB, (size_t)NTOK * 256, 1, 3); chk(O_WINT, (size_t)7168 * 1024, 1, 4); chk(O_WOUTT, (size_t)1024 * 1024, 1, 5); chk(O_WQGT, (size_t)2048 * 1024, 1, 6); chk(O_WPPT, (size_t)1024 * 256, 1, 7); break;
    case 1: chk(O_ZX, M1, 1, 8); chk(O_GY, M1, 1, 9); chk(O_ZQ, MH, 1, 10); chk(O_ZK, MH, 1, 11); chk(O_ZV, M1, 1, 12); chk(O_GR, M1, 1, 13); break;
    case 2: chk(O_XB, M1, 1, 14); break;
    case 3: chk(O_ZQ, MH, 1, 15); chk(O_UT, (size_t)1024 * 256 * 128, 1, 16); chko(17); chk(O_DLAST, (size_t)1024 * 128, 0, 18); break;
    case 4: chko(19); chk(O_SSQ, (size_t)NTOK * 64, 0, 20); break;
    case 5: chk(O_XB, M1, 1, 21); break;
    case 6: chko(22); chk(O_PP, M1, 1, 23); break;
    case 7: chko(24); chk(O_X1B, M1, 1, 25); chk(O_UB, 2 * M1, 1, 26); break;
    case 8: chk(O_QP, M1, 0, 27); chk(O_PP, M1, 1, 28); break;
    case 9: chko(29); break;
    }
}
#endif
#ifndef MULTI_LAUNCH
#define MULTI_LAUNCH 0
#endif
extern "C" void kernel_launch(void* const* d_in, const int* in_sizes, int n_in, void* d_out, int out_size, void* d_ws, size_t ws_size, hipStream_t stream) {
    static int grid = 0;
    if (grid == 0) {
        int dev = 0, cus = 0, per_cu = 0;
        hipGetDevice(&dev); hipDeviceGetAttribute(&cus, hipDeviceAttributeMultiprocessorCount, dev);
        if (hipFuncSetAttribute((const void*)mega, hipFuncAttributeMaxDynamicSharedMemorySize, LDS_BYTES) != hipSuccess) { fprintf(stderr, "hipFuncSetAttribute failed\n"); }
        hipOccupancyMaxActiveBlocksPerMultiprocessor(&per_cu, (const void*)mega, 512, LDS_BYTES);
        if (per_cu < 1) { fprintf(stderr, "occupancy query says %d\n", per_cu); per_cu = 1; }
        (void)hipGetLastError();
        grid = cus * 1;
        if (ws_size < 236 * MBY) fprintf(stderr, "workspace too small: %zu\n", ws_size);
    }
    Params P{};
    P.x = (const float*)d_in[0]; P.p = (const float*)d_in[1]; P.w_in = (const float*)d_in[2]; P.conv_w = (const float*)d_in[3]; P.conv_b = (const float*)d_in[4];
    P.lru_wr = (const float*)d_in[5]; P.lru_br = (const float*)d_in[6]; P.lru_wi = (const float*)d_in[7]; P.lru_bi = (const float*)d_in[8]; P.lru_lambda = (const float*)d_in[9];
    P.gla_wf2 = (const float*)d_in[10]; P.gla_bf = (const float*)d_in[11]; P.gla_norm_g = (const float*)d_in[12]; P.w_out = (const float*)d_in[13]; P.ln1_g = (const float*)d_in[14];
    P.ln1_b = (const float*)d_in[15]; P.peer_wq = (const float*)d_in[16]; P.peer_subkeys = (const float*)d_in[17]; P.peer_u = (const float*)d_in[18]; P.peer_v = (const float*)d_in[19];
    P.ple_gate_w = (const float*)d_in[20]; P.ple_proj_w = (const float*)d_in[21]; P.ln2_g = (const float*)d_in[22]; P.ln2_b = (const float*)d_in[23];
    P.out = (float*)d_out; P.ws = (unsigned char*)d_ws; P.pad_ = 0;
#if MULTI_LAUNCH
    for (int ph = 0; ph < 10; ++ph) {
        P.ph_lo = ph; P.ph_hi = ph + 1; P.coop = 0;
        hipLaunchKernelGGL(mega, dim3(grid), dim3(512), LDS_BYTES, stream, P);
#ifdef DBG_SCAN
        if (ph == 0) (void)hipMemsetAsync(P.ws + 240 * MBY, 0, 256, stream);
        dbg_after_phase(ph, P, stream);
#endif
    }
#ifdef DBG_SCAN
    hipLaunchKernelGGL(dbg_report, dim3(1024), dim3(256), 0, stream, P.out, (size_t)NTOK * 1024, (const int*)(P.ws + 240 * MBY));
#endif
#else
    P.ph_lo = 0; P.ph_hi = 10; P.coop = 1;
#ifdef HOST_MEMSET
    (void)hipMemsetD32Async((hipDeviceptr_t)((unsigned char*)d_ws + O_BAR), 0, 8192, stream);
#endif
    void* args[] = {&P};
    hipError_t e = hipLaunchCooperativeKernel((const void*)mega, dim3(grid), dim3(512), args, LDS_BYTES, stream);
    if (e != hipSuccess) fprintf(stderr, "cooperative launch failed: %s (grid %d)\n", hipGetErrorString(e), grid);
#endif
}
```

```cpp
#define USE_XCD_BARRIER 1
#define HOST_MEMSET 1
#define PEER2 1
#define PEER3 1
#include <hip/hip_runtime.h>
#include <hip/hip_cooperative_groups.h>
#include <cstdio>
namespace cg = cooperative_groups;
namespace pg8 {
#define PG8_LAS __attribute__((address_space(3)))
typedef unsigned short bf16_t;
typedef short bf16x8 __attribute__((ext_vector_type(8)));
typedef float f32x4 __attribute__((ext_vector_type(4)));
typedef unsigned u32x4 __attribute__((ext_vector_type(4)));
constexpr int BM = 256, BK = 64, HALF = 128, HTB = HALF * BK * 2  , STAGE_BYTES = 8 * HTB, NXCD = 8, WGM = 8;

__host__ __device__ __forceinline__ int lds_byte(int r, int c) { const int st = (r >> 4) * 2 + (c >> 5), rr = r & 15, cc = c & 31, ob = rr * 64 + cc * 2; return st * 1024 + (ob ^ (((ob >> 9) & 1) << 5)); }
__host__ __device__ __forceinline__ void stage_rc(int b, int& R, int& C) { const int st = b / 1024, sb = b % 1024, swz = sb ^ (((sb >> 9) & 1) << 5); R = (st >> 1) * 16 + swz / 64; C = (st & 1) * 32 + (swz % 64) / 2; }
__host__ __device__ __forceinline__ int perm32(int rho) { const int n = rho >> 4, i = rho & 15; return 8 * (i >> 2) + 4 * n + (i & 3); }

struct Unit { int pm, pn; };
struct Gemm { const bf16_t* A; const bf16_t* Bt; int M, N, K; };

struct StaticOrder {
    int nM, nN, nwg, G, c;
    __host__ __device__ void init(int M, int N, int G_, int c_) { nM = M / BM; nN = N / BM; nwg = nM * nN; G = G_; c = c_; }
    __host__ __device__ bool next(int i, Unit& u) const {
        const long L = (long)i * G + c; if (L >= nwg) return false;
        int wgid = (int)L; { const int q = nwg / NXCD, r = nwg % NXCD, xcd = wgid % NXCD, off = wgid / NXCD; wgid = (xcd < r ? xcd * (q + 1) : r * (q + 1) + (xcd - r) * q) + off; }
        const int nig = WGM * nN, gid = wgid / nig, fm = gid * WGM, gsz = (nM - fm) < WGM ? (nM - fm) : WGM;
        u.pm = fm + ((wgid % nig) % gsz); u.pn = (wgid % nig) / gsz; return true;
    }
    __device__ __forceinline__ void a_ready(const Unit&) const {}
    __device__ __forceinline__ void done(const Unit&) const {}
};
struct CountedOrder : StaticOrder {
    const unsigned* ready; unsigned need; unsigned* tmo;
    __device__ __forceinline__ void a_ready(const Unit& u) const {
        if (threadIdx.x < 64) {
            const unsigned long long t0 = __builtin_amdgcn_s_memrealtime(); unsigned polls = 0;
            while ((unsigned)__builtin_amdgcn_readfirstlane(__hip_atomic_load(ready + 64 * u.pm, __ATOMIC_RELAXED, __HIP_MEMORY_SCOPE_AGENT)) < need) {
                if ((++polls & 255u) == 0u && __builtin_amdgcn_readfirstlane(__hip_atomic_load(tmo, __ATOMIC_RELAXED, __HIP_MEMORY_SCOPE_AGENT)) != 0u) break;
                if (__builtin_amdgcn_s_memrealtime() - t0 > 2000000ull) {
                    if (threadIdx.x == 0) { unsigned expect = 0u; __hip_atomic_compare_exchange_strong(tmo + 1, &expect, 0x600u | (unsigned)(u.pm & 0xff), __ATOMIC_RELAXED, __ATOMIC_RELAXED, __HIP_MEMORY_SCOPE_AGENT); __hip_atomic_store(tmo, 1u, __ATOMIC_RELAXED, __HIP_MEMORY_SCOPE_AGENT); }
                    break; }
                __builtin_amdgcn_s_sleep(2); }
            __builtin_amdgcn_fence(__ATOMIC_ACQUIRE, "agent");
            asm volatile("s_waitcnt vmcnt(0)" ::: "memory");
        }
#if !defined(BROKEN_HOOK_NO_BARRIER)
        asm volatile("" ::: "memory"); __builtin_amdgcn_s_barrier(); asm volatile("" ::: "memory");
#endif
    }
};

__device__ __forceinline__ unsigned cvt_pk_bf16(float lo, float hi) { unsigned r; asm volatile("v_cvt_pk_bf16_f32 %0, %1, %2" : "=v"(r) : "v"(lo), "v"(hi)); return r; }
typedef float f32x2 __attribute__((ext_vector_type(2)));
__device__ __forceinline__ f32x2 gelu_pk(f32x2 v) {
    const f32x2 av = __builtin_elementwise_abs(v), d = av * 0.2316418882f + 1.0f;
    f32x2 t; t.x = __builtin_amdgcn_rcpf(d.x); t.y = __builtin_amdgcn_rcpf(d.y);
    f32x2 q = t * 0.5307027145f + (-0.7265760135f); q = q * t + 0.7107068705f; q = q * t + (-0.142248368f); q = q * t + 0.127414796f; q = q * t;
    const f32x2 s = (v * v) * (-0.72134752044f);
    f32x2 e; e.x = __builtin_amdgcn_exp2f(s.x); e.y = __builtin_amdgcn_exp2f(s.y);
    const f32x2 m = v * (q * e), r = v - m;
    f32x2 o; o.x = v.x < 0.f ? m.x : r.x; o.y = v.y < 0.f ? m.y : r.y; return o;
}
template <class Epi, class Sched, bool STAMP = false>
__device__ __forceinline__ void gemm_phase(PG8_LAS unsigned char* lds, const Gemm g, const Sched& S, const Epi& E, unsigned long long* stamps) {
    const int tid = threadIdx.x, wid = __builtin_amdgcn_readfirstlane(tid >> 6), lane = tid & 63, wr = wid >> 2, wc = wid & 3, fr = lane & 15, fq = lane >> 4;
    const int K = g.K, nt = K / BK;
    int ts_lo = 0, ts_hi = 0, nts = 0; const unsigned long long rt_entry = STAMP ? (unsigned long long)wall_clock64() : 0ull;
#define PG8_STAMP() do { if (STAMP && wid == 0 && nts < 64) { const unsigned long long _c = (unsigned long long)clock64(); \
        ts_lo = (lane == nts) ? (int)(unsigned)_c : ts_lo; ts_hi = (lane == nts) ? (int)(unsigned)(_c >> 32) : ts_hi; ++nts; } } while (0)
    PG8_STAMP();
    unsigned voffA[2], voffB[2];
#pragma unroll
    for (int i = 0; i < 2; ++i) { int R, C; stage_rc(tid * 16 + i * 8192, R, C); const int Rb = Epi::PERM ? ((R & ~31) + perm32(R & 31)) : R;
        voffA[i] = (unsigned)(R * K + C) * 2u; voffB[i] = (unsigned)(Rb * K + C) * 2u; }
    const size_t kstep = (size_t)(BK * 2);
    const size_t hstep = (size_t)HALF * K * 2;
    const size_t tstep = 2 * hstep;
    const unsigned ldsw = (unsigned)wid * 1024u;
    const int aoff = lds_byte(wr * 64 + fr, fq * 8), boff = lds_byte(wc * 32 + fr, fq * 8);
#define PG8_SA(b, h) (((b) * 2 + (h)) * HTB)
#define PG8_SB(b, h) ((4 + (b) * 2 + (h)) * HTB)
#define PG8_STAGE(bufoff, gbase, voff) do { _Pragma("unroll") for (int _i = 0; _i < 2; ++_i) \
        __builtin_amdgcn_global_load_lds((const unsigned*)((const char*)(gbase) + (voff)[_i]), (PG8_LAS unsigned*)(lds + (bufoff) + ldsw + _i * 8192), 16, 0, 0); } while (0)
#define PG8_LDA(dst, b, h) do { _Pragma("unroll") for (int m = 0; m < 4; ++m) _Pragma("unroll") for (int k = 0; k < 2; ++k) dst[m][k] = *(const PG8_LAS bf16x8*)(lds + PG8_SA(b, h) + aoff + m * 2048 + k * 1024); } while (0)
#define PG8_LDB(dst, b, h) do { _Pragma("unroll") for (int n = 0; n < 2; ++n) _Pragma("unroll") for (int k = 0; k < 2; ++k) dst[n][k] = *(const PG8_LAS bf16x8*)(lds + PG8_SB(b, h) + boff + n * 2048 + k * 1024); } while (0)
#define PG8_MMA(ai, bj, At, Bt) do { __builtin_amdgcn_s_setprio(1); _Pragma("unroll") for (int m = 0; m < 4; ++m) _Pragma("unroll") for (int n = 0; n < 2; ++n) _Pragma("unroll") for (int k = 0; k < 2; ++k) \
        acc[ai][bj][m][n] = __builtin_amdgcn_mfma_f32_16x16x32_bf16(Bt[n][k], At[m][k], acc[ai][bj][m][n], 0, 0, 0); __builtin_amdgcn_s_setprio(0); } while (0)
#define PG8_WAIT_V(n) asm volatile("s_waitcnt vmcnt(" #n ")" ::: "memory")
#define PG8_WAIT_L(n) asm volatile("s_waitcnt lgkmcnt(" #n ")" ::: "memory")
#define PG8_BAR __builtin_amdgcn_s_barrier()
#define PG8_SCHED __builtin_amdgcn_sched_barrier(0)
    Unit cur, nxt; int ui = 0;
    if (!S.next(0, cur)) return;
    f32x4 acc[2][2][4][2];
#pragma unroll
    for (int a = 0; a < 2; ++a)
#pragma unroll
        for (int b = 0; b < 2; ++b)
#pragma unroll
            for (int m = 0; m < 4; ++m)
#pragma unroll
                for (int n = 0; n < 2; ++n) acc[a][b][m][n] = (f32x4){0.f, 0.f, 0.f, 0.f};
    bf16x8 At[4][2], B0[2][2], B1[2][2];
    const char* cA = (const char*)g.A + (size_t)cur.pm * tstep; const char* cB = (const char*)g.Bt + (size_t)cur.pn * tstep;
    S.a_ready(cur);
    PG8_STAGE(PG8_SB(0, 0), cB, voffB); PG8_STAGE(PG8_SA(0, 0), cA, voffA); PG8_STAGE(PG8_SB(0, 1), cB + hstep, voffB); PG8_STAGE(PG8_SA(0, 1), cA + hstep, voffA);
    if (wr == 1) PG8_BAR;
    PG8_WAIT_V(4); PG8_BAR;
    PG8_STAGE(PG8_SB(1, 0), cB + kstep, voffB); PG8_STAGE(PG8_SA(1, 0), cA + kstep, voffA); PG8_STAGE(PG8_SB(1, 1), cB + hstep + kstep, voffB);
    PG8_WAIT_V(6); PG8_BAR;
    PG8_STAMP();
    for (;;) {
        const bool has_next = S.next(ui + 1, nxt);
        const char* nA = has_next ? (const char*)g.A + (size_t)nxt.pm * tstep : cA; const char* nB = has_next ? (const char*)g.Bt + (size_t)nxt.pn * tstep : cB;
        for (int t = 0; t < nt; t += 2) {
            const bool last = (t == nt - 2);
            const char* a1 = cA + (size_t)(t + 1) * kstep;
            const char* a2 = last ? nA : cA + (size_t)(t + 2) * kstep; const char* b2 = last ? nB : cB + (size_t)(t + 2) * kstep;
            const char* a3 = a2 + kstep; const char* b3 = b2 + kstep;
            if (last && has_next) S.a_ready(nxt);
            PG8_LDB(B0, 0, 0); PG8_SCHED; PG8_LDA(At, 0, 0); PG8_STAGE(PG8_SA(1, 1), a1 + hstep, voffA);
            PG8_WAIT_L(8); PG8_BAR; PG8_WAIT_L(0); PG8_MMA(0, 0, At, B0); PG8_BAR; PG8_SCHED;
            PG8_LDB(B1, 0, 1); PG8_STAGE(PG8_SB(0, 0), b2, voffB);
            PG8_BAR; PG8_WAIT_L(0); PG8_MMA(0, 1, At, B1); PG8_BAR;
            PG8_LDA(At, 0, 1); PG8_STAGE(PG8_SA(0, 0), a2, voffA);
            PG8_BAR; PG8_WAIT_L(0); PG8_MMA(1, 0, At, B0); PG8_BAR; PG8_SCHED;
            PG8_STAGE(PG8_SB(0, 1), b2 + hstep, voffB);
            PG8_WAIT_V(6); PG8_BAR; PG8_MMA(1, 1, At, B1); PG8_BAR;
            PG8_LDB(B0, 1, 0); PG8_SCHED; PG8_LDA(At, 1, 0); PG8_STAGE(PG8_SA(0, 1), a2 + hstep, voffA);
            PG8_WAIT_L(8); PG8_BAR; PG8_WAIT_L(0); PG8_MMA(0, 0, At, B0); PG8_BAR; PG8_SCHED;
            PG8_LDB(B1, 1, 1); PG8_STAGE(PG8_SB(1, 0), b3, voffB);
            PG8_BAR; PG8_WAIT_L(0); PG8_MMA(0, 1, At, B1); PG8_BAR;
            PG8_LDA(At, 1, 1); PG8_STAGE(PG8_SA(1, 0), a3, voffA);
            PG8_BAR; PG8_WAIT_L(0); PG8_MMA(1, 0, At, B0); PG8_BAR; PG8_SCHED;
            PG8_STAGE(PG8_SB(1, 1), b3 + hstep, voffB);
            PG8_WAIT_V(6); PG8_BAR; PG8_MMA(1, 1, At, B1); PG8_BAR;
        }
        PG8_STAMP();
        if constexpr (!Epi::AFTER_DRAIN) { E(acc, cur, wr, wc, fr, fq); S.done(cur); }
        PG8_STAMP();
        if (!has_next) break;
#pragma unroll
        for (int a = 0; a < 2; ++a)
#pragma unroll
            for (int b = 0; b < 2; ++b)
#pragma unroll
                for (int m = 0; m < 4; ++m)
#pragma unroll
                    for (int n = 0; n < 2; ++n) acc[a][b][m][n] = (f32x4){0.f, 0.f, 0.f, 0.f};
        cur = nxt; cA = nA; cB = nB; ++ui;
    }
    PG8_WAIT_V(0);
    if (wr == 0) PG8_BAR;
    PG8_BAR;
    if constexpr (Epi::AFTER_DRAIN) { E.fused(acc, cur, wr, wc, fr, fq, lds, wid, lane); S.done(cur); }
    PG8_STAMP();
    if (STAMP && wid == 0) { stamps[lane] = lane < nts ? (((unsigned long long)(unsigned)ts_hi << 32) | (unsigned)ts_lo) : 0ull;
        if (lane == 62) stamps[62] = rt_entry; if (lane == 63) stamps[63] = (unsigned long long)wall_clock64(); }
#undef PG8_STAMP
#undef PG8_SA
#undef PG8_SB
#undef PG8_STAGE
#undef PG8_LDA
#undef PG8_LDB
#undef PG8_MMA
#undef PG8_WAIT_V
#undef PG8_WAIT_L
#undef PG8_BAR
#undef PG8_SCHED
}
}

using pg8::bf16_t; using pg8::bf16x8; using pg8::f32x4; using pg8::u32x4; using pg8::f32x2; using pg8::Unit;
typedef __bf16 bf16x2_t __attribute__((ext_vector_type(2)));
__device__ __forceinline__ float dpp_xor1(float v) { return __int_as_float(__builtin_amdgcn_update_dpp(0, __float_as_int(v), 0xB1, 0xF, 0xF, true)); }
__device__ __forceinline__ float dpp_xor2(float v) { return __int_as_float(__builtin_amdgcn_update_dpp(0, __float_as_int(v), 0x4E, 0xF, 0xF, true)); }
__device__ __forceinline__ float dpp_xor4(float v) { const int m = __builtin_amdgcn_update_dpp(0, __float_as_int(v), 0x141, 0xF, 0xF, true); return __int_as_float(__builtin_amdgcn_update_dpp(0, m, 0x1B, 0xF, 0xF, true)); }
__device__ __forceinline__ float dpp_xor8(float v) { return __int_as_float(__builtin_amdgcn_update_dpp(0, __float_as_int(v), 0x128, 0xF, 0xF, true)); }
typedef unsigned u32x2 __attribute__((ext_vector_type(2)));

constexpr int NTOK = 16384, DM = 1024, SEQL = 2048;
constexpr int INW = 7184;
constexpr size_t MBY = (size_t)1 << 20;
constexpr size_t O_ZX = 0, O_GY = 32 * MBY, O_ZQ = 64 * MBY, O_ZK = 80 * MBY, O_ZV = 96 * MBY, O_GR = 128 * MBY, O_XB = 160 * MBY,
                 O_WINT = 192 * MBY, O_WOUTT = 228 * MBY, O_WQGT = 230 * MBY, O_WPPT = 234 * MBY, O_PB = 235 * MBY, O_FLOW = 243 * MBY,
                 O_DLAST = 244 * MBY, O_SSQ = 245 * MBY;
constexpr size_t O_UT = 0, O_UB = 192 * MBY  , O_VB = 208 * MBY, O_X1B = 64 * MBY, O_PP = 96 * MBY, O_QP = 128 * MBY;
constexpr int LDS_BYTES = 160 * 1024;
constexpr size_t O_RIDX = 0, O_RW = 8 * MBY, O_RG = 16 * MBY  , O_FF = 128 * MBY, O_PART = 128 * MBY  ;
constexpr float DN_ALPHA = 1.189207115002721f;

struct Params {
    const float* x; const float* p; const float* w_in; const float* conv_w; const float* conv_b; const float* lru_wr; const float* lru_br;
    const float* lru_wi; const float* lru_bi; const float* lru_lambda; const float* gla_wf2; const float* gla_bf; const float* gla_norm_g;
    const float* w_out; const float* ln1_g; const float* ln1_b; const float* peer_wq; const float* peer_subkeys; const float* peer_u;
    const float* peer_v; const float* ple_gate_w; const float* ple_proj_w; const float* ln2_g; const float* ln2_b;
    float* out; unsigned char* ws; int ph_lo, ph_hi, coop, pad_;
};

__device__ __forceinline__ bf16_t f2bf(float f) { unsigned u = __float_as_uint(f); u += 0x7FFFu + ((u >> 16) & 1u); return (bf16_t)(u >> 16); }
__device__ __forceinline__ float bf2f(bf16_t b) { return __uint_as_float(((unsigned)b) << 16); }
__device__ __forceinline__ float bflo(unsigned w) { return __uint_as_float(w << 16); }
__device__ __forceinline__ float bfhi(unsigned w) { return __uint_as_float(w & 0xffff0000u); }
__device__ __forceinline__ unsigned pk2(float lo, float hi) { typedef float f2_t __attribute__((ext_vector_type(2))); f2_t v = {lo, hi}; return __builtin_bit_cast(unsigned, __builtin_convertvector(v, bf16x2_t)); }
__device__ __forceinline__ float sigmoidf_(float x) { return __builtin_amdgcn_rcpf(1.0f + __expf(-x)); }
__device__ __forceinline__ f32x4 mfma16(bf16x8 a, bf16x8 b, f32x4 c) { return __builtin_amdgcn_mfma_f32_16x16x32_bf16(a, b, c, 0, 0, 0); }
__device__ __forceinline__ float dot2bf(unsigned a, unsigned b, float c) { return __builtin_amdgcn_fdot2_f32_bf16(__builtin_bit_cast(bf16x2_t, a), __builtin_bit_cast(bf16x2_t, b), c, false); }
__device__ __forceinline__ float wave_sum(float v) {
#pragma unroll
    for (int o = 32; o >= 1; o >>= 1) v += __shfl_xor(v, o);
    return v;
}

struct EpiZ {
    static constexpr bool PERM = true, AFTER_DRAIN = false;
    unsigned char* ws;
    __device__ __forceinline__ void operator()(const f32x4 (&acc)[2][2][4][2], const Unit& u, int wr, int wc, int fr, int fq) const {
        const int pn = u.pn; const int row0 = u.pm * 256 + wr * 64 + fr;
        const bool pairA = (pn >= 4 && pn < 12), pairB = (pn >= 20);
        if (pairA || pairB) {
            const int j = pairA ? pn - 4 : pn - 20;
            bf16_t* base = (bf16_t*)(ws + (pairA ? O_GY : O_GR));
            const int col = j * 128 + wc * 32 + 8 * fq;
#pragma unroll
            for (int ai = 0; ai < 2; ++ai)
#pragma unroll
                for (int m = 0; m < 4; ++m) {
                    const f32x4 a0 = acc[ai][0][m][0], a1 = acc[ai][0][m][1], g0 = acc[ai][1][m][0], g1 = acc[ai][1][m][1];
                    float o[8];
                    if (pairA) {
                        f32x2 e0 = pg8::gelu_pk((f32x2){a0[0], a0[1]}), e1 = pg8::gelu_pk((f32x2){a0[2], a0[3]}), e2 = pg8::gelu_pk((f32x2){a1[0], a1[1]}), e3 = pg8::gelu_pk((f32x2){a1[2], a1[3]});
                        o[0] = e0.x; o[1] = e0.y; o[2] = e1.x; o[3] = e1.y; o[4] = e2.x; o[5] = e2.y; o[6] = e3.x; o[7] = e3.y;
                    } else {
#pragma unroll
                        for (int q = 0; q < 4; ++q) { o[q] = a0[q] * sigmoidf_(a0[q]); o[4 + q] = a1[q] * sigmoidf_(a1[q]); }
                    }
#pragma unroll
                    for (int q = 0; q < 4; ++q) { o[q] *= sigmoidf_(g0[q]); o[4 + q] *= sigmoidf_(g1[q]); }
                    u32x4 w; w.x = pk2(o[0], o[1]); w.y = pk2(o[2], o[3]); w.z = pk2(o[4], o[5]); w.w = pk2(o[6], o[7]);
                    *(u32x4*)(base + (size_t)(row0 + ai * 128 + m * 16) * 1024 + col) = w;
                }
        } else {
            bf16_t* base; int ldc, colt;
            if (pn < 4) { base = (bf16_t*)(ws + O_ZX); ldc = 1024; colt = pn * 256; }
            else if (pn < 14) { base = (bf16_t*)(ws + O_ZQ); ldc = 512; colt = (pn - 12) * 256; }
            else if (pn < 16) { base = (bf16_t*)(ws + O_ZK); ldc = 512; colt = (pn - 14) * 256; }
            else { base = (bf16_t*)(ws + O_ZV); ldc = 1024; colt = (pn - 16) * 256; }
            const int col0 = colt + wc * 32 + 8 * fq;
#pragma unroll
            for (int ai = 0; ai < 2; ++ai)
#pragma unroll
                for (int m = 0; m < 4; ++m) {
                    bf16_t* rowp = base + (size_t)(row0 + ai * 128 + m * 16) * ldc + col0;
#pragma unroll
                    for (int bj = 0; bj < 2; ++bj) {
                        const f32x4 v0 = acc[ai][bj][m][0], v1 = acc[ai][bj][m][1];
                        u32x4 w; w.x = pk2(v0[0], v0[1]); w.y = pk2(v0[2], v0[3]); w.z = pk2(v1[0], v1[1]); w.w = pk2(v1[2], v1[3]);
                        *(u32x4*)(rowp + bj * 128) = w;
                    }
                }
        }
    }
};
struct EpiPP {
    static constexpr bool PERM = true, AFTER_DRAIN = false;
    bf16_t* O;
    __device__ __forceinline__ void operator()(const f32x4 (&acc)[2][2][4][2], const Unit& u, int wr, int wc, int fr, int fq) const {
        const int row0 = u.pm * 256 + wr * 64 + fr, col0 = u.pn * 256 + wc * 32 + 8 * fq;
#pragma unroll
        for (int ai = 0; ai < 2; ++ai)
#pragma unroll
            for (int m = 0; m < 4; ++m) {
                bf16_t* rowp = O + (size_t)(row0 + ai * 128 + m * 16) * 1024 + col0;
#pragma unroll
                for (int bj = 0; bj < 2; ++bj) {
                    const f32x4 v0 = acc[ai][bj][m][0], v1 = acc[ai][bj][m][1];
                    u32x4 w; w.x = pk2(v0[0], v0[1]); w.y = pk2(v0[2], v0[3]); w.z = pk2(v1[0], v1[1]); w.w = pk2(v1[2], v1[3]);
                    *(u32x4*)(rowp + bj * 128) = w;
                }
            }
    }
};
struct EpiY1 {
    static constexpr bool PERM = false, AFTER_DRAIN = false;
    const float* X; float* Y;
    __device__ __forceinline__ void operator()(const f32x4 (&acc)[2][2][4][2], const Unit& u, int wr, int wc, int fr, int fq) const {
        const int row0 = u.pm * 256 + wr * 64 + fr, col0 = u.pn * 256 + wc * 32 + 4 * fq;
#pragma unroll
        for (int ai = 0; ai < 2; ++ai)
#pragma unroll
            for (int m = 0; m < 4; ++m) {
                const size_t ro = (size_t)(row0 + ai * 128 + m * 16) * 1024 + col0;
#pragma unroll
                for (int bj = 0; bj < 2; ++bj)
#pragma unroll
                    for (int n = 0; n < 2; ++n) {
                        const f32x4 xv = *(const f32x4*)(X + ro + bj * 128 + n * 16);
                        *(f32x4*)(Y + ro + bj * 128 + n * 16) = xv * DN_ALPHA + acc[ai][bj][m][n];
                    }
            }
    }
};
struct EpiQG {
    static constexpr bool PERM = false, AFTER_DRAIN = false;
    float* QP; bf16_t* PP;
    __device__ __forceinline__ void operator()(const f32x4 (&acc)[2][2][4][2], const Unit& u, int wr, int wc, int fr, int fq) const {
        const int row0 = u.pm * 256 + wr * 64 + fr; const int pn = u.pn;
        const int col0 = (pn & 3) * 256 + wc * 32 + 4 * fq;
#pragma unroll
        for (int ai = 0; ai < 2; ++ai)
#pragma unroll
            for (int m = 0; m < 4; ++m) {
                const size_t ro = (size_t)(row0 + ai * 128 + m * 16) * 1024 + col0;
#pragma unroll
                for (int bj = 0; bj < 2; ++bj)
#pragma unroll
                    for (int n = 0; n < 2; ++n) {
                        const f32x4 a = acc[ai][bj][m][n];
                        if (pn < 4) { *(f32x4*)(QP + ro + bj * 128 + n * 16) = a; }
                        else {
                            u32x2* pp = (u32x2*)(PP + ro + bj * 128 + n * 16);
                            const u32x2 w = *pp;
                            u32x2 o; o.x = pk2(sigmoidf_(a[0]) * bflo(w.x), sigmoidf_(a[1]) * bfhi(w.x)); o.y = pk2(sigmoidf_(a[2]) * bflo(w.y), sigmoidf_(a[3]) * bfhi(w.y));
                            *pp = o;
                        }
                    }
            }
    }
};

__device__ __forceinline__ int win_src_col(int n) {
    if (n < 1024) return n;
    if (n < 3072) { const int j = (n - 1024) >> 8, r = (n - 1024) & 255; return r < 128 ? 1024 + j * 128 + r : 5136 + j * 128 + (r - 128); }
    if (n < 3584) return 2048 + (n - 3072);
    if (n < 4096) return 2560 + (n - 3584);
    if (n < 5120) return 3072 + (n - 4096);
    { const int j = (n - 5120) >> 8, r = (n - 5120) & 255; return r < 128 ? 4096 + j * 128 + r : 6160 + j * 128 + (r - 128); }
}
__device__ void phase_prep(const Params& P, unsigned char* lds) {
    const int tid = threadIdx.x, wid = tid >> 6, lane = tid & 63;
    bf16_t* wf = (bf16_t*)lds;
    float* ts = (float*)(lds + 34816);
    for (int i = tid; i < 16 * 1024; i += 512) { const int r = i & 15, k = i >> 4; wf[r * 1032 + k] = f2bf(P.w_in[(size_t)k * INW + 5120 + r]); }
    __syncthreads();
    bf16_t* xb = (bf16_t*)(P.ws + O_XB); float* flow = (float*)(P.ws + O_FLOW);
    if (wid < 4) {
        for (int tile = wid * gridDim.x + blockIdx.x; tile < 1024; tile += 4 * gridDim.x) {
            const int c = lane & 15, kq = lane >> 4; const int row = tile * 16 + c;
            f32x4 acc = {0.f, 0.f, 0.f, 0.f};
            const float* xr = P.x + (size_t)row * 1024 + kq * 8;
#pragma unroll 4
            for (int ks = 0; ks < 32; ++ks) {
                const f32x4 a0 = *(const f32x4*)(xr + ks * 32), a1 = *(const f32x4*)(xr + ks * 32 + 4);
                u32x4 w; w.x = pk2(a0[0], a0[1]); w.y = pk2(a0[2], a0[3]); w.z = pk2(a1[0], a1[1]); w.w = pk2(a1[2], a1[3]);
                *(u32x4*)(xb + (size_t)row * 1024 + ks * 32 + kq * 8) = w;
                const bf16x8 bfr = *(const bf16x8*)(wf + c * 1032 + ks * 32 + kq * 8);
                acc = mfma16(__builtin_bit_cast(bf16x8, w), bfr, acc);
            }
#pragma unroll
            for (int i = 0; i < 4; ++i) flow[(size_t)(tile * 16 + kq * 4 + i) * 16 + c] = acc[i];
        }
    } else {
        bf16_t* pb = (bf16_t*)(P.ws + O_PB);
        const int nthr = 4 * 64 * gridDim.x;
        for (int i = ((wid - 4) * gridDim.x + blockIdx.x) * 64 + lane; i < NTOK * 256 / 4; i += nthr) {
            const f32x4 a = *(const f32x4*)(P.p + (size_t)i * 4);
            u32x2 w; w.x = pk2(a[0], a[1]); w.y = pk2(a[2], a[3]);
            *(u32x2*)(pb + (size_t)i * 4) = w;
        }
    }
    for (int job = blockIdx.x; job < 2624; job += gridDim.x) {
        const float* W; bf16_t* O; int ldw, Kd, tn, tk, mode;
        if (job < 1792) { W = P.w_in; O = (bf16_t*)(P.ws + O_WINT); ldw = INW; Kd = 1024; tn = job >> 4; tk = job & 15; mode = 0; }
        else if (job < 2048) { const int j = job - 1792; W = P.w_out; O = (bf16_t*)(P.ws + O_WOUTT); ldw = 1024; Kd = 1024; tn = j >> 4; tk = j & 15; mode = 1; }
        else if (job < 2560) { const int j = job - 2048; tn = j >> 4; tk = j & 15; mode = 2; ldw = 1024; Kd = 1024; O = (bf16_t*)(P.ws + O_WQGT); W = tn < 16 ? P.peer_wq : P.ple_gate_w; }
        else { const int j = job - 2560; W = P.ple_proj_w; O = (bf16_t*)(P.ws + O_WPPT); ldw = 1024; Kd = 256; tn = j >> 2; tk = j & 3; mode = 1; }
        const int n0 = tn * 64, k0 = tk * 64;
        int sc0 = n0; if (mode == 0) sc0 = win_src_col(n0); if (mode == 2) sc0 = n0 & 1023;
        {
            const int kk = tid >> 4, c4 = (tid & 15) * 4;
#pragma unroll
            for (int i = 0; i < 2; ++i) {
                const f32x4 v = *(const f32x4*)(W + (size_t)(k0 + kk + 32 * i) * ldw + sc0 + c4);
                float* d = ts + (kk + 32 * i) * 65 + c4; d[0] = v[0]; d[1] = v[1]; d[2] = v[2]; d[3] = v[3];
            }
        }
        __syncthreads();
        {
            const int n = tid >> 3, kc = (tid & 7) * 8;
            float v[8];
#pragma unroll
            for (int j = 0; j < 8; ++j) v[j] = ts[(kc + j) * 65 + n];
            u32x4 w; w.x = pk2(v[0], v[1]); w.y = pk2(v[2], v[3]); w.z = pk2(v[4], v[5]); w.w = pk2(v[6], v[7]);
            *(u32x4*)(O + (size_t)(n0 + n) * Kd + k0 + kc) = w;
        }
        __syncthreads();
    }
}

__device__ void phase_lru(const Params& P, unsigned char* lds) {
    const int tid = threadIdx.x, wid = __builtin_amdgcn_readfirstlane(tid >> 6), lane = tid & 63, c = lane & 15, kq = lane >> 4;
    bf16_t* u_s = (bf16_t*)lds;
    float* u32_s = (float*)(lds + 34816);
    float* a_s = (float*)(lds + 51712);
    float* i_s = (float*)(lds + 68608);
    float* segA = (float*)(lds + 85504);
    float* segH = (float*)(lds + 87552);
    float* carry = (float*)(lds + 89600);
    const bf16_t* zx = (const bf16_t*)(P.ws + O_ZX); const bf16_t* gy = (const bf16_t*)(P.ws + O_GY); bf16_t* yag = (bf16_t*)(P.ws + O_XB);
    for (int item = blockIdx.x; item < 256; item += gridDim.x) {
        const int grp_ = (item & 7) * 8 + (item >> 5), qd = (item >> 3) & 3, b = grp_ >> 3, blk = grp_ & 7;
        const int ch0 = blk * 128, d0 = ch0 + qd * 32;
        bf16_t* wB = (bf16_t*)(lds + 90112);
        for (int i = tid; i < 2 * 128 * 32; i += 512) {
            const int mat = i >> 12, cc = (i >> 5) & 127, dd = i & 31;
            wB[(mat * 32 + dd) * 136 + cc] = f2bf(((mat ? P.lru_wi : P.lru_wr) + (size_t)blk * 128 * 128)[cc * 128 + qd * 32 + dd]);
        }
        float br[2], bi[2], sp[2];
#pragma unroll
        for (int nt = 0; nt < 2; ++nt) {
            const int dch = d0 + nt * 16 + c;
            br[nt] = P.lru_br[dch]; bi[nt] = P.lru_bi[dch];
            const float lam = P.lru_lambda[dch];
            const float spl = (lam > 0.f ? 0.f : -lam) + log1pf(__expf(-fabsf(lam)));
            sp[nt] = -8.0f * spl;
        }
        const int cg8 = tid & 15, tgrp = tid >> 4;
        float cw[4][8], cb[8];
#pragma unroll
        for (int j = 0; j < 4; ++j)
#pragma unroll
            for (int q = 0; q < 8; ++q) cw[j][q] = P.conv_w[j * 1024 + ch0 + cg8 * 8 + q];
#pragma unroll
        for (int q = 0; q < 8; ++q) cb[q] = P.conv_b[ch0 + cg8 * 8 + q];
        if (tid < 32) carry[tid] = 0.f;
        u32x4 rows[7], rowsN[7];
#pragma unroll
        for (int r = 0; r < 7; ++r) {
            const int tt = tgrp * 4 - 3 + r;
            if (tt >= 0) rows[r] = *(const u32x4*)(zx + ((size_t)b * SEQL + tt) * 1024 + ch0 + cg8 * 8);
            else rows[r] = (u32x4){0u, 0u, 0u, 0u};
        }
#pragma unroll 1
        for (int tile = 0; tile < 16; ++tile) {
            const int t0 = tile * 128;
            {
#pragma unroll
                for (int i = 0; i < 4; ++i) {
                    float o[8];
#pragma unroll
                    for (int q = 0; q < 8; ++q) o[q] = cb[q];
#pragma unroll
                    for (int j = 0; j < 4; ++j) {
                        const u32x4 rw = rows[i + j];
                        o[0] += cw[j][0] * bflo(rw.x); o[1] += cw[j][1] * bfhi(rw.x); o[2] += cw[j][2] * bflo(rw.y); o[3] += cw[j][3] * bfhi(rw.y);
                        o[4] += cw[j][4] * bflo(rw.z); o[5] += cw[j][5] * bfhi(rw.z); o[6] += cw[j][6] * bflo(rw.w); o[7] += cw[j][7] * bfhi(rw.w);
                    }
                    const int t = tgrp * 4 + i;
                    u32x4 w; w.x = pk2(o[0], o[1]); w.y = pk2(o[2], o[3]); w.z = pk2(o[4], o[5]); w.w = pk2(o[6], o[7]);
                    *(u32x4*)(u_s + t * 136 + cg8 * 8) = w;
                    if ((cg8 >> 2) == qd) {
#pragma unroll
                        for (int q = 0; q < 8; ++q) u32_s[t * 33 + (cg8 & 3) * 8 + q] = o[q];
                    }
                }
            }
            __syncthreads();
            f32x4 cvs[4];
            {
                const size_t cbase = ((size_t)item * 16 + tile) * 2048;
#pragma unroll
                for (int k = 0; k < 4; ++k) { const size_t ci = cbase + k * 512 + tid; cvs[k] = __builtin_nontemporal_load((const f32x4*)(ci < (size_t)NTOK * 256 ? P.peer_u + ci * 4 : P.peer_v + (ci - (size_t)NTOK * 256) * 4)); }
            }
            bf16_t gyv[8];
            {
                const int tn = (tile + 1 < 16 ? tile + 1 : 15) * 128;
#pragma unroll
                for (int r = 0; r < 7; ++r) rowsN[r] = *(const u32x4*)(zx + ((size_t)b * SEQL + tn + tgrp * 4 - 3 + r) * 1024 + ch0 + cg8 * 8);
                const int cs_ = tid & 31, seg_ = tid >> 5;
#pragma unroll
                for (int jq = 0; jq < 8; ++jq) gyv[jq] = gy[((size_t)b * SEQL + t0 + seg_ * 8 + jq) * 1024 + d0 + cs_];
            }
            {
                f32x4 accR[2], accI[2];
#pragma unroll
                for (int nt = 0; nt < 2; ++nt) { accR[nt] = (f32x4){0.f, 0.f, 0.f, 0.f}; accI[nt] = (f32x4){0.f, 0.f, 0.f, 0.f}; }
#pragma unroll
                for (int ks = 0; ks < 4; ++ks) {
                    const bf16x8 af = *(const bf16x8*)(u_s + (wid * 16 + c) * 136 + ks * 32 + kq * 8);
#pragma unroll
                    for (int nt = 0; nt < 2; ++nt) {
                        accR[nt] = mfma16(af, *(const bf16x8*)(wB + (nt * 16 + c) * 136 + ks * 32 + kq * 8), accR[nt]);
                        accI[nt] = mfma16(af, *(const bf16x8*)(wB + (32 + nt * 16 + c) * 136 + ks * 32 + kq * 8), accI[nt]);
                    }
                }
#pragma unroll
                for (int nt = 0; nt < 2; ++nt)
#pragma unroll
                    for (int i = 0; i < 4; ++i) {
                        const int t = wid * 16 + kq * 4 + i, dl = nt * 16 + c;
                        const float r = sigmoidf_(accR[nt][i] + br[nt]), ig = sigmoidf_(accI[nt][i] + bi[nt]);
                        const float log_a = sp[nt] * r;
                        const float a = __expf(log_a);
                        const float mult = __builtin_amdgcn_sqrtf(fmaf(-a, a, 1.0f));
                        a_s[t * 33 + dl] = a; i_s[t * 33 + dl] = mult * ig * u32_s[t * 33 + dl];
                    }
            }
            __syncthreads();
            {
                const int cs = tid & 31, seg = tid >> 5;
                float av[8], iv[8];
#pragma unroll
                for (int j = 0; j < 8; ++j) { av[j] = a_s[(seg * 8 + j) * 33 + cs]; iv[j] = i_s[(seg * 8 + j) * 33 + cs]; }
                float A = 1.f, H = 0.f;
#pragma unroll
                for (int j = 0; j < 8; ++j) { H = av[j] * H + iv[j]; A *= av[j]; }
                segA[seg * 32 + cs] = A; segH[seg * 32 + cs] = H;
                __syncthreads();
                float h = carry[cs];
                for (int s = 0; s < seg; ++s) h = segA[s * 32 + cs] * h + segH[s * 32 + cs];
#pragma unroll
                for (int j = 0; j < 8; ++j) {
                    h = av[j] * h + iv[j];
                    const size_t gi = ((size_t)b * SEQL + t0 + seg * 8 + j) * 1024 + d0 + cs;
                    yag[gi] = f2bf(h * bf2f(gyv[j]));
                }
                __syncthreads();
                if (seg == 15) carry[cs] = h;
            }
            {
                unsigned* u8 = (unsigned*)(P.ws + O_UB);
                const size_t cbase = ((size_t)item * 16 + tile) * 2048;
#pragma unroll
                for (int k = 0; k < 4; ++k) {
                    const size_t ci = cbase + k * 512 + tid; const float sc = ci < (size_t)NTOK * 256 ? 256.0f : 32.0f;
                    int wv = 0;
                    wv = __builtin_amdgcn_cvt_pk_fp8_f32(cvs[k][0] * sc, cvs[k][1] * sc, wv, false);
                    wv = __builtin_amdgcn_cvt_pk_fp8_f32(cvs[k][2] * sc, cvs[k][3] * sc, wv, true);
#ifdef PEER2
#ifdef PEER3
                    if (ci < (size_t)NTOK * 256) { const size_t e_ = ci >> 8; const unsigned c4 = (unsigned)ci & 255u; ((unsigned*)(P.ws + O_UB))[((size_t)(c4 >> 5) * 16384 + e_) * 32 + (c4 & 31u)] = (unsigned)wv; }
#else
                    if (ci < (size_t)NTOK * 256) u8[ci] = (unsigned)wv;
#endif
                    else { const size_t cv = ci - (size_t)NTOK * 256; const size_t e_ = cv >> 8; const unsigned c4 = (unsigned)cv & 255u;
                           ((unsigned*)(P.ws + O_VB))[((size_t)(c4 >> 5) * 16384 + e_) * 32 + (c4 & 31u)] = (unsigned)wv; }
#else
                    u8[ci] = (unsigned)wv;
#endif
                }
            }
#pragma unroll
            for (int r = 0; r < 7; ++r) rows[r] = rowsN[r];
        }
        __syncthreads();
    }
}

__device__ void phase_gla1(const Params& P, unsigned char* lds) {
    const int tid = threadIdx.x, wid = __builtin_amdgcn_readfirstlane(tid >> 6), lane = tid & 63, c = lane & 15, kq = lane >> 4;
    bf16_t* Qb_s = (bf16_t*)(lds + 33024);
    bf16_t* Kb_s = (bf16_t*)(lds + 50432);
    bf16_t* Klt_s = (bf16_t*)(lds + 67840);
    bf16_t* Vt_s = (bf16_t*)(lds + 86272);
    bf16_t* A_s = (bf16_t*)(lds + 123136);
    float* fl_s = (float*)(lds + 132352);
    float* segs = (float*)(lds + 136448);
    bf16_t* zq = (bf16_t*)(P.ws + O_ZQ); const bf16_t* zk = (const bf16_t*)(P.ws + O_ZK); const bf16_t* zv = (const bf16_t*)(P.ws + O_ZV);
    const float* flow = (const float*)(P.ws + O_FLOW); bf16_t* dlastb = (bf16_t*)(P.ws + O_DLAST); bf16_t* UT = (bf16_t*)(P.ws + O_UT); float* oin = P.out;
    for (int item0 = blockIdx.x; item0 < 1024; item0 += gridDim.x) {
        const int h = (item0 >> 3) & 3, bn = (item0 & 7) * 32 + (item0 >> 5), tok0 = bn * 64, item = bn * 4 + h;
        const int d = tid & 127, tg = tid >> 7;
        for (int i = tid; i < 1024; i += 512) fl_s[i] = flow[(size_t)tok0 * 16 + i];
        float w2[16];
#pragma unroll
        for (int r = 0; r < 16; ++r) w2[r] = P.gla_wf2[r * 512 + h * 128 + d];
        const float bfd = P.gla_bf[h * 128 + d];
        bf16_t q16[16], k16[16], v32[32];
#pragma unroll
        for (int j = 0; j < 16; ++j) { const size_t gi = (size_t)(tok0 + tg * 16 + j) * 512 + h * 128 + d; q16[j] = zq[gi]; k16[j] = zk[gi]; }
        {
            const int n = tid & 255, tg2 = tid >> 8;
#pragma unroll
            for (int j = 0; j < 32; ++j) v32[j] = zv[(size_t)(tok0 + tg2 * 32 + j) * 1024 + h * 256 + n];
        }
        __syncthreads();
        float g[16]; float run = 0.f;
#pragma unroll
        for (int j = 0; j < 16; ++j) {
            const int t = tg * 16 + j; float xv = bfd;
#pragma unroll
            for (int r = 0; r < 16; ++r) xv += fl_s[t * 16 + r] * w2[r];
            const float ls = fminf(xv, 0.f) - __logf(1.0f + __expf(-fabsf(xv)));
            run += ls * 0.0625f; g[j] = run;
#ifdef DBG_SCAN
            { int* fl = (int*)(P.ws + 240 * MBY); if (!(fabsf(fl_s[t * 16 + (j & 15)]) < 1e3f)) fl[40] = 1; if (!(fabsf(xv) < 1e30f)) fl[41] = 1; if (!(fabsf(ls) < 1e30f)) fl[42] = 1; }
#endif
        }
        segs[tg * 128 + d] = run;
        __syncthreads();
        float pre = 0.f, blast = 0.f;
#pragma unroll
        for (int s = 0; s < 4; ++s) { const float v = segs[s * 128 + d]; if (s < tg) pre += v; blast += v; }
#pragma unroll
        for (int j = 0; j < 16; ++j) {
            const int t = tg * 16 + j; const float bv = pre + g[j];
            const size_t gi = (size_t)(tok0 + t) * 512 + h * 128 + d;
            const float qv = bf2f(q16[j]), kv = bf2f(k16[j]);
            const float qb = qv * __expf(bv) * 0.08838834764831845f, kb = kv * __expf(-bv), kl = kv * __expf(blast - bv);
            const bf16_t qbb = f2bf(qb);
#ifdef DBG_SCAN
            { int* fl = (int*)(P.ws + 240 * MBY); if (!(fabsf(bv) < 1e30f)) fl[43] = 1; if (!(fabsf(kl) < 1e30f)) fl[44] = 1; if (!(fabsf(kb) < 1e30f)) fl[46] = 1; }
#endif
            Qb_s[t * 136 + d] = qbb; zq[gi] = qbb; Kb_s[t * 136 + d] = f2bf(kb); Klt_s[d * 72 + t] = f2bf(kl);
        }
        if (tg == 0) dlastb[(size_t)item * 128 + d] = f2bf(__expf(blast));
        {
            const int n = tid & 255, tg2 = tid >> 8;
#pragma unroll
            for (int j = 0; j < 32; ++j) { const int t = tg2 * 32 + j; Vt_s[n * 72 + t] = v32[j]; }
        }
        __syncthreads();
        {
            const int mi = wid >> 1;
#pragma unroll
            for (int jj = 0; jj < 2; ++jj) {
                const int nj = (wid & 1) * 2 + jj;
                f32x4 acc = {0.f, 0.f, 0.f, 0.f};
                if (nj <= mi) {
#pragma unroll
                    for (int ks = 0; ks < 4; ++ks) {
                        const bf16x8 a = *(const bf16x8*)(Qb_s + (mi * 16 + c) * 136 + ks * 32 + kq * 8);
                        const bf16x8 bb = *(const bf16x8*)(Kb_s + (nj * 16 + c) * 136 + ks * 32 + kq * 8);
                        acc = mfma16(a, bb, acc);
                    }
                }
#pragma unroll
                for (int r = 0; r < 4; ++r) { const int i = mi * 16 + kq * 4 + r, jx = nj * 16 + c; A_s[i * 72 + jx] = f2bf(jx <= i ? acc[r] : 0.f); }
            }
        }
        __syncthreads();
        {
#pragma unroll
            for (int mt = 0; mt < 2; ++mt) {
                const int nt_ = wid * 2 + mt;
                bf16x8 afr[2];
#pragma unroll
                for (int ks = 0; ks < 2; ++ks) afr[ks] = *(const bf16x8*)(Vt_s + (nt_ * 16 + c) * 72 + ks * 32 + kq * 8);
#pragma unroll
                for (int it = 0; it < 4; ++it) {
                    f32x4 acc = {0.f, 0.f, 0.f, 0.f};
#pragma unroll
                    for (int ks = 0; ks < 2; ++ks) acc = mfma16(afr[ks], *(const bf16x8*)(A_s + (it * 16 + c) * 72 + ks * 32 + kq * 8), acc);
                    *(f32x4*)(oin + (size_t)(tok0 + it * 16 + c) * 1024 + h * 256 + nt_ * 16 + kq * 4) = acc;
                }
            }
            bf16x8 kfr[2];
#pragma unroll
            for (int ks = 0; ks < 2; ++ks) kfr[ks] = *(const bf16x8*)(Klt_s + (wid * 16 + c) * 72 + ks * 32 + kq * 8);
#pragma unroll 4
            for (int nt = 0; nt < 16; ++nt) {
                f32x4 acc = {0.f, 0.f, 0.f, 0.f};
#pragma unroll
                for (int ks = 0; ks < 2; ++ks) acc = mfma16(kfr[ks], *(const bf16x8*)(Vt_s + (nt * 16 + c) * 72 + ks * 32 + kq * 8), acc);
#ifdef DBG_SCAN
                { int* fl = (int*)(P.ws + 240 * MBY); if (!(fabsf(acc[0]) < 1e30f) || !(fabsf(acc[1]) < 1e30f) || !(fabsf(acc[2]) < 1e30f) || !(fabsf(acc[3]) < 1e30f)) fl[45] = 1; }
#endif
                u32x2 w; w.x = pk2(acc[0], acc[1]); w.y = pk2(acc[2], acc[3]);
                *(u32x2*)(UT + ((size_t)item * 256 + nt * 16 + c) * 128 + wid * 16 + kq * 4) = w;
            }
        }
        __syncthreads();
    }
}

__device__ void phase_gla2(const Params& P) {
    const int tid = threadIdx.x, wid = __builtin_amdgcn_readfirstlane(tid >> 6), lane = tid & 63, c = lane & 15, kq = lane >> 4;
    const bf16_t* zq = (const bf16_t*)(P.ws + O_ZQ); const bf16_t* dlastb = (const bf16_t*)(P.ws + O_DLAST); const bf16_t* UT = (const bf16_t*)(P.ws + O_UT);
    float* oin = P.out; float* ssq = (float*)(P.ws + O_SSQ);
    for (int item = blockIdx.x; item < 256; item += gridDim.x) {
        const int pair_ = (item & 7) * 4 + (item >> 6), s = (item >> 3) & 7, b = pair_ >> 2, h = pair_ & 3;
        const int mi = wid & 3, ni = wid >> 2, ncol = s * 32 + ni * 16;
        float S[4][8];
#pragma unroll
        for (int ks = 0; ks < 4; ++ks)
#pragma unroll
            for (int j = 0; j < 8; ++j) S[ks][j] = 0.f;
#define G2_LOAD(Q, U, D, OI, NC) do { const int bn_ = b * 32 + (NC), it_ = bn_ * 4 + h, tok_ = bn_ * 64 + mi * 16 + c; \
            OI = *(const f32x4*)(oin + (size_t)tok_ * 1024 + h * 256 + ncol + kq * 4); \
            _Pragma("unroll") for (int ks = 0; ks < 4; ++ks) { \
                Q[ks] = *(const bf16x8*)(zq + (size_t)tok_ * 512 + h * 128 + ks * 32 + kq * 8); \
                U[ks] = *(const u32x4*)(UT + ((size_t)it_ * 256 + ncol + c) * 128 + ks * 32 + kq * 8); \
                D[ks] = *(const u32x4*)(dlastb + (size_t)it_ * 128 + ks * 32 + kq * 8); } } while (0)
#define G2_COMP(Q, U, D, OI, NC) do { const int bn_ = b * 32 + (NC), tok_ = bn_ * 64 + mi * 16 + c; \
            f32x4 acc = OI; \
            _Pragma("unroll") for (int ks = 0; ks < 4; ++ks) { \
                u32x4 w; w.x = pk2(S[ks][0], S[ks][1]); w.y = pk2(S[ks][2], S[ks][3]); w.z = pk2(S[ks][4], S[ks][5]); w.w = pk2(S[ks][6], S[ks][7]); \
                acc = mfma16(__builtin_bit_cast(bf16x8, w), Q[ks], acc); } \
            *(f32x4*)(oin + (size_t)tok_ * 1024 + h * 256 + ncol + kq * 4) = acc; \
            float ss = acc[0] * acc[0] + acc[1] * acc[1] + acc[2] * acc[2] + acc[3] * acc[3]; \
            ss += __shfl_xor(ss, 16); ss += __shfl_xor(ss, 32); \
            if (kq == 0) ssq[((size_t)tok_ * 4 + h) * 16 + s * 2 + ni] = ss; \
            _Pragma("unroll") for (int ks = 0; ks < 4; ++ks) { const u32x4 uu = U[ks]; const u32x4 dd = D[ks]; \
                S[ks][0] = bflo(dd.x) * S[ks][0] + bflo(uu.x); S[ks][1] = bfhi(dd.x) * S[ks][1] + bfhi(uu.x); \
                S[ks][2] = bflo(dd.y) * S[ks][2] + bflo(uu.y); S[ks][3] = bfhi(dd.y) * S[ks][3] + bfhi(uu.y); \
                S[ks][4] = bflo(dd.z) * S[ks][4] + bflo(uu.z); S[ks][5] = bfhi(dd.z) * S[ks][5] + bfhi(uu.z); \
                S[ks][6] = bflo(dd.w) * S[ks][6] + bflo(uu.w); S[ks][7] = bfhi(dd.w) * S[ks][7] + bfhi(uu.w); } } while (0)
        bf16x8 QA[4], QB[4], QC[4]; u32x4 UA[4], UB[4], UC[4], DA[4], DB[4], DC[4]; f32x4 oA, oB, oC;
        G2_LOAD(QA, UA, DA, oA, 0);
        G2_LOAD(QB, UB, DB, oB, 1);
#pragma unroll 1
        for (int nc = 0; nc < 33; nc += 3) {
            G2_LOAD(QC, UC, DC, oC, (nc + 2 < 32 ? nc + 2 : 31));
            G2_COMP(QA, UA, DA, oA, nc);
            G2_LOAD(QA, UA, DA, oA, (nc + 3 < 32 ? nc + 3 : 31));
            G2_COMP(QB, UB, DB, oB, nc + 1);
            if (nc + 2 >= 32) break;
            G2_LOAD(QB, UB, DB, oB, (nc + 4 < 32 ? nc + 4 : 31));
            G2_COMP(QC, UC, DC, oC, nc + 2);
        }
#undef G2_LOAD
#undef G2_COMP
    }
}

__device__ void phase_combine(const Params& P) {
    const float* oin = P.out; const float* ssq = (const float*)(P.ws + O_SSQ); const bf16_t* gr = (const bf16_t*)(P.ws + O_GR); bf16_t* ym = (bf16_t*)(P.ws + O_XB);
    for (int idx = blockIdx.x * 512 + threadIdx.x; idx < NTOK * 128; idx += gridDim.x * 512) {
        const int row = idx >> 7, col = (idx & 127) * 8, h = col >> 8;
        const f32x4* sp = (const f32x4*)(ssq + ((size_t)row * 4 + h) * 16);
        const f32x4 s0 = sp[0], s1 = sp[1], s2 = sp[2], s3 = sp[3];
        const float tot = (s0[0] + s0[1] + s0[2] + s0[3]) + (s1[0] + s1[1] + s1[2] + s1[3]) + (s2[0] + s2[1] + s2[2] + s2[3]) + (s3[0] + s3[1] + s3[2] + s3[3]);
        const float rs = rsqrtf(tot * (1.0f / 256.0f) + 1e-6f);
        const size_t gi = (size_t)row * 1024 + col;
        const f32x4 o0 = *(const f32x4*)(oin + gi), o1 = *(const f32x4*)(oin + gi + 4);
        const f32x4 n0 = *(const f32x4*)(P.gla_norm_g + col), n1 = *(const f32x4*)(P.gla_norm_g + col + 4);
        const u32x4 g = *(const u32x4*)(gr + gi), y = *(const u32x4*)(ym + gi);
        u32x4 w;
        w.x = pk2(bflo(y.x) + bflo(g.x) * (o0[0] * rs * n0[0]), bfhi(y.x) + bfhi(g.x) * (o0[1] * rs * n0[1]));
        w.y = pk2(bflo(y.y) + bflo(g.y) * (o0[2] * rs * n0[2]), bfhi(y.y) + bfhi(g.y) * (o0[3] * rs * n0[3]));
        w.z = pk2(bflo(y.z) + bflo(g.z) * (o1[0] * rs * n1[0]), bfhi(y.z) + bfhi(g.z) * (o1[1] * rs * n1[1]));
        w.w = pk2(bflo(y.w) + bflo(g.w) * (o1[2] * rs * n1[2]), bfhi(y.w) + bfhi(g.w) * (o1[3] * rs * n1[3]));
        *(u32x4*)(ym + gi) = w;
    }
}

__device__ void phase_ln1(const Params& P) {
    const int tid = threadIdx.x, wid = tid >> 6, lane = tid & 63;
    float* y = P.out; bf16_t* x1b = (bf16_t*)(P.ws + O_X1B);
    const int rstride = gridDim.x * 8;
    for (int row0 = blockIdx.x * 8 + wid; row0 < NTOK; row0 += 2 * rstride) {
        const int row1 = row0 + rstride; const bool has1 = row1 < NTOK; const int r1 = has1 ? row1 : row0;
        f32x4 v[4], w[4]; float s = 0.f, s1 = 0.f;
#pragma unroll
        for (int i = 0; i < 4; ++i) { v[i] = *(const f32x4*)(y + (size_t)row0 * 1024 + i * 256 + lane * 4); w[i] = *(const f32x4*)(y + (size_t)r1 * 1024 + i * 256 + lane * 4); }
#pragma unroll
        for (int i = 0; i < 4; ++i) { s += (v[i][0] + v[i][1]) + (v[i][2] + v[i][3]); s1 += (w[i][0] + w[i][1]) + (w[i][2] + w[i][3]); }
        s += __shfl_xor(s, 32); s1 += __shfl_xor(s1, 32); s += __shfl_xor(s, 16); s1 += __shfl_xor(s1, 16);
        s += dpp_xor8(s); s1 += dpp_xor8(s1); s += dpp_xor4(s); s1 += dpp_xor4(s1); s += dpp_xor2(s); s1 += dpp_xor2(s1); s += dpp_xor1(s); s1 += dpp_xor1(s1);
        const float mu = s * (1.0f / 1024.0f), mu1 = s1 * (1.0f / 1024.0f);
        float q = 0.f, q1 = 0.f;
#pragma unroll
        for (int i = 0; i < 4; ++i) { v[i] = v[i] - mu; w[i] = w[i] - mu1; q += (v[i][0] * v[i][0] + v[i][1] * v[i][1]) + (v[i][2] * v[i][2] + v[i][3] * v[i][3]); q1 += (w[i][0] * w[i][0] + w[i][1] * w[i][1]) + (w[i][2] * w[i][2] + w[i][3] * w[i][3]); }
        q += __shfl_xor(q, 32); q1 += __shfl_xor(q1, 32); q += __shfl_xor(q, 16); q1 += __shfl_xor(q1, 16);
        q += dpp_xor8(q); q1 += dpp_xor8(q1); q += dpp_xor4(q); q1 += dpp_xor4(q1); q += dpp_xor2(q); q1 += dpp_xor2(q1); q += dpp_xor1(q); q1 += dpp_xor1(q1);
        const float rstd = rsqrtf(q * (1.0f / 1024.0f) + 1e-5f), rstd1 = rsqrtf(q1 * (1.0f / 1024.0f) + 1e-5f);
#pragma unroll
        for (int i = 0; i < 4; ++i) {
            const int col = i * 256 + lane * 4;
            const f32x4 gg = *(const f32x4*)(P.ln1_g + col), bb = *(const f32x4*)(P.ln1_b + col);
            const f32x4 o = v[i] * rstd * gg + bb;
            *(f32x4*)(y + (size_t)row0 * 1024 + col) = o;
            u32x2 pw; pw.x = pk2(o[0], o[1]); pw.y = pk2(o[2], o[3]);
            *(u32x2*)(x1b + (size_t)row0 * 1024 + col) = pw;
            if (has1) {
                const f32x4 o1 = w[i] * rstd1 * gg + bb;
                *(f32x4*)(y + (size_t)row1 * 1024 + col) = o1;
                u32x2 pw1; pw1.x = pk2(o1[0], o1[1]); pw1.y = pk2(o1[2], o1[3]);
                *(u32x2*)(x1b + (size_t)row1 * 1024 + col) = pw1;
            }
        }
    }
}

__device__ __forceinline__ int sortable(int bits) { return bits ^ ((bits >> 31) & 0x7fffffff); }
__device__ __forceinline__ void sort16_asc(int (&a)[16]) {
#pragma unroll
    for (int k = 2; k <= 16; k <<= 1)
#pragma unroll
        for (int j = k >> 1; j > 0; j >>= 1)
#pragma unroll
            for (int i = 0; i < 16; ++i) { const int l = i ^ j;
                if (l > i) { const int lo = min(a[i], a[l]), hi = max(a[i], a[l]); const bool up = ((i & k) == 0); a[i] = up ? lo : hi; a[l] = up ? hi : lo; } }
}
__device__ __forceinline__ void merge_top16(int (&top)[16], const int (&asc)[16]) {
#pragma unroll
    for (int i = 0; i < 16; ++i) top[i] = max(top[i], asc[i]);
#pragma unroll
    for (int j = 8; j > 0; j >>= 1)
#pragma unroll
        for (int i = 0; i < 16; ++i) { const int l = i ^ j; if (l > i) { const int lo = min(top[i], top[l]), hi = max(top[i], top[l]); top[i] = hi; top[l] = lo; } }
}
__device__ void phase_peer(const Params& P, unsigned char* lds, cg::grid_group& grid) {
    const bool align_sync = false;
    const int tid = threadIdx.x, wid = __builtin_amdgcn_readfirstlane(tid >> 6), lane = tid & 63;
    int* ridx = (int*)lds;
    float* rgt = (float*)(lds + 33024);
    const float* qp = (const float*)(P.ws + O_QP); const bf16_t* x1b = (const bf16_t*)(P.ws + O_X1B);
    const unsigned char* u8t = P.ws + O_UB; const unsigned char* v8t = P.ws + O_VB; const bf16_t* ple = (const bf16_t*)(P.ws + O_PP);
    float* xo = P.out;
    for (int tile = blockIdx.x; tile < NTOK / 64; tile += gridDim.x) {
        const int tok0 = tile * 64;
#ifndef NO_ROUTE
#ifdef PROBE_T
        unsigned long long pt0 = __builtin_amdgcn_s_memrealtime();
#endif
        {
            const int token = tok0 + lane;
            int* Ls = (int*)(lds + 66048) + wid * 32 * 64 + lane;
            typedef float f32x16 __attribute__((ext_vector_type(16)));
            const int lc = lane & 31, lh = lane >> 5;
#define SPLIT8(HI, LO, A0, A1) do { \
                const float v_[8] = {A0[0], A0[1], A0[2], A0[3], A1[0], A1[1], A1[2], A1[3]}; unsigned h_[4], l_[4]; \
                _Pragma("unroll") for (int e_ = 0; e_ < 4; ++e_) { h_[e_] = pk2(v_[2 * e_], v_[2 * e_ + 1]); l_[e_] = pk2(v_[2 * e_] - bflo(h_[e_]), v_[2 * e_ + 1] - bfhi(h_[e_])); } \
                HI = __builtin_bit_cast(bf16x8, (u32x4){h_[0], h_[1], h_[2], h_[3]}); LO = __builtin_bit_cast(bf16x8, (u32x4){l_[0], l_[1], l_[2], l_[3]}); } while (0)
#pragma unroll 1
            for (int p = 0; p < 2; ++p) {
                bf16x8 Qh[2][4], Ql[2][4];
#pragma unroll
                for (int nt = 0; nt < 2; ++nt)
#pragma unroll
                    for (int ks = 0; ks < 4; ++ks) {
                        const float* qr = qp + (size_t)(tok0 + nt * 32 + lc) * 1024 + wid * 128 + p * 64 + ks * 16 + lh * 8;
                        const f32x4 a0 = *(const f32x4*)qr, a1 = *(const f32x4*)(qr + 4);
                        SPLIT8(Qh[nt][ks], Ql[nt][ks], a0, a1);
                    }
                int topA[16], topB[16];
#pragma unroll
                for (int i = 0; i < 16; ++i) { topA[i] = (int)0x80000000; topB[i] = (int)0x80000000; }
                const float* keys = P.peer_subkeys + (size_t)((wid * 2 + p) * 128) * 64;
#pragma unroll 1
                for (int mt = 0; mt < 4; ++mt) {
                    bf16x8 Kh[4], Kl[4];
#pragma unroll
                    for (int ks = 0; ks < 4; ++ks) {
                        const float* kr = keys + (size_t)(mt * 32 + lc) * 64 + ks * 16 + lh * 8;
                        const f32x4 a0 = *(const f32x4*)kr, a1 = *(const f32x4*)(kr + 4);
                        SPLIT8(Kh[ks], Kl[ks], a0, a1);
                    }
#pragma unroll
                    for (int nt = 0; nt < 2; ++nt) {
                        f32x16 acc;
#pragma unroll
                        for (int i = 0; i < 16; ++i) acc[i] = 0.f;
#pragma unroll
                        for (int ks = 0; ks < 4; ++ks) {
                            acc = __builtin_amdgcn_mfma_f32_32x32x16_bf16(Kh[ks], Qh[nt][ks], acc, 0, 0, 0);
                            acc = __builtin_amdgcn_mfma_f32_32x32x16_bf16(Kh[ks], Ql[nt][ks], acc, 0, 0, 0);
                            acc = __builtin_amdgcn_mfma_f32_32x32x16_bf16(Kl[ks], Qh[nt][ks], acc, 0, 0, 0);
                        }
                        int nk16[16];
#pragma unroll
                        for (int i = 0; i < 16; ++i) { const int kidx = mt * 32 + 8 * (i >> 2) + 4 * lh + (i & 3); nk16[i] = sortable((__float_as_int(acc[i]) & ~127) | kidx); }
                        sort16_asc(nk16);
                        if (nt == 0) merge_top16(topA, nk16); else merge_top16(topB, nk16);
                    }
                }
                int mine[16];
#pragma unroll
                for (int i = 0; i < 16; ++i) mine[i] = lh ? topB[i] : topA[i];
                int recv[16];
#pragma unroll
                for (int i = 0; i < 16; ++i) { const int send = lh ? topA[15 - i] : topB[15 - i]; recv[i] = __shfl_xor(send, 32); }
                merge_top16(mine, recv);
#pragma unroll
                for (int i = 0; i < 16; ++i) Ls[(p * 16 + i) * 64] = mine[i];
            }
#undef SPLIT8
            int top2k[16];
#pragma unroll
            for (int i = 0; i < 16; ++i) top2k[i] = (int)0x80000000;
            float v1s[16];
#pragma unroll
            for (int j = 0; j < 16; ++j) v1s[j] = __int_as_float(sortable(Ls[(16 + j) * 64]) & ~127);
#pragma unroll
            for (int i = 0; i < 16; ++i) {
                const int b0 = sortable(Ls[i * 64]); const float va = __int_as_float(b0 & ~127);
#pragma unroll
                for (int j = 0; j < 16 / (i + 1); ++j) {
                    const float sm = va + v1s[j];
                    int key = sortable((__float_as_int(sm) & ~255) | (i << 4) | j);
#pragma unroll
                    for (int m = 0; m < 16; ++m) { const int hi = max(top2k[m], key); key = min(top2k[m], key); top2k[m] = hi; }
                }
            }
            long long top2[16];
#pragma unroll
            for (int m = 0; m < 16; ++m) {
                const int bits = sortable(top2k[m]); const int ci = (bits >> 4) & 15, cj = bits & 15;
                const int e0 = sortable(Ls[ci * 64]) & 127, e1 = sortable(Ls[(16 + cj) * 64]) & 127;
                top2[m] = (long long)((((unsigned long long)(unsigned)sortable(bits & ~255)) << 32) | (unsigned long long)(unsigned)(e0 * 128 + e1));
            }
            float e[16]; float smax = __int_as_float(sortable((int)(top2[0] >> 32))); float den = 0.f;
#pragma unroll
            for (int m = 0; m < 16; ++m) { const float sv = __int_as_float(sortable((int)(top2[m] >> 32))); e[m] = __expf(sv - smax); den += e[m]; }
            const float inv = 1.0f / den;
#ifdef PEER3
            {
                int* RI = (int*)(P.ws + O_RIDX) + (size_t)token * 128 + wid * 16; float* RWp = (float*)(P.ws + O_RG) + (size_t)token * 128 + wid * 16;
#pragma unroll
                for (int m4 = 0; m4 < 4; ++m4) {
                    *(u32x4*)(RI + m4 * 4) = (u32x4){(unsigned)(top2[m4 * 4] & 0xffffffffll), (unsigned)(top2[m4 * 4 + 1] & 0xffffffffll), (unsigned)(top2[m4 * 4 + 2] & 0xffffffffll), (unsigned)(top2[m4 * 4 + 3] & 0xffffffffll)};
                    *(f32x4*)(RWp + m4 * 4) = (f32x4){e[m4 * 4] * inv, e[m4 * 4 + 1] * inv, e[m4 * 4 + 2] * inv, e[m4 * 4 + 3] * inv};
                }
            }
#else
#pragma unroll
            for (int m = 0; m < 16; ++m) { ridx[lane * 129 + wid * 16 + m] = (int)(unsigned)(top2[m] & 0xffffffffll); rgt[lane * 129 + wid * 16 + m] = e[m] * inv; }
#endif
        }
#endif
        __syncthreads();
#ifdef PEER3
        continue;
#endif
#ifndef NO_GATHER
#ifdef PROBE_T
        unsigned long long pt1 = __builtin_amdgcn_s_memrealtime();
#endif
        {
            const int j = lane & 15, g = lane >> 4;
            unsigned char* xt = lds + 82560;
#pragma unroll 1
            for (int half = 0; half < 2; ++half) {
                for (int i = tid; i < 32 * 128; i += 512) { const int t = i >> 7, c16 = i & 127; *(u32x4*)(xt + t * 2064 + c16 * 16) = *(const u32x4*)(x1b + (size_t)(tok0 + half * 32 + t) * 1024 + c16 * 8); }
                __syncthreads();
                float dkeep = 0.f; int pkeep = -1; int nk = 0;
                int r_ = 0, ch_ = wid - 8; unsigned long long m0 = 0ull, m1 = 0ull;
#define PA_ADV(VALID, TL, BS, ACT) do { VALID = true; \
                    while (!(m0 | m1)) { ch_ += 8; if (ch_ >= 32) { ch_ = wid; if (++r_ >= 1) { VALID = false; break; } } \
                        const int tl_ = half * 32 + ch_; const int id0 = ridx[tl_ * 129 + lane], id1 = ridx[tl_ * 129 + 64 + lane]; \
                        m0 = __ballot((id0 >> 14) == r_); m1 = __ballot((id1 >> 14) == r_); } \
                    if (VALID) { int bb[4]; \
                        _Pragma("unroll") for (int q = 0; q < 4; ++q) { \
                            if (m0) { bb[q] = __ffsll((long long)m0) - 1; m0 &= m0 - 1; } \
                            else if (m1) { bb[q] = 64 + __ffsll((long long)m1) - 1; m1 &= m1 - 1; } \
                            else bb[q] = -1; } \
                        const int bg = g == 0 ? bb[0] : (g == 1 ? bb[1] : (g == 2 ? bb[2] : bb[3])); \
                        ACT = bg >= 0; BS = ACT ? bg : bb[0]; TL = half * 32 + ch_; } else { ACT = false; BS = 0; TL = half * 32; } } while (0)
#define PA_LOAD(U, TL, BS) do { const int pidx = ridx[(TL) * 129 + (BS)]; const unsigned char* ur = u8t + (size_t)pidx * 1024 + j * 16; \
                    _Pragma("unroll") for (int i = 0; i < 4; ++i) U[i] = *(const u32x4*)(ur + i * 256); } while (0)
#define PA_COMP(U, TL, BS, ACT) do { \
                        const unsigned char* xrow = xt + ((TL) - half * 32) * 2064 + j * 32; \
                        float d0 = 0.f, d1 = 0.f; \
                        _Pragma("unroll") for (int i = 0; i < 4; ++i) { \
                            const u32x4 xa = *(const u32x4*)(xrow + i * 512), xb_ = *(const u32x4*)(xrow + i * 512 + 16); \
                            _Pragma("unroll") for (int q = 0; q < 4; ++q) { \
                                const u32x4 xs = q < 2 ? xa : xb_; \
                                const unsigned wd = U[i][q]; \
                                const f32x2 lo_ = __builtin_amdgcn_cvt_pk_f32_fp8((int)wd, false), hi_ = __builtin_amdgcn_cvt_pk_f32_fp8((int)wd, true); \
                                d0 = dot2bf(pk2(lo_.x, lo_.y), xs[(q & 1) * 2], d0); d1 = dot2bf(pk2(hi_.x, hi_.y), xs[(q & 1) * 2 + 1], d1); } } \
                        float dsum = d0 + d1; \
                        dsum += __shfl_xor(dsum, 1); dsum += __shfl_xor(dsum, 2); dsum += __shfl_xor(dsum, 4); dsum += __shfl_xor(dsum, 8); \
                        dsum *= (1.0f / 256.0f); \
                        if (j == nk) { dkeep = dsum; pkeep = (ACT) ? (TL) * 129 + (BS) : -1; } \
                        if (++nk == 16) { \
                            if (pkeep >= 0) { const float hid = 0.5f * dkeep * (1.0f + erff(dkeep * 0.70710678118f)); rgt[pkeep] *= hid * (1.0f / 32.0f); } \
                            nk = 0; pkeep = -1; } } while (0)
                bool vA, vB, actA = false, actB = false; int tlA = 0, tlB = 0, bsA = 0, bsB = 0; u32x4 uA[4], uB[4];
                PA_ADV(vA, tlA, bsA, actA);
                PA_LOAD(uA, tlA, bsA);
                while (vA) {
                    PA_ADV(vB, tlB, bsB, actB);
                    PA_LOAD(uB, tlB, bsB);
                    PA_COMP(uA, tlA, bsA, actA);
                    if (!vB) break;
                    PA_ADV(vA, tlA, bsA, actA);
                    PA_LOAD(uA, tlA, bsA);
                    PA_COMP(uB, tlB, bsB, actB);
                }
#undef PA_COMP
#undef PA_ADV
#undef PA_LOAD
                if (pkeep >= 0) { const float hid = 0.5f * dkeep * (1.0f + erff(dkeep * 0.70710678118f)); rgt[pkeep] *= hid * (1.0f / 32.0f); }
                __syncthreads();
            }
#ifdef PROBE_T
            unsigned long long pt2 = __builtin_amdgcn_s_memrealtime();
            { unsigned long long* tsl = (unsigned long long*)(lds + 163840 - 64); if (tid == 0) { tsl[0] = pt1 - pt0; tsl[1] = pt2 - pt1; } }
#endif
#ifdef PEER2
            {
                int* RI = (int*)(P.ws + O_RIDX) + (size_t)tok0 * 128; float* RWp = (float*)(P.ws + O_RW) + (size_t)tok0 * 128;
                for (int i = tid; i < 64 * 128; i += 512) { RI[i] = ridx[(i >> 7) * 129 + (i & 127)]; RWp[i] = rgt[(i >> 7) * 129 + (i & 127)]; }
            }
            continue;
#endif
#pragma unroll 1
            for (int tt = 0; tt < 8; ++tt) {
                const int tl = wid * 8 + tt, token = tok0 + tl;
                f32x2 acc[32];
#pragma unroll
                for (int i = 0; i < 32; ++i) acc[i] = (f32x2){0.f, 0.f};
#define PEER_LOAD(V, GT, IT) do { const int e_ = (IT) * 4 + g; const int idx_ = ridx[tl * 129 + e_]; GT = rgt[tl * 129 + e_]; \
                    const unsigned char* vr_ = v8t + (size_t)idx_ * 1024 + j * 16; \
                    _Pragma("unroll") for (int i = 0; i < 4; ++i) V[i] = *(const u32x4*)(vr_ + i * 256); } while (0)
#define PEER_COMP(V, GT) do { const f32x2 ww = {GT, GT}; \
                    _Pragma("unroll") for (int i = 0; i < 4; ++i) _Pragma("unroll") for (int q = 0; q < 4; ++q) { const int wd = (int)V[i][q]; \
                        acc[i * 8 + q * 2] = __builtin_elementwise_fma(ww, __builtin_amdgcn_cvt_pk_f32_fp8(wd, false), acc[i * 8 + q * 2]); \
                        acc[i * 8 + q * 2 + 1] = __builtin_elementwise_fma(ww, __builtin_amdgcn_cvt_pk_f32_fp8(wd, true), acc[i * 8 + q * 2 + 1]); } } while (0)
                u32x4 vA[4], vB[4], vC[4], vD[4]; float gA, gB, gC, gD;
                PEER_LOAD(vA, gA, 0); PEER_LOAD(vB, gB, 1); PEER_LOAD(vC, gC, 2);
#pragma unroll 1
                for (int it = 0; it < 32; it += 4) {
                    PEER_LOAD(vD, gD, it + 3);
                    PEER_COMP(vA, gA);
                    PEER_LOAD(vA, gA, (it + 4 < 32 ? it + 4 : 31));
                    PEER_COMP(vB, gB);
                    PEER_LOAD(vB, gB, (it + 5 < 32 ? it + 5 : 31));
                    PEER_COMP(vC, gC);
                    PEER_LOAD(vC, gC, (it + 6 < 32 ? it + 6 : 31));
                    PEER_COMP(vD, gD);
                }
#undef PEER_LOAD
#undef PEER_COMP
#pragma unroll
                for (int i = 0; i < 32; ++i) {
                    acc[i].x += __shfl_xor(acc[i].x, 16); acc[i].y += __shfl_xor(acc[i].y, 16);
                    acc[i].x += __shfl_xor(acc[i].x, 32); acc[i].y += __shfl_xor(acc[i].y, 32);
                }
                const size_t col = (size_t)(j + 16 * g) * 16;
                float yv[16]; float s = 0.f;
                {
                    const u32x4 pw0 = *(const u32x4*)(ple + (size_t)token * 1024 + col), pw1 = *(const u32x4*)(ple + (size_t)token * 1024 + col + 8);
                    const float pv[16] = {bflo(pw0.x), bfhi(pw0.x), bflo(pw0.y), bfhi(pw0.y), bflo(pw0.z), bfhi(pw0.z), bflo(pw0.w), bfhi(pw0.w),
                                          bflo(pw1.x), bfhi(pw1.x), bflo(pw1.y), bfhi(pw1.y), bflo(pw1.z), bfhi(pw1.z), bflo(pw1.w), bfhi(pw1.w)};
#pragma unroll
                    for (int q = 0; q < 8; ++q) {
                        const f32x2 a_ = g == 0 ? acc[q] : (g == 1 ? acc[8 + q] : (g == 2 ? acc[16 + q] : acc[24 + q]));
                        const f32x2 x_ = *(const f32x2*)(xo + (size_t)token * 1024 + col + q * 2);
                        const float y0 = DN_ALPHA * x_.x + a_.x + pv[q * 2], y1 = DN_ALPHA * x_.y + a_.y + pv[q * 2 + 1];
                        yv[q * 2] = y0; yv[q * 2 + 1] = y1; s += y0 + y1;
                    }
                }
                const float mu = wave_sum(s) * (1.0f / 1024.0f);
                float qq = 0.f;
#pragma unroll
                for (int q = 0; q < 16; ++q) { yv[q] -= mu; qq += yv[q] * yv[q]; }
                const float rstd = rsqrtf(wave_sum(qq) * (1.0f / 1024.0f) + 1e-5f);
                {
                    const float* lg = P.ln2_g; const float* lb = P.ln2_b; asm volatile("" : "+s"(lg), "+s"(lb));
#pragma unroll
                    for (int q = 0; q < 4; ++q) {
                        const f32x4 gg = *(const f32x4*)(lg + col + q * 4), bb = *(const f32x4*)(lb + col + q * 4);
                        f32x4 o;
#pragma unroll
                        for (int r = 0; r < 4; ++r) o[r] = yv[q * 4 + r] * rstd * gg[r] + bb[r];
                        *(f32x4*)(xo + (size_t)token * 1024 + col + q * 4) = o;
                    }
                }
            }
        }
#endif
        __syncthreads();
    }
}

#define XB_TMO      128
#define XB_XCNT(j)  (256  + 64 * (j))
#define XB_XSUB(j)  (1280 + 64 * (j))
#define XB_XGEN(j)  (2304 + 64 * (j))
#define XB_TOP      3328
#define XB_TOPGEN   3392
#define XCD_BAR_WORDS 3456
#define XB_SPIN_CAP (1u << 18)
#define LAS __attribute__((address_space(3)))

__device__ __forceinline__ unsigned xb_ld(unsigned* p)              { return __hip_atomic_load(p, __ATOMIC_RELAXED, __HIP_MEMORY_SCOPE_AGENT); }
__device__ __forceinline__ unsigned xb_add(unsigned* p, unsigned v) { return __hip_atomic_fetch_add(p, v, __ATOMIC_RELAXED, __HIP_MEMORY_SCOPE_AGENT); }
__device__ __forceinline__ unsigned xb_xcc_id() { return (unsigned)__builtin_amdgcn_s_getreg((3 << 11) | 20) & 0xFu; }
#define XB_SPIN(cond, bar) do { unsigned _sp = 0; while (cond) { __builtin_amdgcn_s_sleep(1); \
    if ((++_sp & 255u) == 0u) { if (xb_ld(&(bar)[XB_TMO])) break; if (_sp > XB_SPIN_CAP) { atomicAdd(&(bar)[XB_TMO], 1u); break; } } } } while (0)

struct XcdBarrier {
    unsigned* bar; unsigned x;
    volatile LAS unsigned* st;
};

__device__ __forceinline__ XcdBarrier xcd_barrier_post(unsigned* bar, volatile LAS unsigned* st) {
    XcdBarrier b; b.bar = bar; b.x = xb_xcc_id(); b.st = st;
    if (threadIdx.x == 0) (void)xb_add(&bar[XB_XCNT(b.x)], 1u);
    return b;
}
__device__ __forceinline__ void xcd_barrier_complete(unsigned* bar, unsigned x, unsigned& nloc, unsigned& nx) {
    const unsigned G = gridDim.x * gridDim.y * gridDim.z;
    unsigned sum, cnt, mine, sp = 0u;
    for (;;) {
        sum = 0u; cnt = 0u; mine = 0u;
#pragma unroll
        for (unsigned j = 0; j < 16; ++j) { const unsigned c = xb_ld(&bar[XB_XCNT(j)]); sum += c; cnt += (c > 0u) ? 1u : 0u; mine = (j == x) ? c : mine; }
        if (sum == G) break;
        __builtin_amdgcn_s_sleep(1);
        if ((++sp & 255u) == 0u) { if (xb_ld(&bar[XB_TMO])) break; if (sp > XB_SPIN_CAP) { atomicAdd(&bar[XB_TMO], 1u); break; } }
    }
    nloc = mine > 0u ? mine : 1u; nx = cnt > 0u ? cnt : 1u;
}

__device__ __forceinline__ void xcd_barrier(const XcdBarrier& b) {
    asm volatile("s_waitcnt vmcnt(0)" ::: "memory");
    __syncthreads();
    if (threadIdx.x == 0) {
        unsigned* bar = b.bar;
        __builtin_amdgcn_s_waitcnt(0);
        unsigned nloc = b.st[0], nx = b.st[1];
        if (nloc == 0u) { xcd_barrier_complete(bar, b.x, nloc, nx); b.st[0] = nloc; b.st[1] = nx; }
        const unsigned old = xb_add(&bar[XB_XSUB(b.x)], 1u);
        const unsigned gen = old / nloc;
        if (old + 1u == (gen + 1u) * nloc) {
            __builtin_amdgcn_fence(__ATOMIC_RELEASE, "agent");
            asm volatile("s_waitcnt vmcnt(0)" ::: "memory");
            const unsigned og = xb_add(&bar[XB_TOP], 1u);
            const unsigned tg = og / nx;
            if (og + 1u == (tg + 1u) * nx) xb_add(&bar[XB_TOPGEN], 1u);
            else XB_SPIN(xb_ld(&bar[XB_TOPGEN]) == tg, bar);
            __builtin_amdgcn_fence(__ATOMIC_ACQUIRE, "agent");
            xb_add(&bar[XB_XGEN(b.x)], 1u);
            asm volatile("s_waitcnt vmcnt(0)" ::: "memory");
        } else {
            XB_SPIN(xb_ld(&bar[XB_XGEN(b.x)]) == gen, bar);
            __builtin_amdgcn_fence(__ATOMIC_ACQUIRE, "agent");
            asm volatile("s_waitcnt vmcnt(0)" ::: "memory");
        }
    }
    __syncthreads();
}


constexpr size_t O_BAR = 250 * MBY;
__device__ __forceinline__ void counter_barrier(unsigned* cnt, unsigned& epoch) {
    asm volatile("s_waitcnt vmcnt(0)" ::: "memory");
    __syncthreads();
    if (threadIdx.x == 0) {
        __builtin_amdgcn_fence(__ATOMIC_RELEASE, "agent");
        asm volatile("s_waitcnt vmcnt(0)" ::: "memory");
        (void)__hip_atomic_fetch_add(cnt, 1u, __ATOMIC_RELAXED, __HIP_MEMORY_SCOPE_AGENT);
        const unsigned target = (epoch + 1u) * gridDim.x;
        while (__hip_atomic_load(cnt, __ATOMIC_RELAXED, __HIP_MEMORY_SCOPE_AGENT) < target) __builtin_amdgcn_s_sleep(2);
        __builtin_amdgcn_fence(__ATOMIC_ACQUIRE, "agent");
        asm volatile("s_waitcnt vmcnt(0)" ::: "memory");
    }
    ++epoch;
    __syncthreads();
}

#ifdef PEER2
__device__ __forceinline__ int peer_pop(unsigned* q, volatile int* slot) {
    __syncthreads();
    if (threadIdx.x == 0) *slot = (int)__hip_atomic_fetch_add(q, 1u, __ATOMIC_RELAXED, __HIP_MEMORY_SCOPE_AGENT);
    __syncthreads();
    return *slot;
}
__device__ __forceinline__ int peer_next(unsigned* q, int k0, int& kk, unsigned limit, volatile int* slot) {
    __syncthreads();
    if (threadIdx.x == 0) {
        int fk = -1, t = 0;
        for (int i = kk; i < 8; ++i) {
            unsigned* qa = q + ((k0 + i) & 7) * 64;
            if (__hip_atomic_load(qa, __ATOMIC_RELAXED, __HIP_MEMORY_SCOPE_AGENT) >= limit) continue;
            const unsigned tt = __hip_atomic_fetch_add(qa, 1u, __ATOMIC_RELAXED, __HIP_MEMORY_SCOPE_AGENT);
            if (tt < limit) { fk = i; t = (int)tt; break; }
        }
        slot[0] = fk; slot[1] = t;
    }
    __syncthreads();
    kk = slot[0]; return slot[1];
}
struct PeerTickets { int is_static, rank, nloc, t, kk; };
__device__ __forceinline__ void peer_tickets_init(PeerTickets& T, unsigned* bar, volatile int* slot) {
    __syncthreads();
    if (threadIdx.x == 0) {
        const unsigned G = gridDim.x; bool ok = (G % 8u) == 0u && (NTOK / 128) % (int)(G / 8u) == 0;
        for (unsigned jx = 0; jx < 16; ++jx) { const unsigned c = __hip_atomic_load(&bar[XB_XCNT(jx)], __ATOMIC_RELAXED, __HIP_MEMORY_SCOPE_AGENT); if (c != (jx < 8 ? G / 8u : 0u)) ok = false; }
        slot[0] = ok ? 1 : 0;
    }
    __syncthreads();
    T.is_static = slot[0]; T.rank = slot[2]; T.nloc = (int)(gridDim.x / 8u); T.t = 0; T.kk = 0;
    __syncthreads();
}
__device__ __forceinline__ int peer_ticket(PeerTickets& T, unsigned* q, int k0, unsigned limit, volatile int* slot) {
    if (T.is_static) {
        __syncthreads();
        const int g = T.rank + T.t * T.nloc; ++T.t;
        if (g >= (int)limit) { T.kk = -1; return 0; }
        T.kk = 0; return g;
    }
    return peer_next(q, k0, T.kk, limit, slot);
}
__device__ void peer_passA2(const Params& P, unsigned char* lds) {
    const int tid = threadIdx.x, wid = __builtin_amdgcn_readfirstlane(tid >> 6), lane = tid & 63, j = lane & 15, g = lane >> 4;
    const int* RI = (const int*)(P.ws + O_RIDX); float* RWp = (float*)(P.ws + O_RW);
    const bf16_t* x1b = (const bf16_t*)(P.ws + O_X1B); const unsigned char* u8t = P.ws + O_UB;
    unsigned char* xt = lds;
    unsigned short* ids = (unsigned short*)(lds + 132096);
    volatile int* slot = (volatile int*)(lds + 163840 - 48);
    unsigned* qA = (unsigned*)(P.ws + O_BAR) + 3584;
    const int k0 = (int)(xb_xcc_id() & 7u);
#pragma unroll 1
    for (int kk = 0; kk < 8; ++kk) {
        const int k = (k0 + kk) & 7;
#pragma unroll 1
        for (;;) {
            const int grp = peer_pop(qA + k * 64, slot);
            if (grp >= NTOK / 64) break;
            const int tok0 = grp * 64;
            for (int i = tid; i < 64 * 128; i += 512) { const int t = i >> 7, c16 = i & 127; *(u32x4*)(xt + t * 2064 + c16 * 16) = *(const u32x4*)(x1b + (size_t)(tok0 + t) * 1024 + c16 * 8); }
            for (int i = tid; i < 64 * 128 / 4; i += 512) { const u32x4 v = *(const u32x4*)(RI + (size_t)tok0 * 128 + i * 4); *(u32x2*)(ids + i * 4) = (u32x2){(v.x & 0xffffu) | (v.y << 16), (v.z & 0xffffu) | (v.w << 16)}; }
            __syncthreads();
            float dkeep = 0.f; int pkeep = -1; int nk = 0;
            int ch_ = -1; unsigned long long m0 = 0ull, m1 = 0ull;
#define PA_ADV(VALID, TL, BS, ACT) do { VALID = true; \
                while (!(m0 | m1)) { if (++ch_ >= 8) { VALID = false; break; } \
                    const int tl_ = wid * 8 + ch_; const int id0 = ids[tl_ * 128 + lane], id1 = ids[tl_ * 128 + 64 + lane]; \
                    m0 = __ballot((id0 >> 11) == k); m1 = __ballot((id1 >> 11) == k); } \
                if (VALID) { int bb[4]; \
                    _Pragma("unroll") for (int q = 0; q < 4; ++q) { \
                        if (m0) { bb[q] = __ffsll((long long)m0) - 1; m0 &= m0 - 1; } \
                        else if (m1) { bb[q] = 64 + __ffsll((long long)m1) - 1; m1 &= m1 - 1; } \
                        else bb[q] = -1; } \
                    const int bg = g == 0 ? bb[0] : (g == 1 ? bb[1] : (g == 2 ? bb[2] : bb[3])); \
                    ACT = bg >= 0; BS = ACT ? bg : bb[0]; TL = wid * 8 + ch_; } else { ACT = false; BS = 0; TL = wid * 8; } } while (0)
#define PA_LOAD(U, TL, BS) do { const int pidx = ids[(TL) * 128 + (BS)]; const unsigned char* ur = u8t + (size_t)pidx * 1024 + j * 16; \
                _Pragma("unroll") for (int i = 0; i < 4; ++i) U[i] = *(const u32x4*)(ur + i * 256); } while (0)
#define PA_COMP(U, TL, BS, ACT) do { \
                const unsigned char* xrow = xt + (TL) * 2064 + j * 32; \
                float d0 = 0.f, d1 = 0.f; \
                _Pragma("unroll") for (int i = 0; i < 4; ++i) { \
                    const u32x4 xa = *(const u32x4*)(xrow + i * 512), xb_ = *(const u32x4*)(xrow + i * 512 + 16); \
                    _Pragma("unroll") for (int q = 0; q < 4; ++q) { \
                        const u32x4 xs = q < 2 ? xa : xb_; \
                        const unsigned wd = U[i][q]; \
                        const f32x2 lo_ = __builtin_amdgcn_cvt_pk_f32_fp8((int)wd, false), hi_ = __builtin_amdgcn_cvt_pk_f32_fp8((int)wd, true); \
                        d0 = dot2bf(pk2(lo_.x, lo_.y), xs[(q & 1) * 2], d0); d1 = dot2bf(pk2(hi_.x, hi_.y), xs[(q & 1) * 2 + 1], d1); } } \
                float dsum = d0 + d1; \
                dsum += __shfl_xor(dsum, 1); dsum += __shfl_xor(dsum, 2); dsum += __shfl_xor(dsum, 4); dsum += __shfl_xor(dsum, 8); \
                dsum *= (1.0f / 256.0f); \
                if (j == nk) { dkeep = dsum; pkeep = (ACT) ? (tok0 + (TL)) * 128 + (BS) : -1; } \
                if (++nk == 16) { \
                    if (pkeep >= 0) { const float hid = 0.5f * dkeep * (1.0f + erff(dkeep * 0.70710678118f)); RWp[pkeep] *= hid * (1.0f / 32.0f); } \
                    nk = 0; pkeep = -1; } } while (0)
            bool vA, vB, actA = false, actB = false; int tlA = 0, tlB = 0, bsA = 0, bsB = 0; u32x4 uA[4], uB[4];
            PA_ADV(vA, tlA, bsA, actA);
            PA_LOAD(uA, tlA, bsA);
            while (vA) {
                PA_ADV(vB, tlB, bsB, actB);
                PA_LOAD(uB, tlB, bsB);
                PA_COMP(uA, tlA, bsA, actA);
                if (!vB) break;
                PA_ADV(vA, tlA, bsA, actA);
                PA_LOAD(uA, tlA, bsA);
                PA_COMP(uB, tlB, bsB, actB);
            }
#undef PA_ADV
#undef PA_LOAD
#undef PA_COMP
            if (pkeep >= 0) { const float hid = 0.5f * dkeep * (1.0f + erff(dkeep * 0.70710678118f)); RWp[pkeep] *= hid * (1.0f / 32.0f); }
        }
    }
}
#ifdef PEER3
__device__ void peer_passA3(const Params& P, unsigned char* lds) {
    const int tid = threadIdx.x, wid = __builtin_amdgcn_readfirstlane(tid >> 6), lane = tid & 63, j8 = lane & 7, t8 = lane >> 3;
    const int* RI = (const int*)(P.ws + O_RIDX); const float* x1 = P.out; float* PART = (float*)(P.ws + O_PART);
    volatile int* slot = (volatile int*)(lds + 163840 - 48);
    unsigned* qA = (unsigned*)(P.ws + O_BAR) + 3584;
    const int k0 = (int)(xb_xcc_id() & 7u);
    PeerTickets TK; peer_tickets_init(TK, (unsigned*)(P.ws + O_BAR), slot);
#pragma unroll 1
    for (;;) {
        const int grp = peer_ticket(TK, qA, k0, (unsigned)(NTOK / 128), slot); const int kk = TK.kk;
        if (kk < 0) break;
        const int k = (k0 + kk) & 7;
        const unsigned char* ublk = P.ws + O_UB + (size_t)k * 16384 * 128 + j8 * 16;
        {
            u32x4* li0 = (u32x4*)lds; const u32x4* gi = (const u32x4*)(RI + (size_t)grp * 128 * 128);
            for (int i = tid; i < 128 * 32; i += 512) li0[(i >> 5) * 33 + (i & 31)] = gi[i];
        }
        __syncthreads();
#pragma unroll 1
        for (int sub = 0; sub < 2; ++sub) {
            const int tl = sub * 64 + wid * 8 + t8, token = grp * 128 + tl;
            const int* li = (const int*)lds + tl * 132;
            f32x2 xp[8];
#pragma unroll
            for (int q = 0; q < 4; ++q) { const f32x4 v = *(const f32x4*)(x1 + (size_t)token * 1024 + k * 128 + j8 * 16 + q * 4); xp[q * 2] = (f32x2){v[0], v[1]}; xp[q * 2 + 1] = (f32x2){v[2], v[3]}; }
            float* po = PART + (size_t)k * NTOK * 128 + (size_t)token * 128 + j8;
#define PA3_LOAD(V, IT) do { _Pragma("unroll") for (int q = 0; q < 8; ++q) V[q] = *(const u32x4*)(ublk + (size_t)li[(IT) + q] * 128); } while (0)
#define PA3_COMP(V, IT) do { float s_[8]; \
                _Pragma("unroll") for (int q = 0; q < 8; ++q) { f32x2 a0 = {0.f, 0.f}, a1 = {0.f, 0.f}; \
                    _Pragma("unroll") for (int d = 0; d < 4; ++d) { const int wd = (int)V[q][d]; \
                        a0 = __builtin_elementwise_fma(__builtin_amdgcn_cvt_pk_f32_fp8(wd, false), xp[d * 2], a0); \
                        a1 = __builtin_elementwise_fma(__builtin_amdgcn_cvt_pk_f32_fp8(wd, true), xp[d * 2 + 1], a1); } \
                    const f32x2 a = a0 + a1; s_[q] = a.x + a.y; } \
                float r4[4]; \
                _Pragma("unroll") for (int i = 0; i < 4; ++i) { const float mine = (j8 & 4) ? s_[4 + i] : s_[i], oth = (j8 & 4) ? s_[i] : s_[4 + i]; r4[i] = mine + dpp_xor4(oth); } \
                float r2[2]; \
                _Pragma("unroll") for (int i = 0; i < 2; ++i) { const float mine = (j8 & 2) ? r4[2 + i] : r4[i], oth = (j8 & 2) ? r4[i] : r4[2 + i]; r2[i] = mine + dpp_xor2(oth); } \
                const float mine1 = (j8 & 1) ? r2[1] : r2[0], oth1 = (j8 & 1) ? r2[0] : r2[1]; \
                po[(IT)] = mine1 + dpp_xor1(oth1); } while (0)
            u32x4 vA[8], vB[8]; int iA[8], iB[8];
#define PA3_IDX(I, IT) do { _Pragma("unroll") for (int q = 0; q < 8; ++q) I[q] = li[(IT) + q]; } while (0)
#define PA3_LOADI(V, I) do { _Pragma("unroll") for (int q = 0; q < 8; ++q) V[q] = *(const u32x4*)(ublk + (size_t)(unsigned)I[q] * 128); } while (0)
            PA3_IDX(iA, 0); PA3_IDX(iB, 8);
            PA3_LOADI(vA, iA);
#pragma unroll 1
            for (int it = 0; it < 128; it += 16) {
                PA3_LOADI(vB, iB);
                PA3_IDX(iA, (it + 16 < 128 ? it + 16 : 112));
                PA3_COMP(vA, it);
                PA3_LOADI(vA, iA);
                PA3_IDX(iB, (it + 24 < 128 ? it + 24 : 120));
                PA3_COMP(vB, it + 8);
            }
#undef PA3_IDX
#undef PA3_LOADI
#undef PA3_LOAD
#undef PA3_COMP
        }
    }
}
__device__ void peer_reduce3(const Params& P) {
    const float* PART = (const float*)(P.ws + O_PART); const float* RG = (const float*)(P.ws + O_RG); float* RWp = (float*)(P.ws + O_RW);
    for (int i = blockIdx.x * 512 + threadIdx.x; i < NTOK * 128 / 4; i += gridDim.x * 512) {
        f32x4 d = *(const f32x4*)(PART + (size_t)i * 4);
#pragma unroll
        for (int k = 1; k < 8; ++k) d += *(const f32x4*)(PART + (size_t)k * NTOK * 128 + (size_t)i * 4);
        const f32x4 gt = *(const f32x4*)(RG + (size_t)i * 4);
        const float dscale = 1.0f / 256.0f;
        const f32x2 g0 = pg8::gelu_pk((f32x2){d[0] * dscale, d[1] * dscale}), g1 = pg8::gelu_pk((f32x2){d[2] * dscale, d[3] * dscale});
        const f32x4 w = (f32x4){gt[0] * g0.x, gt[1] * g0.y, gt[2] * g1.x, gt[3] * g1.y} * (1.0f / 32.0f);
        *(f32x4*)(RWp + (size_t)i * 4) = w;
    }
}
#endif
__device__ void peer_passB2(const Params& P, unsigned char* lds) {
    const int tid = threadIdx.x, wid = __builtin_amdgcn_readfirstlane(tid >> 6), lane = tid & 63, j8 = lane & 7, g8 = lane >> 3;
    const int* RI = (const int*)(P.ws + O_RIDX); const float* RWp = (const float*)(P.ws + O_RW);
    float* FF = (float*)(P.ws + O_FF);
    volatile int* slot = (volatile int*)(lds + 163840 - 48);
    unsigned* qB = (unsigned*)(P.ws + O_BAR) + 4096;
    const int k0 = (int)(xb_xcc_id() & 7u);
    PeerTickets TK; peer_tickets_init(TK, (unsigned*)(P.ws + O_BAR), slot);
#pragma unroll 1
    for (;;) {
        {
            const int grp = peer_ticket(TK, qB, k0, (unsigned)(NTOK / 128), slot); const int kk = TK.kk;
            if (kk < 0) break;
            const int k = (k0 + kk) & 7;
            const unsigned char* vblk = P.ws + O_VB + (size_t)k * 16384 * 128 + j8 * 16;
            {
                u32x4* li0 = (u32x4*)lds; u32x4* lw0 = (u32x4*)(lds + 67584);
                const u32x4* gi = (const u32x4*)(RI + (size_t)grp * 128 * 128); const u32x4* gw = (const u32x4*)(RWp + (size_t)grp * 128 * 128);
                for (int i = tid; i < 128 * 32; i += 512) { li0[(i >> 5) * 33 + (i & 31)] = gi[i]; lw0[(i >> 5) * 33 + (i & 31)] = gw[i]; }
            }
            __syncthreads();
            {
                const int t8 = lane >> 3;
                const int* lib = (const int*)lds + (wid * 8 + t8) * 132; const float* lwb = (const float*)(lds + 67584) + (wid * 8 + t8) * 132;
#define POS(P_) ((((P_) >> 7) * (64 * 132)) + ((P_) & 127))
                f32x2 acc[8];
#pragma unroll
                for (int i = 0; i < 8; ++i) acc[i] = (f32x2){0.f, 0.f};
#define PB_COMP(V, IT) do { const float* lw_ = lwb + POS(IT); _Pragma("unroll") for (int q = 0; q < 8; ++q) { const float w_ = lw_[q]; const f32x2 ww = {w_, w_}; \
                    _Pragma("unroll") for (int d = 0; d < 4; ++d) { const int wd = (int)V[q][d]; \
                        acc[d * 2] = __builtin_elementwise_fma(ww, __builtin_amdgcn_cvt_pk_f32_fp8(wd, false), acc[d * 2]); \
                        acc[d * 2 + 1] = __builtin_elementwise_fma(ww, __builtin_amdgcn_cvt_pk_f32_fp8(wd, true), acc[d * 2 + 1]); } } } while (0)
                u32x4 vA[8], vB[8]; int iA[8], iB[8];
#define PB_IDX(I, IT) do { const int* li_ = lib + POS(IT); _Pragma("unroll") for (int q = 0; q < 8; ++q) I[q] = li_[q]; } while (0)
#define PB_LOADI(V, I) do { _Pragma("unroll") for (int q = 0; q < 8; ++q) V[q] = *(const u32x4*)(vblk + (size_t)(unsigned)I[q] * 128); } while (0)
                PB_IDX(iA, 0); PB_IDX(iB, 8);
                PB_LOADI(vA, iA);
#pragma unroll 1
                for (int it = 0; it < 256; it += 16) {
                    PB_LOADI(vB, iB);
                    PB_IDX(iA, (it + 16 < 256 ? it + 16 : 240));
                    PB_COMP(vA, it);
                    PB_LOADI(vA, iA);
                    PB_IDX(iB, (it + 24 < 256 ? it + 24 : 248));
                    PB_COMP(vB, it + 8);
                    if ((it & 127) == 112) {
                        const int token = grp * 128 + (it >> 7) * 64 + wid * 8 + t8;
                        float* o = FF + (size_t)token * 1024 + k * 128 + j8 * 16;
#pragma unroll
                        for (int q = 0; q < 4; ++q) *(f32x4*)(o + q * 4) = (f32x4){acc[q * 2].x, acc[q * 2].y, acc[q * 2 + 1].x, acc[q * 2 + 1].y};
#pragma unroll
                        for (int i = 0; i < 8; ++i) acc[i] = (f32x2){0.f, 0.f};
                    }
                }
#undef PB_IDX
#undef PB_LOADI
#undef PB_COMP
#undef POS
            }
        }
    }
}
__device__ void peer_ln2(const Params& P) {
    const int tid = threadIdx.x, wid = tid >> 6, lane = tid & 63;
    float* y = P.out; const float* FF = (const float*)(P.ws + O_FF); const bf16_t* ple = (const bf16_t*)(P.ws + O_PP);
    const int rstride = gridDim.x * 8;
    for (int row0 = blockIdx.x * 8 + wid; row0 < NTOK; row0 += 2 * rstride) {
        const int row1 = row0 + rstride; const bool has1 = row1 < NTOK; const int r1 = has1 ? row1 : row0;
        f32x4 v[4], w[4]; float s = 0.f, s1 = 0.f;
#pragma unroll
        for (int i = 0; i < 4; ++i) {
            const size_t c0 = (size_t)row0 * 1024 + i * 256 + lane * 4, c1 = (size_t)r1 * 1024 + i * 256 + lane * 4;
            const u32x2 p0 = *(const u32x2*)(ple + c0), p1 = *(const u32x2*)(ple + c1);
            v[i] = *(const f32x4*)(y + c0) * DN_ALPHA + *(const f32x4*)(FF + c0) + (f32x4){bflo(p0.x), bfhi(p0.x), bflo(p0.y), bfhi(p0.y)};
            w[i] = *(const f32x4*)(y + c1) * DN_ALPHA + *(const f32x4*)(FF + c1) + (f32x4){bflo(p1.x), bfhi(p1.x), bflo(p1.y), bfhi(p1.y)};
        }
#pragma unroll
        for (int i = 0; i < 4; ++i) { s += (v[i][0] + v[i][1]) + (v[i][2] + v[i][3]); s1 += (w[i][0] + w[i][1]) + (w[i][2] + w[i][3]); }
        s += __shfl_xor(s, 32); s1 += __shfl_xor(s1, 32); s += __shfl_xor(s, 16); s1 += __shfl_xor(s1, 16);
        s += dpp_xor8(s); s1 += dpp_xor8(s1); s += dpp_xor4(s); s1 += dpp_xor4(s1); s += dpp_xor2(s); s1 += dpp_xor2(s1); s += dpp_xor1(s); s1 += dpp_xor1(s1);
        const float mu = s * (1.0f / 1024.0f), mu1 = s1 * (1.0f / 1024.0f);
        float q = 0.f, q1 = 0.f;
#pragma unroll
        for (int i = 0; i < 4; ++i) { v[i] = v[i] - mu; w[i] = w[i] - mu1; q += (v[i][0] * v[i][0] + v[i][1] * v[i][1]) + (v[i][2] * v[i][2] + v[i][3] * v[i][3]); q1 += (w[i][0] * w[i][0] + w[i][1] * w[i][1]) + (w[i][2] * w[i][2] + w[i][3] * w[i][3]); }
        q += __shfl_xor(q, 32); q1 += __shfl_xor(q1, 32); q += __shfl_xor(q, 16); q1 += __shfl_xor(q1, 16);
        q += dpp_xor8(q); q1 += dpp_xor8(q1); q += dpp_xor4(q); q1 += dpp_xor4(q1); q += dpp_xor2(q); q1 += dpp_xor2(q1); q += dpp_xor1(q); q1 += dpp_xor1(q1);
        const float rstd = rsqrtf(q * (1.0f / 1024.0f) + 1e-5f), rstd1 = rsqrtf(q1 * (1.0f / 1024.0f) + 1e-5f);
#pragma unroll
        for (int i = 0; i < 4; ++i) {
            const int col = i * 256 + lane * 4;
            const f32x4 gg = *(const f32x4*)(P.ln2_g + col), bb = *(const f32x4*)(P.ln2_b + col);
            *(f32x4*)(y + (size_t)row0 * 1024 + col) = v[i] * rstd * gg + bb;
            if (has1) *(f32x4*)(y + (size_t)row1 * 1024 + col) = w[i] * rstd1 * gg + bb;
        }
    }
}
#endif

__global__ void __launch_bounds__(512, 2) mega(Params P) {
    extern __shared__ __attribute__((aligned(16))) unsigned char shm[];
    cg::grid_group grid = cg::this_grid();
    PG8_LAS unsigned char* ldsg = (PG8_LAS unsigned char*)shm;
#ifdef ONLY
#define PH(i) ((i) == ONLY)
#else
#define PH(i) (P.ph_lo <= (i) && (i) < P.ph_hi)
#endif
#ifdef USE_XCD_BARRIER
#define SYNC() do { if (P.coop == 1) xcd_barrier(xbar); else if (P.coop == 2) grid.sync(); } while (0)
#else
    unsigned bar_epoch = 0u;
#define SYNC() do { if (P.coop == 1) counter_barrier((unsigned*)(P.ws + O_BAR) + 64, bar_epoch); else if (P.coop == 2) grid.sync(); } while (0)
#endif
    volatile LAS unsigned* xst = (volatile LAS unsigned*)(ldsg + (163840 - 32));
    if (threadIdx.x == 0) { xst[0] = 0u; xst[1] = 0u; }
    __syncthreads();
#ifndef HOST_MEMSET
    if (P.coop) {
        if (blockIdx.x == 0) for (int i = threadIdx.x; i < XCD_BAR_WORDS; i += 512) ((unsigned*)(P.ws + O_BAR))[i] = 0u;
        grid.sync();
    }
#else
    if (P.coop == 2) grid.sync();
#endif
    XcdBarrier xbar = xcd_barrier_post((unsigned*)(P.ws + O_BAR), xst);
    if (threadIdx.x == 0) ((volatile LAS int*)(ldsg + (163840 - 48)))[2] = (int)__hip_atomic_fetch_add((unsigned*)(P.ws + O_BAR) + 7168 + 64 * (xbar.x & 15u), 1u, __ATOMIC_RELAXED, __HIP_MEMORY_SCOPE_AGENT);
#ifdef PROBE_T
    unsigned long long TS[14];
#define STAMP(k) TS[k] = __builtin_amdgcn_s_memrealtime()
#else
#define STAMP(k)
#endif
    STAMP(0);
    if (PH(0)) { phase_prep(P, shm); SYNC(); }
    STAMP(1);
    if (PH(1)) {
        pg8::Gemm g{(const bf16_t*)(P.ws + O_XB), (const bf16_t*)(P.ws + O_WINT), NTOK, 7168, 1024};
        pg8::StaticOrder S; S.init(NTOK, 7168, (int)gridDim.x, (int)blockIdx.x);
        EpiZ E{P.ws};
        pg8::gemm_phase<EpiZ, pg8::StaticOrder, false>(ldsg, g, S, E, nullptr);
        SYNC();
    }
    STAMP(2);
    if (PH(2)) { phase_lru(P, shm); SYNC(); }
    STAMP(3);
    if (PH(3)) { phase_gla1(P, shm); SYNC(); }
    STAMP(4);
    if (PH(4)) { phase_gla2(P); SYNC(); }
    STAMP(5);
    if (PH(5)) { phase_combine(P); SYNC(); }
    STAMP(6);
    if (PH(6)) {
        {
            pg8::Gemm g{(const bf16_t*)(P.ws + O_XB), (const bf16_t*)(P.ws + O_WOUTT), NTOK, 1024, 1024};
            pg8::StaticOrder S; S.init(NTOK, 1024, (int)gridDim.x, (int)blockIdx.x);
            EpiY1 E{P.x, P.out};
            pg8::gemm_phase<EpiY1, pg8::StaticOrder, false>(ldsg, g, S, E, nullptr);
        }
        {
            pg8::Gemm g{(const bf16_t*)(P.ws + O_PB), (const bf16_t*)(P.ws + O_WPPT), NTOK, 1024, 256};
            pg8::StaticOrder S; S.init(NTOK, 1024, (int)gridDim.x, (int)blockIdx.x);
            EpiPP E{(bf16_t*)(P.ws + O_PP)};
            pg8::gemm_phase<EpiPP, pg8::StaticOrder, false>(ldsg, g, S, E, nullptr);
        }
        SYNC();
    }
    STAMP(7);
    if (PH(7)) { phase_ln1(P); SYNC(); }
    STAMP(8);
    if (PH(8)) {
        pg8::Gemm g{(const bf16_t*)(P.ws + O_X1B), (const bf16_t*)(P.ws + O_WQGT), NTOK, 2048, 1024};
        pg8::StaticOrder S; S.init(NTOK, 2048, (int)gridDim.x, (int)blockIdx.x);
        EpiQG E{(float*)(P.ws + O_QP), (bf16_t*)(P.ws + O_PP)};
        pg8::gemm_phase<EpiQG, pg8::StaticOrder, false>(ldsg, g, S, E, nullptr);
        SYNC();
    }
    STAMP(9);
#ifdef EXTRA_SYNCS
    for (int i = 0; i < EXTRA_SYNCS; ++i) SYNC();
#endif
    if (PH(9)) { phase_peer(P, shm, grid); }
#ifdef PEER2
#ifdef PEER3
    if (PH(9)) { SYNC(); STAMP(10); peer_passA3(P, shm); SYNC(); peer_reduce3(P); SYNC(); STAMP(11); peer_passB2(P, shm); SYNC(); STAMP(13); peer_ln2(P); }
#else
    if (PH(9)) { SYNC(); STAMP(11); peer_passB2(P, shm); SYNC(); STAMP(13); peer_ln2(P); }
#endif
#endif
#ifdef PROBE_T
    {
        __syncthreads();
        const unsigned long long* tsl = (const unsigned long long*)(shm + 163840 - 64);
#ifndef PEER2
        TS[10] = TS[9] + tsl[0]; TS[11] = TS[10] + tsl[1];
#endif
        STAMP(12);
        const unsigned long long dtS = TS[PROBE_SB] - TS[PROBE_SA], dtF = TS[PROBE_FB] - TS[PROBE_FA];
        while (__builtin_amdgcn_s_memrealtime() - TS[12] < dtS) __builtin_amdgcn_s_sleep(8);
        if (blockIdx.x == 0 && threadIdx.x < 64) {
            const float frac = (float)(double)dtF / (float)(double)(TS[12] - TS[0]);
            P.out[threadIdx.x] += 0.2f + 0.2f * frac;
        }
    }
#endif
#undef PH
#undef SYNC
#undef STAMP
}

#ifdef DBG_SCAN

__global__ void dbg_check(const void* p, size_t n, int is_bf16, int* flags, int code) {
    int bad = 0;
    if (is_bf16) { const unsigned short* q = (const unsigned short*)p; for (size_t i = (size_t)blockIdx.x * blockDim.x + threadIdx.x; i < n; i += (size_t)gridDim.x * blockDim.x) if ((q[i] & 0x7f80) == 0x7f80) bad = 1; }
    else { const unsigned* q = (const unsigned*)p; for (size_t i = (size_t)blockIdx.x * blockDim.x + threadIdx.x; i < n; i += (size_t)gridDim.x * blockDim.x) if ((q[i] & 0x7f800000u) == 0x7f800000u) bad = 1; }
    if (bad) flags[code] = 1;
}
__global__ void dbg_report(float* out, size_t n, const int* flags) {
    int code = 0; for (int c = 40; c < 64; ++c) if (flags[c]) { code = c; break; }
    if (!code) for (int c = 1; c < 40; ++c) if (flags[c]) { code = c; break; }
    for (size_t i = (size_t)blockIdx.x * blockDim.x + threadIdx.x; i < n; i += (size_t)gridDim.x * blockDim.x) out[i] = (i == 0) ? 1000.f * code : 0.f;
}
static void dbg_after_phase(int ph, const Params& P, hipStream_t stream) {
    int* flags = (int*)(P.ws + 240 * MBY);
    auto chk = [&](size_t off, size_t nelem, int bf, int code) { hipLaunchKernelGGL(dbg_check, dim3(1024), dim3(256), 0, stream, (const void*)(P.ws + off), nelem, bf, flags, code); };
    auto chko = [&](int code) { hipLaunchKernelGGL(dbg_check, dim3(1024), dim3(256), 0, stream, (const void*)P.out, (size_t)NTOK * 1024, 0, flags, code); };
    const size_t M1 = (size_t)NTOK * 1024, MH = (size_t)NTOK * 512;
    switch (ph) {
    case 0: chk(O_XB, M1, 1, 1); chk(O_FLOW, (size_t)NTOK * 16, 0, 2); chk(O_PB, (size_t)NTOK * 256, 1, 3); chk(O_WINT, (size_t)7168 * 1024, 1, 4); chk(O_WOUTT, (size_t)1024 * 1024, 1, 5); chk(O_WQGT, (size_t)2048 * 1024, 1, 6); chk(O_WPPT, (size_t)1024 * 256, 1, 7); break;
    case 1: chk(O_ZX, M1, 1, 8); chk(O_GY, M1, 1, 9); chk(O_ZQ, MH, 1, 10); chk(O_ZK, MH, 1, 11); chk(O_ZV, M1, 1, 12); chk(O_GR, M1, 1, 13); break;
    case 2: chk(O_XB, M1, 1, 14); break;
    case 3: chk(O_ZQ, MH, 1, 15); chk(O_UT, (size_t)1024 * 256 * 128, 1, 16); chko(17); chk(O_DLAST, (size_t)1024 * 128, 0, 18); break;
    case 4: chko(19); chk(O_SSQ, (size_t)NTOK * 64, 0, 20); break;
    case 5: chk(O_XB, M1, 1, 21); break;
    case 6: chko(22); chk(O_PP, M1, 1, 23); break;
    case 7: chko(24); chk(O_X1B, M1, 1, 25); chk(O_UB, 2 * M1, 1, 26); break;
    case 8: chk(O_QP, M1, 0, 27); chk(O_PP, M1, 1, 28); break;
    case 9: chko(29); break;
    }
}
#endif
#ifndef MULTI_LAUNCH
#define MULTI_LAUNCH 0
#endif
extern "C" void kernel_launch(void* const* d_in, const int* in_sizes, int n_in, void* d_out, int out_size, void* d_ws, size_t ws_size, hipStream_t stream) {
    static int grid = 0;
    if (grid == 0) {
        int dev = 0, cus = 0, per_cu = 0;
        hipGetDevice(&dev); hipDeviceGetAttribute(&cus, hipDeviceAttributeMultiprocessorCount, dev);
        if (hipFuncSetAttribute((const void*)mega, hipFuncAttributeMaxDynamicSharedMemorySize, LDS_BYTES) != hipSuccess) { fprintf(stderr, "hipFuncSetAttribute failed\n"); }
        hipOccupancyMaxActiveBlocksPerMultiprocessor(&per_cu, (const void*)mega, 512, LDS_BYTES);
        if (per_cu < 1) { fprintf(stderr, "occupancy query says %d\n", per_cu); per_cu = 1; }
        (void)hipGetLastError();
        grid = cus * 1;
        if (ws_size < 236 * MBY) fprintf(stderr, "workspace too small: %zu\n", ws_size);
    }
    Params P{};
    P.x = (const float*)d_in[0]; P.p = (const float*)d_in[1]; P.w_in = (const float*)d_in[2]; P.conv_w = (const float*)d_in[3]; P.conv_b = (const float*)d_in[4];
    P.lru_wr = (const float*)d_in[5]; P.lru_br = (const float*)d_in[6]; P.lru_wi = (const float*)d_in[7]; P.lru_bi = (const float*)d_in[8]; P.lru_lambda = (const float*)d_in[9];
    P.gla_wf2 = (const float*)d_in[10]; P.gla_bf = (const float*)d_in[11]; P.gla_norm_g = (const float*)d_in[12]; P.w_out = (const float*)d_in[13]; P.ln1_g = (const float*)d_in[14];
    P.ln1_b = (const float*)d_in[15]; P.peer_wq = (const float*)d_in[16]; P.peer_subkeys = (const float*)d_in[17]; P.peer_u = (const float*)d_in[18]; P.peer_v = (const float*)d_in[19];
    P.ple_gate_w = (const float*)d_in[20]; P.ple_proj_w = (const float*)d_in[21]; P.ln2_g = (const float*)d_in[22]; P.ln2_b = (const float*)d_in[23];
    P.out = (float*)d_out; P.ws = (unsigned char*)d_ws; P.pad_ = 0;
#if MULTI_LAUNCH
    for (int ph = 0; ph < 10; ++ph) {
        P.ph_lo = ph; P.ph_hi = ph + 1; P.coop = 0;
        hipLaunchKernelGGL(mega, dim3(grid), dim3(512), LDS_BYTES, stream, P);
#ifdef DBG_SCAN
        if (ph == 0) (void)hipMemsetAsync(P.ws + 240 * MBY, 0, 256, stream);
        dbg_after_phase(ph, P, stream);
#endif
    }
#ifdef DBG_SCAN
    hipLaunchKernelGGL(dbg_report, dim3(1024), dim3(256), 0, stream, P.out, (size_t)NTOK * 1024, (const int*)(P.ws + 240 * MBY));
#endif
#else
    P.ph_lo = 0; P.ph_hi = 10; P.coop = 1;
#ifdef HOST_MEMSET
    (void)hipMemsetD32Async((hipDeviceptr_t)((unsigned char*)d_ws + O_BAR), 0, 8192, stream);
#endif
    void* args[] = {&P};
    hipError_t e = hipLaunchCooperativeKernel((const void*)mega, dim3(grid), dim3(512), args, LDS_BYTES, stream);
    if (e != hipSuccess) fprintf(stderr, "cooperative launch failed: %s (grid %d)\n", hipGetErrorString(e), grid);
#endif
}
```
